# Optimizing an MI355X kernel written in HIP

```python
import math
import jax, jax.numpy as jnp
from jax import lax
import numpy as np

D_MODEL = 1024
BATCH = 2
SEQ = 8192
DEPTH = 2
DEC_BATCH = 8
DEC_SEQ = 2048
PAST_LEN = 128

D_MIX = D_MODEL
D_A = D_MIX // 2
D_B = D_MIX - D_A
N_HEADS_A = 8
QK_NOPE = 64
QK_ROPE = 32
V_DIM = D_A // N_HEADS_A
Q_LORA = 384
KV_LORA = 256
ROPE_THETA = 10000.0
Q_BLOCK = 128
CHUNK = 128
G_B = 8
C_B = D_B // G_B
D_FF = ((8 * D_MODEL // 3 + 255) // 256) * 256
EPS = 1e-6
IN_COLS = Q_LORA + KV_LORA + QK_ROPE + 2 * D_B
IN_SPLITS = [Q_LORA, Q_LORA + KV_LORA, Q_LORA + KV_LORA + QK_ROPE, Q_LORA + KV_LORA + QK_ROPE + D_B]
N_MOD = 6

kernel_name = 'hybrid_mla_gmlp_encoder'


def _rmsnorm(x, g):
    xf = x.astype(jnp.float32)
    y = xf * lax.rsqrt(jnp.mean(xf * xf, axis=-1, keepdims=True) + EPS)
    return (y * g.astype(jnp.float32)).astype(x.dtype)


def _rope(x, cos, sin):
    half = x.shape[-1] // 2
    x1, x2 = x[..., :half], x[..., half:]
    cos = cos.astype(x.dtype)
    sin = sin.astype(x.dtype)
    return jnp.concatenate([x1 * cos - x2 * sin, x1 * sin + x2 * cos], axis=-1)


def _mla_attention(q_nope, q_rope, k_nope, k_rope, val):
    B, S, H, _ = q_nope.shape
    nb = S // Q_BLOCK
    scale = 1.0 / math.sqrt(QK_NOPE + QK_ROPE)
    qn = q_nope.reshape(B, nb, Q_BLOCK, H, QK_NOPE).transpose(1, 0, 2, 3, 4)
    qr = q_rope.reshape(B, nb, Q_BLOCK, H, QK_ROPE).transpose(1, 0, 2, 3, 4)

    def block(args):
        qn_b, qr_b = args
        s = (jnp.einsum('bqhd,bkhd->bhqk', qn_b, k_nope)
             + jnp.einsum('bqhd,bkd->bhqk', qr_b, k_rope))
        p = jax.nn.softmax(s.astype(jnp.float32) * scale, axis=-1)
        return jnp.einsum('bhqk,bkhd->bqhd', p.astype(val.dtype), val)

    out = lax.map(block, (qn, qr))
    return out.transpose(1, 0, 2, 3, 4).reshape(B, S, H * V_DIM)


def _spatial_gating(u, v, w_s, b_s):
    B, S, _ = v.shape
    n = S // CHUNK
    vr = v.reshape(B, n, CHUNK, G_B, C_B)
    mixed = jnp.einsum('gts,bnsgc->bntgc', w_s, vr) + b_s.T[None, None, :, :, None].astype(v.dtype)
    return u * mixed.reshape(B, S, D_B)


def _mixer(h, w_in, g_q_a, w_q_b, g_kv_a, w_kv_b, g_sgu, w_spatial, b_spatial, g_out_a, g_out_b, w_out):
    B, S, _ = h.shape
    z = h @ w_in
    q_a, kv_a, k_r, u, v = jnp.split(z, IN_SPLITS, axis=-1)
    q = (_rmsnorm(q_a, g_q_a) @ w_q_b).reshape(B, S, N_HEADS_A, QK_NOPE + QK_ROPE)
    q_nope, q_rope = q[..., :QK_NOPE], q[..., QK_NOPE:]
    kv = (_rmsnorm(kv_a, g_kv_a) @ w_kv_b).reshape(B, S, N_HEADS_A, QK_NOPE + V_DIM)
    k_nope, val = kv[..., :QK_NOPE], kv[..., QK_NOPE:]
    pos = jnp.arange(S, dtype=jnp.float32)
    inv_freq = ROPE_THETA ** (-jnp.arange(0, QK_ROPE, 2, dtype=jnp.float32) / QK_ROPE)
    ang = pos[:, None] * inv_freq[None, :]
    cos, sin = jnp.cos(ang), jnp.sin(ang)
    q_rope = _rope(q_rope, cos[:, None, :], sin[:, None, :])
    k_rope = _rope(k_r, cos, sin)
    attn = _mla_attention(q_nope, q_rope, k_nope, k_rope, val)
    sgu = _spatial_gating(jax.nn.gelu(u), _rmsnorm(jax.nn.gelu(v), g_sgu), w_spatial, b_spatial)
    merged = jnp.concatenate([_rmsnorm(attn, g_out_a), _rmsnorm(sgu, g_out_b)], axis=-1)
    return merged @ w_out


def _trunk(x, c, params):
    (w_mod, b_mod, g_pre_mix, g_post_mix, g_pre_ffn, g_post_ffn, w_in, g_q_a, w_q_b, g_kv_a, w_kv_b,
     g_sgu, w_spatial, b_spatial, g_out_a, g_out_b, w_out, w_gate, w_up, w_down) = params
    cs = jax.nn.silu(c)
    for l in range(DEPTH):
        mod = (cs @ w_mod[l] + b_mod[l])[:, None, :]
        sh1, sc1, ga1, sh2, sc2, ga2 = jnp.split(mod, N_MOD, axis=-1)
        h = _rmsnorm(x, g_pre_mix[l]) * (1 + sc1) + sh1
        m = _mixer(h, w_in[l], g_q_a[l], w_q_b[l], g_kv_a[l], w_kv_b[l], g_sgu[l], w_spatial[l], b_spatial[l],
                   g_out_a[l], g_out_b[l], w_out[l])
        x = x + ga1 * _rmsnorm(m, g_post_mix[l])
        h = _rmsnorm(x, g_pre_ffn[l]) * (1 + sc2) + sh2
        f = (jax.nn.silu(h @ w_gate[l]) * (h @ w_up[l])) @ w_down[l]
        x = x + ga2 * _rmsnorm(f, g_post_ffn[l])
    return x


def setup_inputs(seed: int = 0) -> dict:
    key = jax.random.key(seed)
    ks = jax.random.split(key, 32)
    f32 = jnp.float32

    def nrm(k, shape, scale):
        return jax.random.normal(k, shape, f32) * scale

    def gain(k, shape):
        return 1.0 + 0.02 * jax.random.normal(k, shape, f32)

    L = DEPTH
    return {
        'x_prompt': nrm(ks[0], (BATCH, SEQ, D_MODEL), 1.0),
        'x_sample': nrm(ks[1], (DEC_BATCH, DEC_SEQ, D_MODEL), 1.0),
        'c_prompt': nrm(ks[2], (BATCH, D_MODEL), 1.0),
        'c_sample': nrm(ks[3], (DEC_BATCH, D_MODEL), 1.0),
        'w_mod': nrm(ks[4], (L, D_MODEL, N_MOD * D_MODEL), 0.5 * D_MODEL ** -0.5),
        'b_mod': nrm(ks[5], (L, N_MOD * D_MODEL), 0.01),
        'g_pre_mix': gain(ks[6], (L, D_MODEL)),
        'g_post_mix': gain(ks[7], (L, D_MODEL)),
        'g_pre_ffn': gain(ks[8], (L, D_MODEL)),
        'g_post_ffn': gain(ks[9], (L, D_MODEL)),
        'w_in': nrm(ks[10], (L, D_MODEL, IN_COLS), D_MODEL ** -0.5),
        'g_q_a': gain(ks[11], (L, Q_LORA)),
        'w_q_b': nrm(ks[12], (L, Q_LORA, N_HEADS_A * (QK_NOPE + QK_ROPE)), Q_LORA ** -0.5),
        'g_kv_a': gain(ks[13], (L, KV_LORA)),
        'w_kv_b': nrm(ks[14], (L, KV_LORA, N_HEADS_A * (QK_NOPE + V_DIM)), KV_LORA ** -0.5),
        'g_sgu': gain(ks[15], (L, D_B)),
        'w_spatial': nrm(ks[16], (L, G_B, CHUNK, CHUNK), CHUNK ** -0.5),
        'b_spatial': 1.0 + nrm(ks[17], (L, G_B, CHUNK), 0.01),
        'g_out_a': gain(ks[18], (L, D_A)),
        'g_out_b': gain(ks[19], (L, D_B)),
        'w_out': nrm(ks[20], (L, D_MIX, D_MODEL), D_MIX ** -0.5),
        'w_gate': nrm(ks[21], (L, D_MODEL, D_FF), D_MODEL ** -0.5),
        'w_up': nrm(ks[22], (L, D_MODEL, D_FF), D_MODEL ** -0.5),
        'w_down': nrm(ks[23], (L, D_FF, D_MODEL), D_FF ** -0.5),
    }


def reference(x_prompt, x_sample, c_prompt, c_sample, w_mod, b_mod, g_pre_mix, g_post_mix, g_pre_ffn, g_post_ffn,
              w_in, g_q_a, w_q_b, g_kv_a, w_kv_b, g_sgu, w_spatial, b_spatial, g_out_a, g_out_b, w_out,
              w_gate, w_up, w_down):
    params = (w_mod, b_mod, g_pre_mix, g_post_mix, g_pre_ffn, g_post_ffn, w_in, g_q_a, w_q_b, g_kv_a, w_kv_b,
              g_sgu, w_spatial, b_spatial, g_out_a, g_out_b, w_out, w_gate, w_up, w_down)
    y_prompt = _trunk(x_prompt, c_prompt, params)
    y_sample = _trunk(x_sample, c_sample, params)
    return (y_prompt, y_sample)
```

```cpp
#include <hip/hip_runtime.h>
#include <hip/hip_cooperative_groups.h>
#include <cstdio>
#include <cstdint>
namespace cg = cooperative_groups;
namespace pg8 {
#define PG8_LAS __attribute__((address_space(3)))
typedef unsigned short bf16_t;
typedef short bf16x8 __attribute__((ext_vector_type(8)));
typedef float f32x4 __attribute__((ext_vector_type(4)));
typedef unsigned u32x4 __attribute__((ext_vector_type(4)));
constexpr int BM = 256, BK = 64, HALF = 128, HTB = HALF * BK * 2  , STAGE_BYTES = 8 * HTB, NXCD = 8, WGM = 8;

__host__ __device__ __forceinline__ int lds_byte(int r, int c) { const int st = (r >> 4) * 2 + (c >> 5), rr = r & 15, cc = c & 31, ob = rr * 64 + cc * 2; return st * 1024 + (ob ^ (((ob >> 9) & 1) << 5)); }
__host__ __device__ __forceinline__ void stage_rc(int b, int& R, int& C) { const int st = b / 1024, sb = b % 1024, swz = sb ^ (((sb >> 9) & 1) << 5); R = (st >> 1) * 16 + swz / 64; C = (st & 1) * 32 + (swz % 64) / 2; }
__host__ __device__ __forceinline__ int perm32(int rho) { const int n = rho >> 4, i = rho & 15; return 8 * (i >> 2) + 4 * n + (i & 3); }

struct Unit { int pm, pn; };
struct Gemm { const bf16_t* A; const bf16_t* Bt; int M, N, K, lda; };

struct StaticOrder {
    int nM, nN, nwg, G, c;
    __host__ __device__ void init(int M, int N, int G_, int c_) { nM = M / BM; nN = N / BM; nwg = nM * nN; G = G_; c = c_; }
    __host__ __device__ bool next(int i, Unit& u) const {
        const long L = (long)i * G + c; if (L >= nwg) return false;
        int wgid = (int)L; { const int q = nwg / NXCD, r = nwg % NXCD, xcd = wgid % NXCD, off = wgid / NXCD; wgid = (xcd < r ? xcd * (q + 1) : r * (q + 1) + (xcd - r) * q) + off; }
        const int nig = WGM * nN, gid = wgid / nig, fm = gid * WGM, gsz = (nM - fm) < WGM ? (nM - fm) : WGM;
        u.pm = fm + ((wgid % nig) % gsz); u.pn = (wgid % nig) / gsz; return true;
    }
    __device__ __forceinline__ void a_ready(const Unit&) const {}
    __device__ __forceinline__ void done(const Unit&) const {}
};

__device__ __forceinline__ unsigned cvt_pk_bf16(float lo, float hi) { unsigned r; asm volatile("v_cvt_pk_bf16_f32 %0, %1, %2" : "=v"(r) : "v"(lo), "v"(hi)); return r; }
typedef float f32x2 __attribute__((ext_vector_type(2)));
template <class Epi, class Sched, bool ALIGN_EPI = false, bool SP2 = false>
__device__ __forceinline__ void gemm_phase(PG8_LAS unsigned char* lds, const Gemm g, const Sched& S, const Epi& E, const int wv  ) {
    int tid0_ = wv * 64 + (int)__builtin_amdgcn_mbcnt_hi(~0u, __builtin_amdgcn_mbcnt_lo(~0u, 0u)); asm volatile("" : "+v"(tid0_));
    const int tid = tid0_, wid = __builtin_amdgcn_readfirstlane(tid >> 6), lane = tid & 63, wr = wid >> 2, wc = wid & 3, fr = lane & 15, fq = lane >> 4;
    const int K = g.K, nt = K / BK;
    unsigned voffA[2], voffB[2];
#pragma unroll
    for (int i = 0; i < 2; ++i) { int R, C; stage_rc(tid * 16 + i * 8192, R, C); const int Rb = Epi::PERM ? ((R & ~31) + perm32(R & 31)) : R;
        voffA[i] = (unsigned)(R * g.lda + C) * 2u; voffB[i] = (unsigned)(Rb * K + C) * 2u; }
    const size_t kstep = (size_t)(BK * 2);
    const size_t hstepB = (size_t)HALF * K * 2, hstepA = (size_t)HALF * g.lda * 2;
    const size_t tstepB = 2 * hstepB, tstepA = 2 * hstepA;
    const unsigned ldsw = (unsigned)wid * 1024u;
    const int aoff = lds_byte(wr * 64 + fr, fq * 8), boff = lds_byte(wc * 32 + fr, fq * 8);
#define PG8_SA(b, h) (((b) * 2 + (h)) * HTB)
#define PG8_SB(b, h) ((4 + (b) * 2 + (h)) * HTB)
#define PG8_STAGE(bufoff, gbase, voff) do { _Pragma("unroll") for (int _i = 0; _i < 2; ++_i) \
        __builtin_amdgcn_global_load_lds((const unsigned*)((const char*)(gbase) + (voff)[_i]), (PG8_LAS unsigned*)(lds + (bufoff) + ldsw + _i * 8192), 16, 0, 0); } while (0)
#define PG8_LDA(dst, b, h) do { _Pragma("unroll") for (int m = 0; m < 4; ++m) _Pragma("unroll") for (int k = 0; k < 2; ++k) dst[m][k] = *(const PG8_LAS bf16x8*)(lds + PG8_SA(b, h) + aoff + m * 2048 + k * 1024); } while (0)
#define PG8_LDB(dst, b, h) do { _Pragma("unroll") for (int n = 0; n < 2; ++n) _Pragma("unroll") for (int k = 0; k < 2; ++k) dst[n][k] = *(const PG8_LAS bf16x8*)(lds + PG8_SB(b, h) + boff + n * 2048 + k * 1024); } while (0)
#define PG8_MMA(ai, bj, At, Bt) do { __builtin_amdgcn_s_setprio(1); _Pragma("unroll") for (int m = 0; m < 4; ++m) _Pragma("unroll") for (int n = 0; n < 2; ++n) _Pragma("unroll") for (int k = 0; k < 2; ++k) \
        acc[ai][bj][m][n] = __builtin_amdgcn_mfma_f32_16x16x32_bf16(Bt[n][k], At[m][k], acc[ai][bj][m][n], 0, 0, 0); __builtin_amdgcn_s_setprio(0); } while (0)
#define PG8_WAIT_V(n) asm volatile("s_waitcnt vmcnt(" #n ")" ::: "memory")
#define PG8_WAIT_L(n) asm volatile("s_waitcnt lgkmcnt(" #n ")" ::: "memory")
#define PG8_BAR __builtin_amdgcn_s_barrier()
#define PG8_SCHED __builtin_amdgcn_sched_barrier(0)
    Unit cur, nxt; int ui = 0;
    if (!S.next(0, cur)) return;
    f32x4 acc[2][2][4][2];
#pragma unroll
    for (int a = 0; a < 2; ++a)
#pragma unroll
        for (int b = 0; b < 2; ++b)
#pragma unroll
            for (int m = 0; m < 4; ++m)
#pragma unroll
                for (int n = 0; n < 2; ++n) acc[a][b][m][n] = (f32x4){0.f, 0.f, 0.f, 0.f};
    bf16x8 At[4][2], B0[2][2], B1[2][2];
    const char* cA = (const char*)g.A + (size_t)cur.pm * tstepA; const char* cB = (const char*)g.Bt + (size_t)cur.pn * tstepB;
    S.a_ready(cur);
    if constexpr (SP2) {
        PG8_STAGE(PG8_SB(0, 0), cB, voffB); PG8_STAGE(PG8_SB(0, 1), cB + hstepB, voffB); PG8_STAGE(PG8_SA(0, 0), cA, voffA); PG8_STAGE(PG8_SA(0, 1), cA + hstepA, voffA);
        if (wr == 1) PG8_BAR;
        PG8_WAIT_V(2); PG8_BAR;
        PG8_STAGE(PG8_SB(1, 0), cB + kstep, voffB); PG8_STAGE(PG8_SA(1, 0), cA + kstep, voffA); PG8_STAGE(PG8_SB(1, 1), cB + hstepB + kstep, voffB);
        PG8_WAIT_V(6); PG8_BAR;
    } else {
        PG8_STAGE(PG8_SB(0, 0), cB, voffB); PG8_STAGE(PG8_SA(0, 0), cA, voffA); PG8_STAGE(PG8_SB(0, 1), cB + hstepB, voffB); PG8_STAGE(PG8_SA(0, 1), cA + hstepA, voffA);
        if (wr == 1) PG8_BAR;
        PG8_WAIT_V(4); PG8_BAR;
        PG8_STAGE(PG8_SB(1, 0), cB + kstep, voffB); PG8_STAGE(PG8_SA(1, 0), cA + kstep, voffA); PG8_STAGE(PG8_SB(1, 1), cB + hstepB + kstep, voffB);
        PG8_WAIT_V(6); PG8_BAR;
    }
    for (;;) {
        const bool has_next = S.next(ui + 1, nxt);
        const char* nA = has_next ? (const char*)g.A + (size_t)nxt.pm * tstepA : cA; const char* nB = has_next ? (const char*)g.Bt + (size_t)nxt.pn * tstepB : cB;
#pragma unroll 1
        for (int t = 0; t < nt; t += 2) {
            const bool last = (t == nt - 2);
            if constexpr (Epi::MIDK) { if (t == 8) E.midk(acc, cur, wr, fr); }
            const char* a1 = cA + (size_t)(t + 1) * kstep;
            const char* a2 = last ? nA : cA + (size_t)(t + 2) * kstep; const char* b2 = last ? nB : cB + (size_t)(t + 2) * kstep;
            const char* a3 = a2 + kstep; const char* b3 = b2 + kstep;
            if (last && has_next) S.a_ready(nxt);
            if constexpr (SP2) {
            PG8_LDB(B0, 0, 0); PG8_LDB(B1, 0, 1); PG8_SCHED; PG8_LDA(At, 0, 0); PG8_STAGE(PG8_SA(1, 1), a1 + hstepA, voffA);
            PG8_WAIT_V(8); PG8_WAIT_L(0); PG8_BAR; PG8_MMA(0, 0, At, B0); PG8_MMA(0, 1, At, B1); PG8_BAR; PG8_SCHED;
            PG8_LDA(At, 0, 1); PG8_STAGE(PG8_SB(0, 0), b2, voffB); PG8_STAGE(PG8_SB(0, 1), b2 + hstepB, voffB); PG8_STAGE(PG8_SA(0, 0), a2, voffA);
            PG8_WAIT_V(8); PG8_WAIT_L(0); PG8_BAR; PG8_MMA(1, 0, At, B0); PG8_MMA(1, 1, At, B1); PG8_BAR; PG8_SCHED;
            PG8_LDB(B0, 1, 0); PG8_LDB(B1, 1, 1); PG8_SCHED; PG8_LDA(At, 1, 0); PG8_STAGE(PG8_SA(0, 1), a2 + hstepA, voffA);
            PG8_WAIT_V(8); PG8_WAIT_L(0); PG8_BAR; PG8_MMA(0, 0, At, B0); PG8_MMA(0, 1, At, B1); PG8_BAR; PG8_SCHED;
            PG8_LDA(At, 1, 1); PG8_STAGE(PG8_SB(1, 0), b3, voffB); PG8_STAGE(PG8_SB(1, 1), b3 + hstepB, voffB); PG8_STAGE(PG8_SA(1, 0), a3, voffA);
            PG8_WAIT_V(8); PG8_WAIT_L(0); PG8_BAR; PG8_MMA(1, 0, At, B0); PG8_MMA(1, 1, At, B1); PG8_BAR; PG8_SCHED;
            } else {
            PG8_LDB(B0, 0, 0); PG8_SCHED; PG8_LDA(At, 0, 0); PG8_STAGE(PG8_SA(1, 1), a1 + hstepA, voffA);
            PG8_WAIT_L(8); PG8_BAR; PG8_WAIT_L(0); PG8_MMA(0, 0, At, B0); PG8_BAR; PG8_SCHED;
            PG8_LDB(B1, 0, 1); PG8_STAGE(PG8_SB(0, 0), b2, voffB);
            PG8_BAR; PG8_WAIT_L(0); PG8_MMA(0, 1, At, B1); PG8_BAR;
            PG8_LDA(At, 0, 1); PG8_STAGE(PG8_SA(0, 0), a2, voffA);
            PG8_BAR; PG8_WAIT_L(0); PG8_MMA(1, 0, At, B0); PG8_BAR; PG8_SCHED;
            PG8_STAGE(PG8_SB(0, 1), b2 + hstepB, voffB);
            PG8_WAIT_V(6); PG8_BAR; PG8_MMA(1, 1, At, B1); PG8_BAR;
            PG8_LDB(B0, 1, 0); PG8_SCHED; PG8_LDA(At, 1, 0); PG8_STAGE(PG8_SA(0, 1), a2 + hstepA, voffA);
            PG8_WAIT_L(8); PG8_BAR; PG8_WAIT_L(0); PG8_MMA(0, 0, At, B0); PG8_BAR; PG8_SCHED;
            PG8_LDB(B1, 1, 1); PG8_STAGE(PG8_SB(1, 0), b3, voffB);
            PG8_BAR; PG8_WAIT_L(0); PG8_MMA(0, 1, At, B1); PG8_BAR;
            PG8_LDA(At, 1, 1); PG8_STAGE(PG8_SA(1, 0), a3, voffA);
            PG8_BAR; PG8_WAIT_L(0); PG8_MMA(1, 0, At, B0); PG8_BAR; PG8_SCHED;
            PG8_STAGE(PG8_SB(1, 1), b3 + hstepB, voffB);
            PG8_WAIT_V(6); PG8_BAR; PG8_MMA(1, 1, At, B1); PG8_BAR;
            }
        }
        if constexpr (ALIGN_EPI) { if (wr == 0) PG8_BAR; }
        if constexpr (!Epi::AFTER_DRAIN) { E(acc, cur, wr, wc, fr, fq); S.done(cur); }
        if (!has_next) break;
#pragma unroll
        for (int a = 0; a < 2; ++a)
#pragma unroll
            for (int b = 0; b < 2; ++b)
#pragma unroll
                for (int m = 0; m < 4; ++m)
#pragma unroll
                    for (int n = 0; n < 2; ++n) acc[a][b][m][n] = (f32x4){0.f, 0.f, 0.f, 0.f};
        cur = nxt; cA = nA; cB = nB; ++ui;
        if constexpr (ALIGN_EPI) { if (wr == 1) PG8_BAR; }
    }
    PG8_WAIT_V(0);
    if constexpr (!ALIGN_EPI) { if (wr == 0) PG8_BAR; }
    PG8_BAR;
    if constexpr (Epi::AFTER_DRAIN) { E.fused(acc, cur, wr, wc, fr, fq, lds, wid, lane); S.done(cur); }
#undef PG8_SA
#undef PG8_SB
#undef PG8_STAGE
#undef PG8_LDA
#undef PG8_LDB
#undef PG8_MMA
#undef PG8_WAIT_V
#undef PG8_WAIT_L
#undef PG8_BAR
#undef PG8_SCHED
}
}

#define LAS __attribute__((address_space(3)))
using pg8::bf16_t; using pg8::bf16x8; using pg8::f32x4; using pg8::u32x4;
typedef float f32x16 __attribute__((ext_vector_type(16)));
typedef float f32x2v __attribute__((ext_vector_type(2)));
typedef __bf16 bf16x2v __attribute__((ext_vector_type(2)));
typedef unsigned u32x2 __attribute__((ext_vector_type(2)));

constexpr int T = 32768, TP = 16384, DM = 1024, NLAYER = 2, NCR = 10, NMODC = 6144;
constexpr int INC = 1696, LZ = 1728, ZQ = 0, ZKV = 384, ZKR = 640, ZU = 704, ZV = 1216, ZATT = 192, NIN = 1792;
constexpr int DFF = 2816, NGU = 5632;
constexpr float EPS = 1e-6f;
constexpr float QSCALE = 0.10206207261596577f * 1.4426950408889634f;
constexpr size_t MiB = 1u << 20;
constexpr size_t WS_MOD = 512 * 1024, WS_ROPE = 1 * MiB, WS_SSQ = 2 * MiB, WS_W = 3 * MiB;
constexpr size_t OW_IN = 0, OW_QB = 3670016, OW_KVB = 4259840, OW_OUT = 4784128, OW_GU = 6881280, OW_D = 18415616, OW_S = 24182784, WL = 24444928;
constexpr size_t WS_H = 50 * MiB, WS_Z = 114 * MiB, WS_VT = 222 * MiB, WS_END = 254 * MiB;
static_assert(WS_Z + (size_t)32768 * LZ * 2 <= WS_VT, "z fits");
static_assert(WS_W + 2 * WL <= WS_H, "weights fit");
constexpr int LDS_BYTES = 147456;

struct Args { const float* in[24]; float* out; unsigned char* ws; };
constexpr int TAB_OFF = LDS_BYTES - 256;
typedef const float* cfptr;
#define GAS __attribute__((address_space(1)))
#define EB(xo) ((bf16_t*)((unsigned char*)(xo) + 2048))
#define INP(k) ((const float*)(ws + ((LAS long long*)(lds + TAB_OFF))[k]))

__device__ __forceinline__ float bf_lo(unsigned w) { return __uint_as_float(w << 16); }
__device__ __forceinline__ float bf_hi(unsigned w) { return __uint_as_float(w & 0xffff0000u); }
__device__ __forceinline__ unsigned pk2(float lo, float hi) { f32x2v v = {lo, hi}; bf16x2v b = __builtin_convertvector(v, bf16x2v); return __builtin_bit_cast(unsigned, b); }
__device__ __forceinline__ float wave_sum(float v) {
#pragma unroll
    for (int o = 1; o < 64; o <<= 1) v += __shfl_xor(v, o);
    return v;
}
__device__ __forceinline__ float gelu_tanh(float x) {
    const float u = 0.7978845608028654f * (x + 0.044715f * x * x * x);
    const float e = __builtin_amdgcn_exp2f(-2.8853900817779268f * u);
    return x * __builtin_amdgcn_rcpf(1.0f + e);
}
__device__ __forceinline__ float silu_f(float x) { return x * __builtin_amdgcn_rcpf(1.0f + __builtin_amdgcn_exp2f(-1.4426950408889634f * x)); }
__device__ __forceinline__ int tok_pos(int row) { return row < TP ? (row & 8191) : (row & 2047); }
__device__ __forceinline__ int tok_cr(int row) { return row < TP ? (row >> 13) : 2 + ((row - TP) >> 11); }

namespace pg8 {
template <bool MK> struct EpiStore {
    static constexpr bool PERM = true, AFTER_DRAIN = false, MIDK = MK;
    bf16_t* O; int ldc; int ncols; const float* ssq;
    __device__ __forceinline__ void operator()(const f32x4 (&acc)[2][2][4][2], const Unit& u, int wr, int wc, int fr, int fq) const {
        const int row0 = u.pm * BM + wr * 64 + fr, col0 = u.pn * BM + wc * 32 + 8 * fq;
#pragma unroll
        for (int ai = 0; ai < 2; ++ai)
#pragma unroll
            for (int m = 0; m < 4; ++m) { bf16_t* rowp = O + (size_t)(row0 + ai * HALF + m * 16) * ldc + col0;
#pragma unroll
                for (int bj = 0; bj < 2; ++bj) if (col0 + bj * HALF < ncols) { const f32x4 v0 = acc[ai][bj][m][0], v1 = acc[ai][bj][m][1];
                    u32x4 w; w.x = pk2(v0[0], v0[1]); w.y = pk2(v0[2], v0[3]); w.z = pk2(v1[0], v1[1]); w.w = pk2(v1[2], v1[3]);
                    *(u32x4*)(rowp + bj * HALF) = w; } }
    }
    __device__ __forceinline__ void midk(f32x4 (&acc)[2][2][4][2], const Unit& u, int wr, int fr) const {
#pragma unroll
        for (int ai = 0; ai < 2; ++ai)
#pragma unroll
            for (int m = 0; m < 4; ++m) { int row = u.pm * BM + ai * HALF + wr * 64 + m * 16 + fr; asm volatile("" : "+v"(row) :: "memory"); const f32x4* p = (const f32x4*)(ssq + (size_t)row * 8);
                const f32x4 s0 = p[0], s1 = p[1]; const float s = ((s0[0] + s0[1]) + (s0[2] + s0[3])) + ((s1[0] + s1[1]) + (s1[2] + s1[3]));
                const float rs = rsqrtf(s * (1.0f / 512.0f) + EPS);
#pragma unroll
                for (int bj = 0; bj < 2; ++bj)
#pragma unroll
                    for (int n = 0; n < 2; ++n) acc[ai][bj][m][n] *= rs; }
    }
};
struct EpiQ {
    static constexpr bool PERM = false, AFTER_DRAIN = false, MIDK = false;
    bf16_t* Q; const float* rope; const float* rstd;
    __device__ __forceinline__ void midk(f32x4 (&)[2][2][4][2], const Unit&, int, int) const {}
    __device__ __forceinline__ void operator()(const f32x4 (&acc)[2][2][4][2], const Unit& u, int wr, int wc, int fr, int fq) const {
        const int G0 = 8 * u.pn + wc, part0 = G0 % 3, part1 = (G0 + 4) % 3;
#pragma unroll
        for (int ai = 0; ai < 2; ++ai)
#pragma unroll
            for (int m = 0; m < 4; ++m) { int row = u.pm * BM + ai * HALF + wr * 64 + m * 16 + fr; asm volatile("" : "+v"(row)); bf16_t* rp = Q + (size_t)row * 768 + 32 * G0 + 4 * fq;
                const float rs = rstd[row] * QSCALE;
                f32x4 cs = {1.f, 1.f, 1.f, 1.f}, sn = {0.f, 0.f, 0.f, 0.f};
                if (part0 == 2 || part1 == 2) { const f32x4* t = (const f32x4*)(rope + ((size_t)tok_pos(row) * 16 + 4 * fq) * 2); const f32x4 c0 = t[0], c1 = t[1];
                    cs = (f32x4){c0[0], c0[2], c1[0], c1[2]}; sn = (f32x4){c0[1], c0[3], c1[1], c1[3]}; }
#pragma unroll
                for (int bj = 0; bj < 2; ++bj) { const bool rp2 = (bj == 0 ? part0 : part1) == 2;
                    f32x4 x1 = acc[ai][bj][m][0] * rs, x2 = acc[ai][bj][m][1] * rs;
                    if (rp2) { const f32x4 o1 = x1 * cs - x2 * sn, o2 = x1 * sn + x2 * cs; x1 = o1; x2 = o2; }
                    u32x2 w1, w2; w1.x = pk2(x1[0], x1[1]); w1.y = pk2(x1[2], x1[3]); w2.x = pk2(x2[0], x2[1]); w2.y = pk2(x2[2], x2[3]);
                    *(u32x2*)(rp + 128 * bj) = w1; *(u32x2*)(rp + 128 * bj + 16) = w2; }
                asm volatile("" ::: "memory"); }
    }
};
struct EpiKV {
    static constexpr bool PERM = true, AFTER_DRAIN = false, MIDK = false;
    bf16_t* kn; bf16_t* vt; const float* rstd;
    __device__ __forceinline__ void midk(f32x4 (&)[2][2][4][2], const Unit&, int, int) const {}
    __device__ __forceinline__ void operator()(const f32x4 (&acc)[2][2][4][2], const Unit& u, int wr, int wc, int fr, int fq) const {
        const int sfr = (fr & 3) | ((fr & 4) << 1) | ((fr & 8) >> 1); const int within = 32 * wc + 8 * fq;
#pragma unroll
        for (int ai = 0; ai < 2; ++ai)
#pragma unroll
            for (int m = 0; m < 4; ++m) { int row = u.pm * BM + ai * HALF + wr * 64 + m * 16 + fr; asm volatile("" : "+v"(row)); const float rs = rstd[row];
#pragma unroll
                for (int bj = 0; bj < 2; ++bj) { const int head = 2 * u.pn + bj;
                    const f32x4 v0 = acc[ai][bj][m][0] * rs, v1 = acc[ai][bj][m][1] * rs;
                    u32x4 w; w.x = pk2(v0[0], v0[1]); w.y = pk2(v0[2], v0[3]); w.z = pk2(v1[0], v1[1]); w.w = pk2(v1[2], v1[3]);
                    if (wc < 2) { *(u32x4*)(kn + (size_t)row * LZ + head * 64 + within) = w; }
                    else {
                        const int q = fr & 3;
#define SELW(i) ((i) == 0 ? w.x : (i) == 1 ? w.y : (i) == 2 ? w.z : w.w)
                        const unsigned own = SELW(q), s1 = SELW(q ^ 1), s2 = SELW(q ^ 2), s3 = SELW(q ^ 3);
#undef SELW
                        const unsigned r1 = (unsigned)__builtin_amdgcn_update_dpp(0, (int)s1, 0xB1, 0xf, 0xf, false);
                        const unsigned r2 = (unsigned)__builtin_amdgcn_update_dpp(0, (int)s2, 0x4E, 0xf, 0xf, false);
                        const unsigned r3 = (unsigned)__builtin_amdgcn_update_dpp(0, (int)s3, 0x1B, 0xf, 0xf, false);
#define TOK(j) ((j) == q ? own : (j) == (q ^ 1) ? r1 : (j) == (q ^ 2) ? r2 : r3)
                        const unsigned t0 = TOK(0), t1 = TOK(1), t2 = TOK(2), t3 = TOK(3);
#undef TOK
                        u32x2 lo, hi2; lo.x = __builtin_amdgcn_perm(t1, t0, 0x05040100u); lo.y = __builtin_amdgcn_perm(t3, t2, 0x05040100u);
                        hi2.x = __builtin_amdgcn_perm(t1, t0, 0x07060302u); hi2.y = __builtin_amdgcn_perm(t3, t2, 0x07060302u);
                        bf16_t* vp = vt + (size_t)(head * 64 + within - 64 + 2 * q) * T + ((row & ~15) | (sfr & ~3));
                        *(u32x2*)vp = lo; *(u32x2*)(vp + (size_t)T) = hi2; } }
                asm volatile("" ::: "memory"); }
    }
};
struct EpiGU {
    static constexpr bool PERM = true, AFTER_DRAIN = false, MIDK = false;
    bf16_t* O;
    __device__ __forceinline__ void midk(f32x4 (&)[2][2][4][2], const Unit&, int, int) const {}
    __device__ __forceinline__ void operator()(const f32x4 (&acc)[2][2][4][2], const Unit& u, int wr, int wc, int fr, int fq) const {
        const int col = 128 * u.pn + 32 * wc + 8 * fq;
#pragma unroll
        for (int ai = 0; ai < 2; ++ai)
#pragma unroll
            for (int m = 0; m < 4; ++m) { const int row = u.pm * BM + ai * HALF + wr * 64 + m * 16 + fr;
                const f32x4 g0 = acc[ai][0][m][0], g1 = acc[ai][0][m][1], u0 = acc[ai][1][m][0], u1 = acc[ai][1][m][1];
                u32x4 w; w.x = pk2(silu_f(g0[0]) * u0[0], silu_f(g0[1]) * u0[1]); w.y = pk2(silu_f(g0[2]) * u0[2], silu_f(g0[3]) * u0[3]);
                w.z = pk2(silu_f(g1[0]) * u1[0], silu_f(g1[1]) * u1[1]); w.w = pk2(silu_f(g1[2]) * u1[2], silu_f(g1[3]) * u1[3]);
                *(u32x4*)(O + (size_t)row * DFF + col) = w; }
    }
};
}

__device__ __forceinline__ int rowmap(int mode, int n) { return mode == 0 ? n : mode == 3 ? (n < 672 ? n : n + 32) : (((n >> 7) << 8) + (n & 127) + (mode == 2 ? 128 : 0)); }
__device__ __forceinline__ void transpose_item(const float* W, int K, int N, bf16_t* WT, int mode, const float* gain, LAS float* scr, int item, int lane) {
    const int nblk = N / 32, kb = item / nblk, nb = item % nblk, k0 = 64 * kb, n0 = 32 * nb;
    { const int kq = lane >> 3, nq = lane & 7;
      f32x4 v[8];
#pragma unroll
      for (int i = 0; i < 8; ++i) v[i] = *(const f32x4*)(W + (size_t)(k0 + 8 * i + kq) * N + n0 + 4 * nq);
#pragma unroll
      for (int i = 0; i < 8; ++i) { const int kk = 8 * i + kq; const float gk = gain ? gain[k0 + kk] : 1.0f;
#pragma unroll
          for (int e = 0; e < 4; ++e) scr[kk * 33 + 4 * nq + e] = v[i][e] * gk; } }
    asm volatile("s_waitcnt lgkmcnt(0)" ::: "memory");
    const int c = lane & 7;
#pragma unroll
    for (int j = 0; j < 4; ++j) { const int n = (lane >> 3) + 8 * j; const LAS float* s = scr + (8 * c) * 33 + n;
        u32x4 o; o.x = pk2(s[0 * 33], s[1 * 33]); o.y = pk2(s[2 * 33], s[3 * 33]); o.z = pk2(s[4 * 33], s[5 * 33]); o.w = pk2(s[6 * 33], s[7 * 33]);
        *(u32x4*)(WT + (size_t)rowmap(mode, n0 + n) * K + k0 + 8 * c) = o; }
    asm volatile("s_waitcnt lgkmcnt(0)" ::: "memory");
}

constexpr int WT_I_IN = 16 * 53, WT_I_QB = 6 * 24, WT_I_KVB = 4 * 32, WT_I_OUT = 16 * 32, WT_I_G = 16 * 88, WT_I_D = 44 * 32;
constexpr int WT_NITEMS = WT_I_IN + WT_I_QB + WT_I_KVB + WT_I_OUT + 2 * WT_I_G + WT_I_D;
__device__ __forceinline__ void wt_convert(unsigned char* ws, LAS unsigned char* lds, int l, int it0, int it1, int rank, int nwk, int tid, int lane, int wid) {
    unsigned char* wb = ws + WS_W + (size_t)l * WL;
    if (it0 == 0) {
        const int gtid = rank * 512 + tid, NT = nwk * 512;
        for (int j = gtid; j < 65536; j += NT) { const float* s = INP(16) + (size_t)l * 131072 + 2 * j; ((unsigned*)(wb + OW_S))[j] = pk2(s[0], s[1]); }
        for (int j = gtid; j < 12288; j += NT) { const int r = j >> 7, dr = r < 32 ? 672 + r : 1728 + (r - 32);
            ((u32x4*)(wb + OW_IN))[(size_t)dr * 128 + (j & 127)] = (u32x4){0u, 0u, 0u, 0u}; }
    }
    LAS float* scr = (LAS float*)(lds + 65536) + wid * (64 * 33);
    for (int it = it0 + rank * 8 + wid; it < it1; it += nwk * 8) {
        int r = it;
        if (r < WT_I_IN) { transpose_item(INP(10) + (size_t)l * 1024 * INC, 1024, INC, (bf16_t*)(wb + OW_IN), 3, nullptr, scr, r, lane); continue; } r -= WT_I_IN;
        if (r < WT_I_QB) { transpose_item(INP(12) + (size_t)l * 384 * 768, 384, 768, (bf16_t*)(wb + OW_QB), 0, INP(11) + l * 384, scr, r, lane); continue; } r -= WT_I_QB;
        if (r < WT_I_KVB) { transpose_item(INP(14) + (size_t)l * 256 * 1024, 256, 1024, (bf16_t*)(wb + OW_KVB), 0, INP(13) + l * 256, scr, r, lane); continue; } r -= WT_I_KVB;
        if (r < WT_I_OUT) { const int kb = r / 32; transpose_item(INP(20) + (size_t)l * 1024 * 1024, 1024, 1024, (bf16_t*)(wb + OW_OUT), 0, kb < 8 ? INP(18) + l * 512 : INP(19) + l * 512 - 512, scr, r, lane); continue; } r -= WT_I_OUT;
        if (r < WT_I_G) { transpose_item(INP(21) + (size_t)l * 1024 * DFF, 1024, DFF, (bf16_t*)(wb + OW_GU), 1, nullptr, scr, r, lane); continue; } r -= WT_I_G;
        if (r < WT_I_G) { transpose_item(INP(22) + (size_t)l * 1024 * DFF, 1024, DFF, (bf16_t*)(wb + OW_GU), 2, nullptr, scr, r, lane); continue; } r -= WT_I_G;
        transpose_item(INP(23) + (size_t)l * DFF * 1024, DFF, 1024, (bf16_t*)(wb + OW_D), 0, nullptr, scr, r, lane);
    }
}

__device__ __forceinline__ void p0_phase(unsigned char* ws, LAS unsigned char* lds, const int wv) {
    int tid = wv * 64 + (int)__builtin_amdgcn_mbcnt_hi(~0u, __builtin_amdgcn_mbcnt_lo(~0u, 0u)); asm volatile("" : "+v"(tid)); const int lane = tid & 63, wid = wv;
    const int G = gridDim.x;
    {
        LAS float* cs = (LAS float*)lds; LAS float* red = cs + NCR * 1024;
        float* mod = (float*)(ws + WS_MOD);
        for (int bg = blockIdx.x; bg < 192; bg += G) {
            for (int t = tid; t < NCR * 1024; t += 512) { const int cr = t >> 10, k = t & 1023; const float c = cr < 2 ? INP(2)[cr * 1024 + k] : INP(3)[(cr - 2) * 1024 + k]; cs[t] = silu_f(c); }
            __syncthreads();
            const int l = bg / 96, cb = (bg % 96) * 64;
            const int cg4 = lane & 15, kq = lane >> 4;
            const float* wm = INP(4) + (size_t)l * 1024 * NMODC + cb + 4 * cg4;
            f32x4 acc[NCR];
#pragma unroll
            for (int cr = 0; cr < NCR; ++cr) acc[cr] = (f32x4){0.f, 0.f, 0.f, 0.f};
#pragma unroll 8
            for (int kk = 0; kk < 32; ++kk) { const int k = wid * 128 + 4 * kk + kq; const f32x4 w = *(const f32x4*)(wm + (size_t)k * NMODC);
#pragma unroll
                for (int cr = 0; cr < NCR; ++cr) acc[cr] += w * cs[cr * 1024 + k]; }
#pragma unroll
            for (int cr = 0; cr < NCR; ++cr) {
#pragma unroll
                for (int e = 0; e < 4; ++e) { float s = acc[cr][e]; s += __shfl_xor(s, 16); s += __shfl_xor(s, 32); acc[cr][e] = s; }
                if (kq == 0) *(LAS f32x4*)(red + (wid * NCR + cr) * 64 + 4 * cg4) = acc[cr]; }
            __syncthreads();
            for (int t = tid; t < NCR * 64; t += 512) { const int cr = t >> 6, ln = t & 63; float s = 0.f;
#pragma unroll
                for (int w = 0; w < 8; ++w) s += red[(w * NCR + cr) * 64 + ln];
                mod[(size_t)(l * NCR + cr) * NMODC + cb + ln] = s + INP(5)[l * NMODC + cb + ln]; }
            __syncthreads();
        }
    }
    const int gtid = blockIdx.x * 512 + tid, NT = G * 512;
    {
        float* rope = (float*)(ws + WS_ROPE);
        for (int idx = gtid; idx < 8192 * 16; idx += NT) { const int pos = idx >> 4, i = idx & 15;
            const float inv = exp2f(-(float)i * 0.8304820237218406f);
            const float ang = (float)pos * inv;
            double rev = (double)ang * 0.15915494309189535; rev -= __builtin_rint(rev);
            const float rf = (float)rev;
            rope[2 * idx] = __builtin_amdgcn_cosf(rf); rope[2 * idx + 1] = __builtin_amdgcn_sinf(rf); }
    }
    wt_convert(ws, lds, 0, 0, WT_NITEMS, blockIdx.x, G, tid, lane, wid);
    wt_convert(ws, lds, 1, 0, WT_NITEMS, blockIdx.x, G, tid, lane, wid);
}

struct RowArgs { const bf16_t* src; const float* xin_p; const float* xin_s; float* xout; const float* gpost; const float* ga; const float* gpre; const float* sc; const float* sh; bf16_t* hout; unsigned char* xb; int src_ld, h_ld; };
template <bool HAS_RES, bool HAS_H, bool XIN_BF, bool XOUT_BF>
__device__ __forceinline__ void row_phase(const RowArgs& ra, const int wv) {
    int tid = wv * 64 + (int)__builtin_amdgcn_mbcnt_hi(~0u, __builtin_amdgcn_mbcnt_lo(~0u, 0u)); asm volatile("" : "+v"(tid)); const int lane = tid & 63, wid = wv;
    const int gw = blockIdx.x * 8 + wid, NGW = gridDim.x * 8;
    for (int grp = gw; grp < T / 16; grp += NGW) {
        const int r0 = grp * 16, cr = tok_cr(r0);
        float A[16], B[16], S[16];
#pragma unroll
        for (int j = 0; j < 2; ++j)
#pragma unroll
            for (int q = 0; q < 2; ++q) { const int c = 512 * j + 8 * lane + 4 * q;
                if (HAS_RES) { const f32x4 g = *(const f32x4*)(ra.gpost + c), m = *(const f32x4*)(ra.ga + (size_t)cr * NMODC + c);
#pragma unroll
                    for (int e = 0; e < 4; ++e) A[8 * j + 4 * q + e] = g[e] * m[e]; }
                if (HAS_H) { const f32x4 g = *(const f32x4*)(ra.gpre + c), s1 = *(const f32x4*)(ra.sc + (size_t)cr * NMODC + c), s2 = *(const f32x4*)(ra.sh + (size_t)cr * NMODC + c);
#pragma unroll
                    for (int e = 0; e < 4; ++e) { B[8 * j + 4 * q + e] = g[e] * (1.0f + s1[e]); S[8 * j + 4 * q + e] = s2[e]; } } }
#pragma unroll 2
        for (int i = 0; i < 16; ++i) {
            const int row = r0 + i;
            float x[16];
            if constexpr (XIN_BF) {
#pragma unroll
                for (int j = 0; j < 2; ++j) { const u32x4 w = *(const u32x4*)((const bf16_t*)(ra.xb + (size_t)row * 4096) + 512 * j + 8 * lane);
                    x[8 * j + 0] = bf_lo(w.x); x[8 * j + 1] = bf_hi(w.x); x[8 * j + 2] = bf_lo(w.y); x[8 * j + 3] = bf_hi(w.y);
                    x[8 * j + 4] = bf_lo(w.z); x[8 * j + 5] = bf_hi(w.z); x[8 * j + 6] = bf_lo(w.w); x[8 * j + 7] = bf_hi(w.w); }
            } else {
                const float* xr = row < TP ? ra.xin_p + (size_t)row * DM : ra.xin_s + (size_t)(row - TP) * DM;
#pragma unroll
                for (int j = 0; j < 2; ++j)
#pragma unroll
                    for (int q = 0; q < 2; ++q) { const f32x4 v = *(const f32x4*)(xr + 512 * j + 8 * lane + 4 * q);
#pragma unroll
                        for (int e = 0; e < 4; ++e) x[8 * j + 4 * q + e] = v[e]; }
            }
            if (HAS_RES) {
                float sv[16]; float ss = 0.f;
#pragma unroll
                for (int j = 0; j < 2; ++j) { const u32x4 w = *(const u32x4*)(ra.src + (size_t)row * ra.src_ld + 512 * j + 8 * lane);
                    sv[8 * j + 0] = bf_lo(w.x); sv[8 * j + 1] = bf_hi(w.x); sv[8 * j + 2] = bf_lo(w.y); sv[8 * j + 3] = bf_hi(w.y);
                    sv[8 * j + 4] = bf_lo(w.z); sv[8 * j + 5] = bf_hi(w.z); sv[8 * j + 6] = bf_lo(w.w); sv[8 * j + 7] = bf_hi(w.w); }
#pragma unroll
                for (int e = 0; e < 16; ++e) ss += sv[e] * sv[e];
                const float rs = rsqrtf(wave_sum(ss) * (1.0f / DM) + EPS);
#pragma unroll
                for (int e = 0; e < 16; ++e) x[e] += A[e] * (sv[e] * rs);
                if constexpr (XOUT_BF) {
#pragma unroll
                    for (int j = 0; j < 2; ++j) { u32x4 w; w.x = pk2(x[8 * j], x[8 * j + 1]); w.y = pk2(x[8 * j + 2], x[8 * j + 3]); w.z = pk2(x[8 * j + 4], x[8 * j + 5]); w.w = pk2(x[8 * j + 6], x[8 * j + 7]);
                        *(u32x4*)((bf16_t*)(ra.xb + (size_t)row * 4096) + 512 * j + 8 * lane) = w; }
                } else {
#pragma unroll
                    for (int j = 0; j < 2; ++j)
#pragma unroll
                        for (int q = 0; q < 2; ++q) { const f32x4 v = {x[8 * j + 4 * q], x[8 * j + 4 * q + 1], x[8 * j + 4 * q + 2], x[8 * j + 4 * q + 3]};
                            *(f32x4*)(ra.xout + (size_t)row * DM + 512 * j + 8 * lane + 4 * q) = v; }
                }
            }
            if (HAS_H) {
                float ss = 0.f;
#pragma unroll
                for (int e = 0; e < 16; ++e) ss += x[e] * x[e];
                const float rs = rsqrtf(wave_sum(ss) * (1.0f / DM) + EPS);
#pragma unroll
                for (int j = 0; j < 2; ++j) { u32x4 w; float h[8];
#pragma unroll
                    for (int e = 0; e < 8; ++e) h[e] = x[8 * j + e] * rs * B[8 * j + e] + S[8 * j + e];
                    w.x = pk2(h[0], h[1]); w.y = pk2(h[2], h[3]); w.z = pk2(h[4], h[5]); w.w = pk2(h[6], h[7]);
                    *(u32x4*)(ra.hout + (size_t)row * ra.h_ld + 512 * j + 8 * lane) = w; }
            }
        }
    }
}

__device__ __forceinline__ void mid_phase(unsigned char* ws, int l, LAS unsigned char* lds, const int wv) {
    int tid = wv * 64 + (int)__builtin_amdgcn_mbcnt_hi(~0u, __builtin_amdgcn_mbcnt_lo(~0u, 0u)); asm volatile("" : "+v"(tid)); const int lane = tid & 63, wid = wv;
    bf16_t* z = (bf16_t*)(ws + WS_Z); bf16_t* kr = (bf16_t*)(ws + WS_H) + (size_t)T * 768;
    float* rstdq = (float*)(ws + WS_SSQ); float* rstdkv = rstdq + T;
    const float* rope = (const float*)(ws + WS_ROPE);
    const bf16_t* Wsb = (const bf16_t*)(ws + WS_W + l * WL + OW_S);
    const float* g_sgu = INP(15) + l * 512; const float* b_sp = INP(17) + l * 1024;
    LAS bf16_t* vn = (LAS bf16_t*)lds;
    LAS float* part = (LAS float*)(lds + 131072);
    LAS float* rstd_s = part + 1024;
    const int r32 = lane & 31, hi = lane >> 5;
    for (int ch = blockIdx.x; ch < T / 128; ch += gridDim.x) {
        const int R0 = ch * 128;
        float gs[8];
#pragma unroll
        for (int e = 0; e < 8; ++e) gs[e] = g_sgu[8 * lane + e];
        { const int rrow = R0 + wid * 16 + (lane >> 2), L = lane & 3;
          const u32x4 wr_ = *(const u32x4*)(z + (size_t)rrow * LZ + ZKR + 8 * L);
          const f32x4* tp = (const f32x4*)(rope + ((size_t)tok_pos(rrow) * 16 + 8 * (L & 1)) * 2);
          const f32x4 t0 = tp[0], t1 = tp[1], t2 = tp[2], t3 = tp[3];
          const float cs[8] = {t0[0], t0[2], t1[0], t1[2], t2[0], t2[2], t3[0], t3[2]}, sn[8] = {t0[1], t0[3], t1[1], t1[3], t2[1], t2[3], t3[1], t3[3]};
          float mine[8] = {bf_lo(wr_.x), bf_hi(wr_.x), bf_lo(wr_.y), bf_hi(wr_.y), bf_lo(wr_.z), bf_hi(wr_.z), bf_lo(wr_.w), bf_hi(wr_.w)}; float o[8];
#pragma unroll
          for (int e = 0; e < 8; ++e) { const float oth = __shfl_xor(mine[e], 2); o[e] = L < 2 ? (mine[e] * cs[e] - oth * sn[e]) : (oth * sn[e] + mine[e] * cs[e]); }
          u32x4 w; w.x = pk2(o[0], o[1]); w.y = pk2(o[2], o[3]); w.z = pk2(o[4], o[5]); w.w = pk2(o[6], o[7]);
          *(u32x4*)(kr + (size_t)rrow * 32 + 8 * L) = w; }
#pragma unroll 1
        for (int i0 = 0; i0 < 16; i0 += 4) {
            u32x4 wqa[4], wkva[4], wva[4];
#pragma unroll
            for (int k = 0; k < 4; ++k) { const bf16_t* zr = z + (size_t)(R0 + wid * 16 + i0 + k) * LZ;
                wqa[k] = (u32x4){0u, 0u, 0u, 0u}; wkva[k] = (u32x4){0u, 0u, 0u, 0u};
                if (lane < 48) wqa[k] = *(const u32x4*)(zr + ZQ + 8 * lane);
                if (lane < 32) wkva[k] = *(const u32x4*)(zr + ZKV + 8 * lane);
                wva[k] = *(const u32x4*)(zr + ZV + 8 * lane); }
#pragma unroll
            for (int k = 0; k < 4; ++k) {
                const int lr = wid * 16 + i0 + k, row = R0 + lr; const u32x4 wq = wqa[k], wkv = wkva[k], wv = wva[k];
                float sq = 0.f, skv = 0.f;
                { const float f0 = bf_lo(wq.x), f1 = bf_hi(wq.x), f2 = bf_lo(wq.y), f3 = bf_hi(wq.y), f4 = bf_lo(wq.z), f5 = bf_hi(wq.z), f6 = bf_lo(wq.w), f7 = bf_hi(wq.w);
                  sq = (f0 * f0 + f1 * f1) + (f2 * f2 + f3 * f3) + (f4 * f4 + f5 * f5) + (f6 * f6 + f7 * f7); }
                { const float f0 = bf_lo(wkv.x), f1 = bf_hi(wkv.x), f2 = bf_lo(wkv.y), f3 = bf_hi(wkv.y), f4 = bf_lo(wkv.z), f5 = bf_hi(wkv.z), f6 = bf_lo(wkv.w), f7 = bf_hi(wkv.w);
                  skv = (f0 * f0 + f1 * f1) + (f2 * f2 + f3 * f3) + (f4 * f4 + f5 * f5) + (f6 * f6 + f7 * f7); }
                float gv[8];
                gv[0] = gelu_tanh(bf_lo(wv.x)); gv[1] = gelu_tanh(bf_hi(wv.x)); gv[2] = gelu_tanh(bf_lo(wv.y)); gv[3] = gelu_tanh(bf_hi(wv.y));
                gv[4] = gelu_tanh(bf_lo(wv.z)); gv[5] = gelu_tanh(bf_hi(wv.z)); gv[6] = gelu_tanh(bf_lo(wv.w)); gv[7] = gelu_tanh(bf_hi(wv.w));
                float sv = 0.f;
#pragma unroll
                for (int e = 0; e < 8; ++e) sv += gv[e] * gv[e];
                sq = wave_sum(sq); skv = wave_sum(skv); sv = wave_sum(sv);
                if (lane == 0) { rstdq[row] = rsqrtf(sq * (1.0f / 384.0f) + EPS); rstdkv[row] = rsqrtf(skv * (1.0f / 256.0f) + EPS); }
                const float rv = rsqrtf(sv * (1.0f / 512.0f) + EPS);
                { u32x4 o; o.x = pk2(gv[0] * rv * gs[0], gv[1] * rv * gs[1]); o.y = pk2(gv[2] * rv * gs[2], gv[3] * rv * gs[3]);
                  o.z = pk2(gv[4] * rv * gs[4], gv[5] * rv * gs[5]); o.w = pk2(gv[6] * rv * gs[6], gv[7] * rv * gs[7]);
                  *(LAS u32x4*)(vn + lr * 512 + 8 * lane) = o; }
            }
        }
        __syncthreads();
        const int g = wid;
        f32x16 acc[2][4];
#pragma unroll
        for (int ct = 0; ct < 2; ++ct)
#pragma unroll
            for (int tt = 0; tt < 4; ++tt)
#pragma unroll
                for (int r = 0; r < 16; ++r) acc[ct][tt][r] = 0.f;
#pragma unroll 1
        for (int ks = 0; ks < 8; ++ks) {
            bf16x8 af[2], bfr[4];
#pragma unroll
            for (int ct = 0; ct < 2; ++ct)
#pragma unroll
                for (int e = 0; e < 8; ++e) af[ct][e] = (short)vn[(16 * ks + 8 * hi + e) * 512 + 64 * g + 32 * ct + r32];
#pragma unroll
            for (int tt = 0; tt < 4; ++tt) bfr[tt] = *(const bf16x8*)(Wsb + ((size_t)(g * 128 + 32 * tt + r32) * 128 + 16 * ks + 8 * hi));
#pragma unroll
            for (int ct = 0; ct < 2; ++ct)
#pragma unroll
                for (int tt = 0; tt < 4; ++tt) acc[ct][tt] = __builtin_amdgcn_mfma_f32_32x32x16_bf16(af[ct], bfr[tt], acc[ct][tt], 0, 0, 0);
        }
#pragma unroll
        for (int tt = 0; tt < 4; ++tt) { const int t = 32 * tt + r32; const float bias = b_sp[g * 128 + t]; const bf16_t* zu = z + (size_t)(R0 + t) * LZ + ZU + 64 * g; float s = 0.f;
#pragma unroll
            for (int ct = 0; ct < 2; ++ct)
#pragma unroll
                for (int rq = 0; rq < 4; ++rq) { const u32x2 w = *(const u32x2*)(zu + 32 * ct + 8 * rq + 4 * hi);
                    const float u0 = gelu_tanh(bf_lo(w.x)), u1 = gelu_tanh(bf_hi(w.x)), u2 = gelu_tanh(bf_lo(w.y)), u3 = gelu_tanh(bf_hi(w.y));
                    float v0 = u0 * (acc[ct][tt][4 * rq] + bias), v1 = u1 * (acc[ct][tt][4 * rq + 1] + bias), v2 = u2 * (acc[ct][tt][4 * rq + 2] + bias), v3 = u3 * (acc[ct][tt][4 * rq + 3] + bias);
                    acc[ct][tt][4 * rq] = v0; acc[ct][tt][4 * rq + 1] = v1; acc[ct][tt][4 * rq + 2] = v2; acc[ct][tt][4 * rq + 3] = v3;
                    s += (v0 * v0 + v1 * v1) + (v2 * v2 + v3 * v3); }
            s += __shfl_xor(s, 32);
            if (hi == 0) part[g * 128 + t] = s; }
        __syncthreads();
        if (tid < 128) { float s = 0.f;
#pragma unroll
            for (int w = 0; w < 8; ++w) s += part[w * 128 + tid];
            rstd_s[tid] = rsqrtf(s * (1.0f / 512.0f) + EPS); }
        __syncthreads();
#pragma unroll
        for (int tt = 0; tt < 4; ++tt) { const int t = 32 * tt + r32; const float rs = rstd_s[t]; bf16_t* zu = z + (size_t)(R0 + t) * LZ + ZU + 64 * g;
#pragma unroll
            for (int ct = 0; ct < 2; ++ct)
#pragma unroll
                for (int rq = 0; rq < 4; ++rq) { u32x2 w; w.x = pk2(acc[ct][tt][4 * rq] * rs, acc[ct][tt][4 * rq + 1] * rs); w.y = pk2(acc[ct][tt][4 * rq + 2] * rs, acc[ct][tt][4 * rq + 3] * rs);
                    *(u32x2*)(zu + 32 * ct + 8 * rq + 4 * hi) = w; } }
        __syncthreads();
    }
}

constexpr int KROW = 208, VROW = 144, KTILE_B = 64 * KROW, VTILE_B = 64 * VROW;
__device__ __forceinline__ void attn_phase(unsigned char* ws, LAS unsigned char* lds, const int wv) {
    int tid = wv * 64 + (int)__builtin_amdgcn_mbcnt_hi(~0u, __builtin_amdgcn_mbcnt_lo(~0u, 0u)); asm volatile("" : "+v"(tid)); const int lane = tid & 63, wid = wv;
    const bf16_t* Q = (const bf16_t*)(ws + WS_H); const bf16_t* kr = Q + (size_t)T * 768;
    bf16_t* z = (bf16_t*)(ws + WS_Z); const bf16_t* kn = z + ZV; const bf16_t* Vt = (const bf16_t*)(ws + WS_VT);
    float* ssq = (float*)(ws + WS_SSQ);
    const int r32 = lane & 31, hi = lane >> 5, G = gridDim.x;
    LAS unsigned char* Kl = lds; LAS unsigned char* Vl = lds + 2 * KTILE_B;
    const int kc0 = tid, kc1 = tid + 512;
    const int kr0 = kc0 / 12, kp0 = kc0 % 12, kr1 = kc1 / 12, kp1 = kc1 % 12;
    const int vd = tid >> 3, vch = tid & 7;
    for (int it = 0;; ++it) {
        const int flat = it * G + blockIdx.x; if (flat >= 1024) break;
        int seq, head, qb, s0, len;
        { const int v = flat < 512 ? flat : flat - 512; const int x = v & 7, y = v >> 3;
          if (flat < 512) { qb = y & 31; const int pair = x + 8 * (y >> 5); seq = pair >> 3; head = pair & 7; s0 = seq * 8192; len = 8192; }
          else { qb = y & 7; const int pair = x + 8 * (y >> 3); seq = pair >> 3; head = pair & 7; s0 = TP + seq * 2048; len = 2048; } }
        const int NTL = len / 64;
        const int qrow = s0 + qb * 256 + wid * 32 + r32;
        bf16x8 qf[6];
#pragma unroll
        for (int d0 = 0; d0 < 6; ++d0) qf[d0] = *(const bf16x8*)(Q + (size_t)qrow * 768 + head * 96 + d0 * 16 + hi * 8);
        const unsigned ko0 = kp0 < 8 ? (unsigned)(WS_Z + ((size_t)(s0 + kr0) * LZ + ZV + head * 64 + kp0 * 8) * 2) : (unsigned)(WS_H + ((size_t)T * 768 + (size_t)(s0 + kr0) * 32 + (kp0 - 8) * 8) * 2);
        const unsigned kst0 = kp0 < 8 ? 64u * LZ * 2u : 64u * 32u * 2u;
        const unsigned ko1 = kp1 < 8 ? (unsigned)(WS_Z + ((size_t)(s0 + kr1) * LZ + ZV + head * 64 + kp1 * 8) * 2) : (unsigned)(WS_H + ((size_t)T * 768 + (size_t)(s0 + kr1) * 32 + (kp1 - 8) * 8) * 2);
        const unsigned kst1 = kp1 < 8 ? 64u * LZ * 2u : 64u * 32u * 2u;
        const unsigned vo = (unsigned)(WS_VT + ((size_t)(head * 64 + vd) * T + s0 + vch * 8) * 2);
#define KLD0(t) (*(const u32x4*)(ws + (ko0 + (unsigned)(t) * kst0)))
#define KLD1(t) (*(const u32x4*)(ws + (ko1 + (unsigned)(t) * kst1)))
#define VLD(t) (*(const u32x4*)(ws + (vo + (unsigned)(t) * 128u)))
        const int kd0 = kr0 * KROW + kp0 * 16, kd1 = kr1 * KROW + kp1 * 16, vdst = vd * VROW + vch * 16;
        u32x4 rk0, rk1 = {0u, 0u, 0u, 0u}, rv;
        rk0 = KLD0(0); if (tid < 256) rk1 = KLD1(0); rv = VLD(0);
        *(LAS u32x4*)(Kl + kd0) = rk0; if (tid < 256) *(LAS u32x4*)(Kl + kd1) = rk1; *(LAS u32x4*)(Vl + vdst) = rv;
        rk0 = KLD0(1); if (tid < 256) rk1 = KLD1(1);
        *(LAS u32x4*)(Kl + KTILE_B + kd0) = rk0; if (tid < 256) *(LAS u32x4*)(Kl + KTILE_B + kd1) = rk1;
        rk0 = KLD0(2); if (tid < 256) rk1 = KLD1(2); rv = VLD(1);
        __syncthreads();
        f32x16 o0, o1, negm, sc0, sc1; bf16x8 kf[12];
#pragma unroll
        for (int r = 0; r < 16; ++r) { o0[r] = 0.f; o1[r] = 0.f; negm[r] = 0.f; }
        float lsum = 0.f;
        { const LAS unsigned char* Kb = Kl + r32 * KROW + hi * 16;
#pragma unroll
          for (int d0 = 0; d0 < 6; ++d0) { kf[2 * d0] = *(const LAS bf16x8*)(Kb + d0 * 32); kf[2 * d0 + 1] = *(const LAS bf16x8*)(Kb + 32 * KROW + d0 * 32); }
#pragma unroll
          for (int d0 = 0; d0 < 6; ++d0) {
              sc0 = __builtin_amdgcn_mfma_f32_32x32x16_bf16(kf[2 * d0], qf[d0], d0 == 0 ? negm : sc0, 0, 0, 0);
              sc1 = __builtin_amdgcn_mfma_f32_32x32x16_bf16(kf[2 * d0 + 1], qf[d0], d0 == 0 ? negm : sc1, 0, 0, 0); }
          float rm = fmaxf(fmaxf(sc0[0], sc0[1]), sc1[0]);
#pragma unroll
          for (int r = 2; r < 16; r += 2) rm = fmaxf(fmaxf(rm, sc0[r]), sc0[r + 1]);
#pragma unroll
          for (int r = 1; r < 15; r += 2) rm = fmaxf(fmaxf(rm, sc1[r]), sc1[r + 1]);
          rm = fmaxf(rm, sc1[15]);
          rm = fmaxf(rm, __shfl_xor(rm, 32));
#pragma unroll
          for (int r = 0; r < 16; ++r) { sc0[r] -= rm; sc1[r] -= rm; negm[r] = -rm; }
          const LAS unsigned char* Kb1 = Kb + KTILE_B;
#pragma unroll
          for (int d0 = 0; d0 < 6; ++d0) { kf[2 * d0] = *(const LAS bf16x8*)(Kb1 + d0 * 32); kf[2 * d0 + 1] = *(const LAS bf16x8*)(Kb1 + 32 * KROW + d0 * 32); } }
        __syncthreads();
        int vb3 = 0;
#pragma unroll 2
        for (int kt = 0; kt < NTL; ++kt) {
            const int buf = kt & 1; const int vb3n = vb3 == 2 ? 0 : vb3 + 1;
            const int t3 = kt + 3 < NTL ? kt + 3 : NTL - 1, t2 = kt + 2 < NTL ? kt + 2 : NTL - 1;
            *(LAS u32x4*)(Kl + buf * KTILE_B + kd0) = rk0; if (tid < 256) *(LAS u32x4*)(Kl + buf * KTILE_B + kd1) = rk1;
            *(LAS u32x4*)(Vl + vb3n * VTILE_B + vdst) = rv;
            rk0 = KLD0(t3); if (tid < 256) rk1 = KLD1(t3);
            rv = VLD(t2);
            f32x16 sn0, sn1;
#pragma unroll
            for (int d0 = 0; d0 < 6; ++d0) {
                sn0 = __builtin_amdgcn_mfma_f32_32x32x16_bf16(kf[2 * d0], qf[d0], d0 == 0 ? negm : sn0, 0, 0, 0);
                sn1 = __builtin_amdgcn_mfma_f32_32x32x16_bf16(kf[2 * d0 + 1], qf[d0], d0 == 0 ? negm : sn1, 0, 0, 0); }
#pragma unroll
            for (int r = 0; r < 16; ++r) { sc0[r] = __builtin_amdgcn_exp2f(sc0[r]); sc1[r] = __builtin_amdgcn_exp2f(sc1[r]); }
#pragma unroll
            for (int r = 0; r < 16; ++r) { lsum += sc0[r]; asm volatile("" : "+v"(lsum)); lsum += sc1[r]; asm volatile("" : "+v"(lsum)); }
            float lchk = lsum;
            { auto rr = __builtin_amdgcn_permlane32_swap(__float_as_uint(lchk), __float_as_uint(lchk), false, false); lchk = fmaxf(__uint_as_float(rr[0]), __uint_as_float(rr[1])); }
            u32x4 pw[4];
            pw[0] = (u32x4){pk2(sc0[0], sc0[1]), pk2(sc0[2], sc0[3]), pk2(sc0[4], sc0[5]), pk2(sc0[6], sc0[7])};
            pw[1] = (u32x4){pk2(sc0[8], sc0[9]), pk2(sc0[10], sc0[11]), pk2(sc0[12], sc0[13]), pk2(sc0[14], sc0[15])};
            pw[2] = (u32x4){pk2(sc1[0], sc1[1]), pk2(sc1[2], sc1[3]), pk2(sc1[4], sc1[5]), pk2(sc1[6], sc1[7])};
            pw[3] = (u32x4){pk2(sc1[8], sc1[9]), pk2(sc1[10], sc1[11]), pk2(sc1[12], sc1[13]), pk2(sc1[14], sc1[15])};
            asm volatile("s_waitcnt lgkmcnt(0)" ::: "memory"); __builtin_amdgcn_s_barrier(); asm volatile("" ::: "memory");
            { const LAS unsigned char* Kb = Kl + buf * KTILE_B + r32 * KROW + hi * 16;
#pragma unroll
              for (int d0 = 0; d0 < 6; ++d0) { kf[2 * d0] = *(const LAS bf16x8*)(Kb + d0 * 32); kf[2 * d0 + 1] = *(const LAS bf16x8*)(Kb + 32 * KROW + d0 * 32); } }
            { const LAS unsigned char* Vb = Vl + vb3 * VTILE_B + r32 * VROW + hi * 16;
#pragma unroll
              for (int h2 = 0; h2 < 2; ++h2) { bf16x8 vf[4];
#pragma unroll
                  for (int s = 0; s < 2; ++s) { vf[2 * s] = *(const LAS bf16x8*)(Vb + (2 * h2 + s) * 32); vf[2 * s + 1] = *(const LAS bf16x8*)(Vb + 32 * VROW + (2 * h2 + s) * 32); }
#pragma unroll
                  for (int s = 0; s < 2; ++s) {
                      const bf16x8 pb = __builtin_bit_cast(bf16x8, pw[2 * h2 + s]);
                      o0 = __builtin_amdgcn_mfma_f32_32x32x16_bf16(vf[2 * s], pb, o0, 0, 0, 0);
                      o1 = __builtin_amdgcn_mfma_f32_32x32x16_bf16(vf[2 * s + 1], pb, o1, 0, 0, 0); } } }
            if (__any(lchk > 1.0e12f)) {
                const float dl = fmaxf(floorf(__builtin_amdgcn_logf(lchk)), 0.f); const float f = __builtin_amdgcn_exp2f(-dl);
                lsum *= f; const float nm = negm[0] - dl;
#pragma unroll
                for (int r = 0; r < 16; ++r) { sn0[r] -= dl; sn1[r] -= dl; o0[r] *= f; o1[r] *= f; negm[r] = nm; }
            }
            sc0 = sn0; sc1 = sn1; vb3 = vb3n;
        }
        __syncthreads();
        lsum += __shfl_xor(lsum, 32);
        const float inv = 1.0f / lsum;
        bf16_t* orow = z + (size_t)qrow * LZ + ZATT + head * 64;
        float sq = 0.f;
#pragma unroll
        for (int rq = 0; rq < 4; ++rq) {
            const float a0 = o0[4 * rq] * inv, a1 = o0[4 * rq + 1] * inv, a2 = o0[4 * rq + 2] * inv, a3 = o0[4 * rq + 3] * inv;
            const float b0 = o1[4 * rq] * inv, b1 = o1[4 * rq + 1] * inv, b2 = o1[4 * rq + 2] * inv, b3 = o1[4 * rq + 3] * inv;
            sq += (a0 * a0 + a1 * a1) + (a2 * a2 + a3 * a3) + (b0 * b0 + b1 * b1) + (b2 * b2 + b3 * b3);
            u32x2 w0, w1; w0.x = pk2(a0, a1); w0.y = pk2(a2, a3); w1.x = pk2(b0, b1); w1.y = pk2(b2, b3);
            *(u32x2*)(orow + 8 * rq + 4 * hi) = w0; *(u32x2*)(orow + 32 + 8 * rq + 4 * hi) = w1;
        }
        sq += __shfl_xor(sq, 32);
        if (hi == 0) ssq[(size_t)qrow * 8 + head] = sq;
    }
}

#define XB_TMO      128
#define XB_XCNT(j)  (256  + 64 * (j))
#define XB_XSUB(j)  (1280 + 64 * (j))
#define XB_XGEN(j)  (2304 + 64 * (j))
#define XB_TOP      3328
#define XB_TOPGEN   3392
#define XCD_BAR_WORDS 3456
#define XB_SPIN_CAP (1u << 18)

__device__ __forceinline__ unsigned xb_ld(unsigned* p)              { return __hip_atomic_load(p, __ATOMIC_RELAXED, __HIP_MEMORY_SCOPE_AGENT); }
__device__ __forceinline__ unsigned xb_add(unsigned* p, unsigned v) { return __hip_atomic_fetch_add(p, v, __ATOMIC_RELAXED, __HIP_MEMORY_SCOPE_AGENT); }
__device__ __forceinline__ unsigned xb_xcc_id() { return (unsigned)__builtin_amdgcn_s_getreg((3 << 11) | 20) & 0xFu; }
#define XB_SPIN(cond, bar) do { unsigned _sp = 0; while (cond) { __builtin_amdgcn_s_sleep(1); \
    if ((++_sp & 255u) == 0u) { if (xb_ld(&(bar)[XB_TMO])) break; if (_sp > XB_SPIN_CAP) { atomicAdd(&(bar)[XB_TMO], 1u); break; } } } } while (0)

struct XcdBarrier {
    unsigned* bar; unsigned x;
    volatile LAS unsigned* st;
};

__device__ __forceinline__ XcdBarrier xcd_barrier_post(unsigned* bar, volatile LAS unsigned* st, const bool t0  ) {
    XcdBarrier b; b.bar = bar; b.x = xb_xcc_id(); b.st = st;
    if (t0) (void)xb_add(&bar[XB_XCNT(b.x)], 1u);
    return b;
}
__device__ __forceinline__ void xcd_barrier_complete(unsigned* bar, unsigned x, unsigned& nloc, unsigned& nx) {
    const unsigned G = gridDim.x * gridDim.y * gridDim.z;
    unsigned sum, cnt, mine, sp = 0u;
    for (;;) {
        sum = 0u; cnt = 0u; mine = 0u;
#pragma unroll
        for (unsigned j = 0; j < 16; ++j) { const unsigned c = xb_ld(&bar[XB_XCNT(j)]); sum += c; cnt += (c > 0u) ? 1u : 0u; mine = (j == x) ? c : mine; }
        if (sum == G) break;
        __builtin_amdgcn_s_sleep(1);
        if ((++sp & 255u) == 0u) { if (xb_ld(&bar[XB_TMO])) break; if (sp > XB_SPIN_CAP) { atomicAdd(&bar[XB_TMO], 1u); break; } }
    }
    nloc = mine > 0u ? mine : 1u; nx = cnt > 0u ? cnt : 1u;
}

__device__ __forceinline__ void xcd_barrier(const XcdBarrier& b, const int wv) {
    asm volatile("s_waitcnt vmcnt(0)" ::: "memory");
    __syncthreads();
    if (wv == 0 && (int)__builtin_amdgcn_mbcnt_hi(~0u, __builtin_amdgcn_mbcnt_lo(~0u, 0u)) == 0) {
        unsigned* bar = b.bar; unsigned bx = b.x; asm volatile("" : "+s"(bx));
        __builtin_amdgcn_s_waitcnt(0);
        unsigned nloc = b.st[0], nx = b.st[1];
        if (nloc == 0u) { xcd_barrier_complete(bar, bx, nloc, nx); b.st[0] = nloc; b.st[1] = nx; }
        const unsigned old = xb_add(&bar[XB_XSUB(bx)], 1u);
        const unsigned gen = old / nloc;
        if (old + 1u == (gen + 1u) * nloc) {
            __builtin_amdgcn_fence(__ATOMIC_RELEASE, "agent");
            asm volatile("s_waitcnt vmcnt(0)" ::: "memory");
            const unsigned og = xb_add(&bar[XB_TOP], 1u);
            const unsigned tg = og / nx;
            if (og + 1u == (tg + 1u) * nx) xb_add(&bar[XB_TOPGEN], 1u);
            else XB_SPIN(xb_ld(&bar[XB_TOPGEN]) == tg, bar);
            __builtin_amdgcn_fence(__ATOMIC_ACQUIRE, "agent");
            xb_add(&bar[XB_XGEN(bx)], 1u);
            asm volatile("s_waitcnt vmcnt(0)" ::: "memory");
        } else {
            XB_SPIN(xb_ld(&bar[XB_XGEN(bx)]) == gen, bar);
            __builtin_amdgcn_fence(__ATOMIC_ACQUIRE, "agent");
            asm volatile("s_waitcnt vmcnt(0)" ::: "memory");
        }
    }
    __syncthreads();
}

__global__ void __launch_bounds__(512, 2) fwd_kernel(Args a) {
    __shared__ __attribute__((aligned(16))) unsigned char lds_raw[LDS_BYTES];
    cg::grid_group grid = cg::this_grid();
    LAS unsigned char* lds = (LAS unsigned char*)lds_raw;
    const int wv = __builtin_amdgcn_readfirstlane((int)threadIdx.x >> 6);
    const bool t0 = wv == 0 && (int)__builtin_amdgcn_mbcnt_hi(~0u, __builtin_amdgcn_mbcnt_lo(~0u, 0u)) == 0;
    unsigned char* ws = a.ws;

    if (t0) { LAS long long* tab = (LAS long long*)(lds + TAB_OFF); ((LAS unsigned*)(lds + TAB_OFF + 224))[0] = 0u; ((LAS unsigned*)(lds + TAB_OFF + 224))[1] = 0u;
        tab[0] = (long long)((const unsigned char*)a.in[0] - (const unsigned char*)a.ws);
        tab[1] = (long long)((const unsigned char*)a.in[1] - (const unsigned char*)a.ws);
        tab[2] = (long long)((const unsigned char*)a.in[2] - (const unsigned char*)a.ws);
        tab[3] = (long long)((const unsigned char*)a.in[3] - (const unsigned char*)a.ws);
        tab[4] = (long long)((const unsigned char*)a.in[4] - (const unsigned char*)a.ws);
        tab[5] = (long long)((const unsigned char*)a.in[5] - (const unsigned char*)a.ws);
        tab[6] = (long long)((const unsigned char*)a.in[6] - (const unsigned char*)a.ws);
        tab[7] = (long long)((const unsigned char*)a.in[7] - (const unsigned char*)a.ws);
        tab[8] = (long long)((const unsigned char*)a.in[8] - (const unsigned char*)a.ws);
        tab[9] = (long long)((const unsigned char*)a.in[9] - (const unsigned char*)a.ws);
        tab[10] = (long long)((const unsigned char*)a.in[10] - (const unsigned char*)a.ws);
        tab[11] = (long long)((const unsigned char*)a.in[11] - (const unsigned char*)a.ws);
        tab[12] = (long long)((const unsigned char*)a.in[12] - (const unsigned char*)a.ws);
        tab[13] = (long long)((const unsigned char*)a.in[13] - (const unsigned char*)a.ws);
        tab[14] = (long long)((const unsigned char*)a.in[14] - (const unsigned char*)a.ws);
        tab[15] = (long long)((const unsigned char*)a.in[15] - (const unsigned char*)a.ws);
        tab[16] = (long long)((const unsigned char*)a.in[16] - (const unsigned char*)a.ws);
        tab[17] = (long long)((const unsigned char*)a.in[17] - (const unsigned char*)a.ws);
        tab[18] = (long long)((const unsigned char*)a.in[18] - (const unsigned char*)a.ws);
        tab[19] = (long long)((const unsigned char*)a.in[19] - (const unsigned char*)a.ws);
        tab[20] = (long long)((const unsigned char*)a.in[20] - (const unsigned char*)a.ws);
        tab[21] = (long long)((const unsigned char*)a.in[21] - (const unsigned char*)a.ws);
        tab[22] = (long long)((const unsigned char*)a.in[22] - (const unsigned char*)a.ws);
        tab[23] = (long long)((const unsigned char*)a.in[23] - (const unsigned char*)a.ws);
    }
    __syncthreads();
    const XcdBarrier bar = xcd_barrier_post((unsigned*)ws, (volatile LAS unsigned*)(lds + TAB_OFF + 224), t0);
    float* const xout = a.out;
#define WSL(w) size_t w##_z = 0; asm volatile("" : "+s"(w##_z)); unsigned char* w = ws + w##_z
#define HB(w) ((bf16_t*)((w) + WS_H))
#define ZB(w) ((bf16_t*)((w) + WS_Z))
#define MODP(w) ((const float*)((w) + WS_MOD))
    p0_phase(ws, lds, wv);
    grid.sync();
    { WSL(w); RowArgs ra{nullptr, INP(0), INP(1), nullptr, nullptr, nullptr, INP(6), MODP(w) + 1024, MODP(w), HB(w), nullptr, 0, DM}; row_phase<false, true, false, true>(ra, wv); }
    xcd_barrier(bar, wv);
#pragma unroll 1
    for (int l = 0; l < NLAYER; ++l) {
        { WSL(w); int Gl = gridDim.x, bl = blockIdx.x; asm volatile("" : "+s"(Gl), "+s"(bl));
          pg8::Gemm g{HB(w), (const bf16_t*)(w + WS_W + (size_t)l * WL + OW_IN), T, NIN, 1024, 1024}; pg8::StaticOrder S; S.init(T, NIN, Gl, bl);
          pg8::EpiStore<false> E{ZB(w), LZ, LZ, nullptr}; pg8::gemm_phase<pg8::EpiStore<false>, pg8::StaticOrder, true, true>(lds, g, S, E, wv); }
        xcd_barrier(bar, wv);
        { WSL(w); mid_phase(w, l, lds, wv); }
        xcd_barrier(bar, wv);
        { WSL(w); int Gl = gridDim.x, bl = blockIdx.x; asm volatile("" : "+s"(Gl), "+s"(bl));
          pg8::Gemm g{ZB(w) + ZQ, (const bf16_t*)(w + WS_W + (size_t)l * WL + OW_QB), T, 768, 384, LZ}; pg8::StaticOrder S; S.init(T, 768, Gl, bl);
          pg8::EpiQ E{HB(w), (const float*)(w + WS_ROPE), (const float*)(w + WS_SSQ)}; pg8::gemm_phase<pg8::EpiQ, pg8::StaticOrder, true, true>(lds, g, S, E, wv); }
        { WSL(w); int Gl = gridDim.x, bl = blockIdx.x; asm volatile("" : "+s"(Gl), "+s"(bl));
          pg8::Gemm g{ZB(w) + ZKV, (const bf16_t*)(w + WS_W + (size_t)l * WL + OW_KVB), T, 1024, 256, LZ}; pg8::StaticOrder S; S.init(T, 1024, Gl, bl);
          pg8::EpiKV E{ZB(w) + ZV, (bf16_t*)(w + WS_VT), (const float*)(w + WS_SSQ) + T}; pg8::gemm_phase<pg8::EpiKV, pg8::StaticOrder, true, true>(lds, g, S, E, wv); }
        xcd_barrier(bar, wv);
        { WSL(w); attn_phase(w, lds, wv); }
        xcd_barrier(bar, wv);
        { WSL(w); int Gl = gridDim.x, bl = blockIdx.x; asm volatile("" : "+s"(Gl), "+s"(bl));
          pg8::Gemm g{ZB(w) + ZATT, (const bf16_t*)(w + WS_W + (size_t)l * WL + OW_OUT), T, 1024, 1024, LZ}; pg8::StaticOrder S; S.init(T, 1024, Gl, bl);
          pg8::EpiStore<true> E{HB(w), DM, DM, (const float*)(w + WS_SSQ)}; pg8::gemm_phase<pg8::EpiStore<true>, pg8::StaticOrder, true, true>(lds, g, S, E, wv); }
        xcd_barrier(bar, wv);
        { WSL(w); const float* modl = MODP(w) + (size_t)l * NCR * NMODC;
          RowArgs ra{HB(w), INP(0), INP(1), nullptr, INP(7) + l * DM, modl + 2048, INP(8) + l * DM, modl + 4096, modl + 3072, EB(xout), (unsigned char*)xout, DM, 2048};
          if (l == 0) row_phase<true, true, false, true>(ra, wv); else row_phase<true, true, true, true>(ra, wv); }
        xcd_barrier(bar, wv);
        { WSL(w); int Gl = gridDim.x, bl = blockIdx.x; asm volatile("" : "+s"(Gl), "+s"(bl));
          pg8::Gemm g{EB(xout), (const bf16_t*)(w + WS_W + (size_t)l * WL + OW_GU), T, NGU, 1024, 2048}; pg8::StaticOrder S; S.init(T, NGU, Gl, bl);
          pg8::EpiGU E{HB(w)}; pg8::gemm_phase<pg8::EpiGU, pg8::StaticOrder, true, true>(lds, g, S, E, wv); }
        xcd_barrier(bar, wv);
        { WSL(w); int Gl = gridDim.x, bl = blockIdx.x; asm volatile("" : "+s"(Gl), "+s"(bl));
          pg8::Gemm g{HB(w), (const bf16_t*)(w + WS_W + (size_t)l * WL + OW_D), T, 1024, DFF, DFF}; pg8::StaticOrder S; S.init(T, 1024, Gl, bl);
          pg8::EpiStore<false> E{EB(xout), 2048, DM, nullptr}; pg8::gemm_phase<pg8::EpiStore<false>, pg8::StaticOrder, true, true>(lds, g, S, E, wv); }
        xcd_barrier(bar, wv);
        if (l + 1 < NLAYER) {
            WSL(w); const float* modl = MODP(w) + (size_t)l * NCR * NMODC; const float* modn = modl + NCR * NMODC;
            RowArgs ra{EB(xout), nullptr, nullptr, nullptr, INP(9) + l * DM, modl + 5120, INP(6) + (l + 1) * DM, modn + 1024, modn, HB(w), (unsigned char*)xout, 2048, DM};
            row_phase<true, true, true, true>(ra, wv);
            xcd_barrier(bar, wv);
        } else {
            WSL(w); const float* modl = MODP(w) + (size_t)l * NCR * NMODC;
            RowArgs ra{EB(xout), nullptr, nullptr, xout, INP(9) + l * DM, modl + 5120, nullptr, nullptr, nullptr, nullptr, (unsigned char*)xout, 2048, 0};
            row_phase<true, false, true, false>(ra, wv);
        }
    }
}

extern "C" void kernel_launch(void* const* d_in, const int* in_sizes, int n_in, void* d_out, int out_size, void* d_ws, size_t ws_size, hipStream_t stream) {
    static int grid = 0;
    if (grid == 0) {
        if (n_in != 24 || out_size != T * DM || ws_size < WS_END) { fprintf(stderr, "kernel_launch: unexpected problem (n_in %d out %d ws %zu)\n", n_in, out_size, ws_size); grid = -1; return; }
        int dev = 0, cus = 0, per_cu = 0;
        hipGetDevice(&dev); hipDeviceGetAttribute(&cus, hipDeviceAttributeMultiprocessorCount, dev);
        hipOccupancyMaxActiveBlocksPerMultiprocessor(&per_cu, (const void*)fwd_kernel, 512, 0);
        if (per_cu < 1) per_cu = 1;
        grid = cus * per_cu;
        fprintf(stderr, "kernel_launch: grid %d (cus %d x %d)\n", grid, cus, per_cu);
    }
    if (grid < 0) return;
    if (hipMemsetAsync(d_ws, 0, 16384, stream) != hipSuccess) { fprintf(stderr, "kernel_launch: memset failed\n"); return; }
    Args a{};
    for (int i = 0; i < 24; ++i) a.in[i] = (const float*)d_in[i];
    a.out = (float*)d_out; a.ws = (unsigned char*)d_ws;
    void* args[] = {&a};
    hipError_t e = hipLaunchCooperativeKernel((const void*)fwd_kernel, dim3(grid), dim3(512), args, 0, stream);
    if (e != hipSuccess) fprintf(stderr, "cooperative launch failed: %s (grid %d)\n", hipGetErrorString(e), grid);
}
```

```cpp
#include <hip/hip_runtime.h>
#include <hip/hip_cooperative_groups.h>
#include <cstdio>
#include <cstdint>
namespace cg = cooperative_groups;
namespace pg8 {
#define PG8_LAS __attribute__((address_space(3)))
typedef unsigned short bf16_t;
typedef short bf16x8 __attribute__((ext_vector_type(8)));
typedef float f32x4 __attribute__((ext_vector_type(4)));
typedef unsigned u32x4 __attribute__((ext_vector_type(4)));
constexpr int BM = 256, BK = 64, HALF = 128, HTB = HALF * BK * 2  , STAGE_BYTES = 8 * HTB, NXCD = 8, WGM = 8;

__host__ __device__ __forceinline__ int lds_byte(int r, int c) { const int st = (r >> 4) * 2 + (c >> 5), rr = r & 15, cc = c & 31, ob = rr * 64 + cc * 2; return st * 1024 + (ob ^ (((ob >> 9) & 1) << 5)); }
__host__ __device__ __forceinline__ void stage_rc(int b, int& R, int& C) { const int st = b / 1024, sb = b % 1024, swz = sb ^ (((sb >> 9) & 1) << 5); R = (st >> 1) * 16 + swz / 64; C = (st & 1) * 32 + (swz % 64) / 2; }
__host__ __device__ __forceinline__ int perm32(int rho) { const int n = rho >> 4, i = rho & 15; return 8 * (i >> 2) + 4 * n + (i & 3); }

struct Unit { int pm, pn; };
struct Gemm { const bf16_t* A; const bf16_t* Bt; int M, N, K, lda; };

struct StaticOrder {
    int nM, nN, nwg, G, c;
    __host__ __device__ void init(int M, int N, int G_, int c_) { nM = M / BM; nN = N / BM; nwg = nM * nN; G = G_; c = c_; }
    __host__ __device__ bool next(int i, Unit& u) const {
        const long L = (long)i * G + c; if (L >= nwg) return false;
        int wgid = (int)L; { const int q = nwg / NXCD, r = nwg % NXCD, xcd = wgid % NXCD, off = wgid / NXCD; wgid = (xcd < r ? xcd * (q + 1) : r * (q + 1) + (xcd - r) * q) + off; }
        const int nig = WGM * nN, gid = wgid / nig, fm = gid * WGM, gsz = (nM - fm) < WGM ? (nM - fm) : WGM;
        u.pm = fm + ((wgid % nig) % gsz); u.pn = (wgid % nig) / gsz; return true;
    }
    __device__ __forceinline__ void a_ready(const Unit&) const {}
    __device__ __forceinline__ void done(const Unit&) const {}
};

__device__ __forceinline__ unsigned cvt_pk_bf16(float lo, float hi) { unsigned r; asm volatile("v_cvt_pk_bf16_f32 %0, %1, %2" : "=v"(r) : "v"(lo), "v"(hi)); return r; }
typedef float f32x2 __attribute__((ext_vector_type(2)));
template <class Epi, class Sched, bool ALIGN_EPI = false, bool SP2 = false>
__device__ __forceinline__ void gemm_phase(PG8_LAS unsigned char* lds, const Gemm g, const Sched& S, const Epi& E, const int wv  ) {
    int tid0_ = wv * 64 + (int)__builtin_amdgcn_mbcnt_hi(~0u, __builtin_amdgcn_mbcnt_lo(~0u, 0u)); asm volatile("" : "+v"(tid0_));
    const int tid = tid0_, wid = __builtin_amdgcn_readfirstlane(tid >> 6), lane = tid & 63, wr = wid >> 2, wc = wid & 3, fr = lane & 15, fq = lane >> 4;
    const int K = g.K, nt = K / BK;
    unsigned voffA[2], voffB[2];
#pragma unroll
    for (int i = 0; i < 2; ++i) { int R, C; stage_rc(tid * 16 + i * 8192, R, C); const int Rb = Epi::PERM ? ((R & ~31) + perm32(R & 31)) : R;
        voffA[i] = (unsigned)(R * g.lda + C) * 2u; voffB[i] = (unsigned)(Rb * K + C) * 2u; }
    const size_t kstep = (size_t)(BK * 2);
    const size_t hstepB = (size_t)HALF * K * 2, hstepA = (size_t)HALF * g.lda * 2;
    const size_t tstepB = 2 * hstepB, tstepA = 2 * hstepA;
    const unsigned ldsw = (unsigned)wid * 1024u;
    const int aoff = lds_byte(wr * 64 + fr, fq * 8), boff = lds_byte(wc * 32 + fr, fq * 8);
#define PG8_SA(b, h) (((b) * 2 + (h)) * HTB)
#define PG8_SB(b, h) ((4 + (b) * 2 + (h)) * HTB)
#define PG8_STAGE(bufoff, gbase, voff) do { _Pragma("unroll") for (int _i = 0; _i < 2; ++_i) \
        __builtin_amdgcn_global_load_lds((const unsigned*)((const char*)(gbase) + (voff)[_i]), (PG8_LAS unsigned*)(lds + (bufoff) + ldsw + _i * 8192), 16, 0, 0); } while (0)
#define PG8_LDA(dst, b, h) do { _Pragma("unroll") for (int m = 0; m < 4; ++m) _Pragma("unroll") for (int k = 0; k < 2; ++k) dst[m][k] = *(const PG8_LAS bf16x8*)(lds + PG8_SA(b, h) + aoff + m * 2048 + k * 1024); } while (0)
#define PG8_LDB(dst, b, h) do { _Pragma("unroll") for (int n = 0; n < 2; ++n) _Pragma("unroll") for (int k = 0; k < 2; ++k) dst[n][k] = *(const PG8_LAS bf16x8*)(lds + PG8_SB(b, h) + boff + n * 2048 + k * 1024); } while (0)
#define PG8_MMA(ai, bj, At, Bt) do { __builtin_amdgcn_s_setprio(1); _Pragma("unroll") for (int m = 0; m < 4; ++m) _Pragma("unroll") for (int n = 0; n < 2; ++n) _Pragma("unroll") for (int k = 0; k < 2; ++k) \
        acc[ai][bj][m][n] = __builtin_amdgcn_mfma_f32_16x16x32_bf16(Bt[n][k], At[m][k], acc[ai][bj][m][n], 0, 0, 0); __builtin_amdgcn_s_setprio(0); } while (0)
#define PG8_WAIT_V(n) asm volatile("s_waitcnt vmcnt(" #n ")" ::: "memory")
#define PG8_WAIT_L(n) asm volatile("s_waitcnt lgkmcnt(" #n ")" ::: "memory")
#define PG8_BAR __builtin_amdgcn_s_barrier()
#define PG8_SCHED __builtin_amdgcn_sched_barrier(0)
    Unit cur, nxt; int ui = 0;
    if (!S.next(0, cur)) return;
    f32x4 acc[2][2][4][2];
#pragma unroll
    for (int a = 0; a < 2; ++a)
#pragma unroll
        for (int b = 0; b < 2; ++b)
#pragma unroll
            for (int m = 0; m < 4; ++m)
#pragma unroll
                for (int n = 0; n < 2; ++n) acc[a][b][m][n] = (f32x4){0.f, 0.f, 0.f, 0.f};
    bf16x8 At[4][2], B0[2][2], B1[2][2];
    const char* cA = (const char*)g.A + (size_t)cur.pm * tstepA; const char* cB = (const char*)g.Bt + (size_t)cur.pn * tstepB;
    S.a_ready(cur);
    if constexpr (SP2) {
        PG8_STAGE(PG8_SB(0, 0), cB, voffB); PG8_STAGE(PG8_SB(0, 1), cB + hstepB, voffB); PG8_STAGE(PG8_SA(0, 0), cA, voffA); PG8_STAGE(PG8_SA(0, 1), cA + hstepA, voffA);
        if (wr == 1) PG8_BAR;
        PG8_WAIT_V(2); PG8_BAR;
        PG8_STAGE(PG8_SB(1, 0), cB + kstep, voffB); PG8_STAGE(PG8_SA(1, 0), cA + kstep, voffA); PG8_STAGE(PG8_SB(1, 1), cB + hstepB + kstep, voffB);
        PG8_WAIT_V(6); PG8_BAR;
    } else {
        PG8_STAGE(PG8_SB(0, 0), cB, voffB); PG8_STAGE(PG8_SA(0, 0), cA, voffA); PG8_STAGE(PG8_SB(0, 1), cB + hstepB, voffB); PG8_STAGE(PG8_SA(0, 1), cA + hstepA, voffA);
        if (wr == 1) PG8_BAR;
        PG8_WAIT_V(4); PG8_BAR;
        PG8_STAGE(PG8_SB(1, 0), cB + kstep, voffB); PG8_STAGE(PG8_SA(1, 0), cA + kstep, voffA); PG8_STAGE(PG8_SB(1, 1), cB + hstepB + kstep, voffB);
        PG8_WAIT_V(6); PG8_BAR;
    }
    for (;;) {
        const bool has_next = S.next(ui + 1, nxt);
        const char* nA = has_next ? (const char*)g.A + (size_t)nxt.pm * tstepA : cA; const char* nB = has_next ? (const char*)g.Bt + (size_t)nxt.pn * tstepB : cB;
#pragma unroll 1
        for (int t = 0; t < nt; t += 2) {
            const bool last = (t == nt - 2);
            if constexpr (Epi::MIDK) { if (t == 8) E.midk(acc, cur, wr, fr); }
            const char* a1 = cA + (size_t)(t + 1) * kstep;
            const char* a2 = last ? nA : cA + (size_t)(t + 2) * kstep; const char* b2 = last ? nB : cB + (size_t)(t + 2) * kstep;
            const char* a3 = a2 + kstep; const char* b3 = b2 + kstep;
            if (last && has_next) S.a_ready(nxt);
            if constexpr (SP2) {
            PG8_LDB(B0, 0, 0); PG8_LDB(B1, 0, 1); PG8_SCHED; PG8_LDA(At, 0, 0); PG8_STAGE(PG8_SA(1, 1), a1 + hstepA, voffA);
            PG8_WAIT_V(8); PG8_WAIT_L(0); PG8_BAR; PG8_MMA(0, 0, At, B0); PG8_MMA(0, 1, At, B1); PG8_BAR; PG8_SCHED;
            PG8_LDA(At, 0, 1); PG8_STAGE(PG8_SB(0, 0), b2, voffB); PG8_STAGE(PG8_SB(0, 1), b2 + hstepB, voffB); PG8_STAGE(PG8_SA(0, 0), a2, voffA);
            PG8_WAIT_V(8); PG8_WAIT_L(0); PG8_BAR; PG8_MMA(1, 0, At, B0); PG8_MMA(1, 1, At, B1); PG8_BAR; PG8_SCHED;
            PG8_LDB(B0, 1, 0); PG8_LDB(B1, 1, 1); PG8_SCHED; PG8_LDA(At, 1, 0); PG8_STAGE(PG8_SA(0, 1), a2 + hstepA, voffA);
            PG8_WAIT_V(8); PG8_WAIT_L(0); PG8_BAR; PG8_MMA(0, 0, At, B0); PG8_MMA(0, 1, At, B1); PG8_BAR; PG8_SCHED;
            PG8_LDA(At, 1, 1); PG8_STAGE(PG8_SB(1, 0), b3, voffB); PG8_STAGE(PG8_SB(1, 1), b3 + hstepB, voffB); PG8_STAGE(PG8_SA(1, 0), a3, voffA);
            PG8_WAIT_V(8); PG8_WAIT_L(0); PG8_BAR; PG8_MMA(1, 0, At, B0); PG8_MMA(1, 1, At, B1); PG8_BAR; PG8_SCHED;
            } else {
            PG8_LDB(B0, 0, 0); PG8_SCHED; PG8_LDA(At, 0, 0); PG8_STAGE(PG8_SA(1, 1), a1 + hstepA, voffA);
            PG8_WAIT_L(8); PG8_BAR; PG8_WAIT_L(0); PG8_MMA(0, 0, At, B0); PG8_BAR; PG8_SCHED;
            PG8_LDB(B1, 0, 1); PG8_STAGE(PG8_SB(0, 0), b2, voffB);
            PG8_BAR; PG8_WAIT_L(0); PG8_MMA(0, 1, At, B1); PG8_BAR;
            PG8_LDA(At, 0, 1); PG8_STAGE(PG8_SA(0, 0), a2, voffA);
            PG8_BAR; PG8_WAIT_L(0); PG8_MMA(1, 0, At, B0); PG8_BAR; PG8_SCHED;
            PG8_STAGE(PG8_SB(0, 1), b2 + hstepB, voffB);
            PG8_WAIT_V(6); PG8_BAR; PG8_MMA(1, 1, At, B1); PG8_BAR;
            PG8_LDB(B0, 1, 0); PG8_SCHED; PG8_LDA(At, 1, 0); PG8_STAGE(PG8_SA(0, 1), a2 + hstepA, voffA);
            PG8_WAIT_L(8); PG8_BAR; PG8_WAIT_L(0); PG8_MMA(0, 0, At, B0); PG8_BAR; PG8_SCHED;
            PG8_LDB(B1, 1, 1); PG8_STAGE(PG8_SB(1, 0), b3, voffB);
            PG8_BAR; PG8_WAIT_L(0); PG8_MMA(0, 1, At, B1); PG8_BAR;
            PG8_LDA(At, 1, 1); PG8_STAGE(PG8_SA(1, 0), a3, voffA);
            PG8_BAR; PG8_WAIT_L(0); PG8_MMA(1, 0, At, B0); PG8_BAR; PG8_SCHED;
            PG8_STAGE(PG8_SB(1, 1), b3 + hstepB, voffB);
            PG8_WAIT_V(6); PG8_BAR; PG8_MMA(1, 1, At, B1); PG8_BAR;
            }
        }
        if constexpr (ALIGN_EPI) { if (wr == 0) PG8_BAR; }
        if constexpr (!Epi::AFTER_DRAIN) { E(acc, cur, wr, wc, fr, fq); S.done(cur); }
        if (!has_next) break;
#pragma unroll
        for (int a = 0; a < 2; ++a)
#pragma unroll
            for (int b = 0; b < 2; ++b)
#pragma unroll
                for (int m = 0; m < 4; ++m)
#pragma unroll
                    for (int n = 0; n < 2; ++n) acc[a][b][m][n] = (f32x4){0.f, 0.f, 0.f, 0.f};
        cur = nxt; cA = nA; cB = nB; ++ui;
        if constexpr (ALIGN_EPI) { if (wr == 1) PG8_BAR; }
    }
    PG8_WAIT_V(0);
    if constexpr (!ALIGN_EPI) { if (wr == 0) PG8_BAR; }
    PG8_BAR;
    if constexpr (Epi::AFTER_DRAIN) { E.fused(acc, cur, wr, wc, fr, fq, lds, wid, lane); S.done(cur); }
#undef PG8_SA
#undef PG8_SB
#undef PG8_STAGE
#undef PG8_LDA
#undef PG8_LDB
#undef PG8_MMA
#undef PG8_WAIT_V
#undef PG8_WAIT_L
#undef PG8_BAR
#undef PG8_SCHED
}
}

#define LAS __attribute__((address_space(3)))
using pg8::bf16_t; using pg8::bf16x8; using pg8::f32x4; using pg8::u32x4;
typedef float f32x16 __attribute__((ext_vector_type(16)));
typedef float f32x2v __attribute__((ext_vector_type(2)));
typedef __bf16 bf16x2v __attribute__((ext_vector_type(2)));
typedef unsigned u32x2 __attribute__((ext_vector_type(2)));

constexpr int T = 32768, TP = 16384, DM = 1024, NLAYER = 2, NCR = 10, NMODC = 6144;
constexpr int INC = 1696, LZ = 1728, ZQ = 0, ZKV = 384, ZKR = 640, ZU = 704, ZV = 1216, ZATT = 192, NIN = 1792;
constexpr int DFF = 2816, NGU = 5632;
constexpr float EPS = 1e-6f;
constexpr float QSCALE = 0.10206207261596577f * 1.4426950408889634f;
constexpr size_t MiB = 1u << 20;
constexpr size_t WS_MOD = 512 * 1024, WS_ROPE = 1 * MiB, WS_SSQ = 2 * MiB, WS_W = 3 * MiB;
constexpr size_t OW_IN = 0, OW_QB = 3670016, OW_KVB = 4259840, OW_OUT = 4784128, OW_GU = 6881280, OW_D = 18415616, OW_S = 24182784, WL = 24444928;
constexpr size_t WS_H = 50 * MiB, WS_Z = 114 * MiB, WS_VT = 222 * MiB, WS_END = 254 * MiB;
static_assert(WS_Z + (size_t)32768 * LZ * 2 <= WS_VT, "z fits");
static_assert(WS_W + 2 * WL <= WS_H, "weights fit");
constexpr int LDS_BYTES = 147456;

struct Args { const float* in[24]; float* out; unsigned char* ws; };
constexpr int TAB_OFF = LDS_BYTES - 256;
typedef const float* cfptr;
#define GAS __attribute__((address_space(1)))
#define EB(xo) ((bf16_t*)((unsigned char*)(xo) + 2048))
#define INP(k) ((const float*)(ws + ((LAS long long*)(lds + TAB_OFF))[k]))

__device__ __forceinline__ float bf_lo(unsigned w) { return __uint_as_float(w << 16); }
__device__ __forceinline__ float bf_hi(unsigned w) { return __uint_as_float(w & 0xffff0000u); }
__device__ __forceinline__ unsigned pk2(float lo, float hi) { f32x2v v = {lo, hi}; bf16x2v b = __builtin_convertvector(v, bf16x2v); return __builtin_bit_cast(unsigned, b); }
__device__ __forceinline__ float wave_sum(float v) {
#pragma unroll
    for (int o = 1; o < 64; o <<= 1) v += __shfl_xor(v, o);
    return v;
}
__device__ __forceinline__ float gelu_tanh(float x) {
    const float u = 0.7978845608028654f * (x + 0.044715f * x * x * x);
    const float e = __builtin_amdgcn_exp2f(-2.8853900817779268f * u);
    return x * __builtin_amdgcn_rcpf(1.0f + e);
}
__device__ __forceinline__ float silu_f(float x) { return x * __builtin_amdgcn_rcpf(1.0f + __builtin_amdgcn_exp2f(-1.4426950408889634f * x)); }
__device__ __forceinline__ int tok_pos(int row) { return row < TP ? (row & 8191) : (row & 2047); }
__device__ __forceinline__ int tok_cr(int row) { return row < TP ? (row >> 13) : 2 + ((row - TP) >> 11); }

namespace pg8 {
template <bool MK> struct EpiStore {
    static constexpr bool PERM = true, AFTER_DRAIN = false, MIDK = MK;
    bf16_t* O; int ldc; int ncols; const float* ssq;
    __device__ __forceinline__ void operator()(const f32x4 (&acc)[2][2][4][2], const Unit& u, int wr, int wc, int fr, int fq) const {
        const int row0 = u.pm * BM + wr * 64 + fr, col0 = u.pn * BM + wc * 32 + 8 * fq;
#pragma unroll
        for (int ai = 0; ai < 2; ++ai)
#pragma unroll
            for (int m = 0; m < 4; ++m) { bf16_t* rowp = O + (size_t)(row0 + ai * HALF + m * 16) * ldc + col0;
#pragma unroll
                for (int bj = 0; bj < 2; ++bj) if (col0 + bj * HALF < ncols) { const f32x4 v0 = acc[ai][bj][m][0], v1 = acc[ai][bj][m][1];
                    u32x4 w; w.x = pk2(v0[0], v0[1]); w.y = pk2(v0[2], v0[3]); w.z = pk2(v1[0], v1[1]); w.w = pk2(v1[2], v1[3]);
                    *(u32x4*)(rowp + bj * HALF) = w; } }
    }
    __device__ __forceinline__ void midk(f32x4 (&acc)[2][2][4][2], const Unit& u, int wr, int fr) const {
#pragma unroll
        for (int ai = 0; ai < 2; ++ai)
#pragma unroll
            for (int m = 0; m < 4; ++m) { int row = u.pm * BM + ai * HALF + wr * 64 + m * 16 + fr; asm volatile("" : "+v"(row) :: "memory"); const f32x4* p = (const f32x4*)(ssq + (size_t)row * 8);
                const f32x4 s0 = p[0], s1 = p[1]; const float s = ((s0[0] + s0[1]) + (s0[2] + s0[3])) + ((s1[0] + s1[1]) + (s1[2] + s1[3]));
                const float rs = rsqrtf(s * (1.0f / 512.0f) + EPS);
#pragma unroll
                for (int bj = 0; bj < 2; ++bj)
#pragma unroll
                    for (int n = 0; n < 2; ++n) acc[ai][bj][m][n] *= rs; }
    }
};
struct EpiQ {
    static constexpr bool PERM = false, AFTER_DRAIN = false, MIDK = false;
    bf16_t* Q; const float* rope; const float* rstd;
    __device__ __forceinline__ void midk(f32x4 (&)[2][2][4][2], const Unit&, int, int) const {}
    __device__ __forceinline__ void operator()(const f32x4 (&acc)[2][2][4][2], const Unit& u, int wr, int wc, int fr, int fq) const {
        const int G0 = 8 * u.pn + wc, part0 = G0 % 3, part1 = (G0 + 4) % 3;
#pragma unroll
        for (int ai = 0; ai < 2; ++ai)
#pragma unroll
            for (int m = 0; m < 4; ++m) { int row = u.pm * BM + ai * HALF + wr * 64 + m * 16 + fr; asm volatile("" : "+v"(row)); bf16_t* rp = Q + (size_t)row * 768 + 32 * G0 + 4 * fq;
                const float rs = rstd[row] * QSCALE;
                f32x4 cs = {1.f, 1.f, 1.f, 1.f}, sn = {0.f, 0.f, 0.f, 0.f};
                if (part0 == 2 || part1 == 2) { const f32x4* t = (const f32x4*)(rope + ((size_t)tok_pos(row) * 16 + 4 * fq) * 2); const f32x4 c0 = t[0], c1 = t[1];
                    cs = (f32x4){c0[0], c0[2], c1[0], c1[2]}; sn = (f32x4){c0[1], c0[3], c1[1], c1[3]}; }
#pragma unroll
                for (int bj = 0; bj < 2; ++bj) { const bool rp2 = (bj == 0 ? part0 : part1) == 2;
                    f32x4 x1 = acc[ai][bj][m][0] * rs, x2 = acc[ai][bj][m][1] * rs;
                    if (rp2) { const f32x4 o1 = x1 * cs - x2 * sn, o2 = x1 * sn + x2 * cs; x1 = o1; x2 = o2; }
                    u32x2 w1, w2; w1.x = pk2(x1[0], x1[1]); w1.y = pk2(x1[2], x1[3]); w2.x = pk2(x2[0], x2[1]); w2.y = pk2(x2[2], x2[3]);
                    *(u32x2*)(rp + 128 * bj) = w1; *(u32x2*)(rp + 128 * bj + 16) = w2; }
                asm volatile("" ::: "memory"); }
    }
};
struct EpiKV {
    static constexpr bool PERM = true, AFTER_DRAIN = false, MIDK = false;
    bf16_t* kn; bf16_t* vt; const float* rstd;
    __device__ __forceinline__ void midk(f32x4 (&)[2][2][4][2], const Unit&, int, int) const {}
    __device__ __forceinline__ void operator()(const f32x4 (&acc)[2][2][4][2], const Unit& u, int wr, int wc, int fr, int fq) const {
        const int sfr = (fr & 3) | ((fr & 4) << 1) | ((fr & 8) >> 1); const int within = 32 * wc + 8 * fq;
#pragma unroll
        for (int ai = 0; ai < 2; ++ai)
#pragma unroll
            for (int m = 0; m < 4; ++m) { int row = u.pm * BM + ai * HALF + wr * 64 + m * 16 + fr; asm volatile("" : "+v"(row)); const float rs = rstd[row];
#pragma unroll
                for (int bj = 0; bj < 2; ++bj) { const int head = 2 * u.pn + bj;
                    const f32x4 v0 = acc[ai][bj][m][0] * rs, v1 = acc[ai][bj][m][1] * rs;
                    u32x4 w; w.x = pk2(v0[0], v0[1]); w.y = pk2(v0[2], v0[3]); w.z = pk2(v1[0], v1[1]); w.w = pk2(v1[2], v1[3]);
                    if (wc < 2) { *(u32x4*)(kn + (size_t)row * LZ + head * 64 + within) = w; }
                    else { bf16_t* vp = vt + (size_t)(head * 64 + within - 64) * T + ((row & ~15) | sfr);
                        vp[0] = (bf16_t)(w.x & 0xffffu); vp[(size_t)T] = (bf16_t)(w.x >> 16); vp[(size_t)2 * T] = (bf16_t)(w.y & 0xffffu); vp[(size_t)3 * T] = (bf16_t)(w.y >> 16);
                        vp[(size_t)4 * T] = (bf16_t)(w.z & 0xffffu); vp[(size_t)5 * T] = (bf16_t)(w.z >> 16); vp[(size_t)6 * T] = (bf16_t)(w.w & 0xffffu); vp[(size_t)7 * T] = (bf16_t)(w.w >> 16); } }
                asm volatile("" ::: "memory"); }
    }
};
struct EpiGU {
    static constexpr bool PERM = true, AFTER_DRAIN = false, MIDK = false;
    bf16_t* O;
    __device__ __forceinline__ void midk(f32x4 (&)[2][2][4][2], const Unit&, int, int) const {}
    __device__ __forceinline__ void operator()(const f32x4 (&acc)[2][2][4][2], const Unit& u, int wr, int wc, int fr, int fq) const {
        const int col = 128 * u.pn + 32 * wc + 8 * fq;
#pragma unroll
        for (int ai = 0; ai < 2; ++ai)
#pragma unroll
            for (int m = 0; m < 4; ++m) { const int row = u.pm * BM + ai * HALF + wr * 64 + m * 16 + fr;
                const f32x4 g0 = acc[ai][0][m][0], g1 = acc[ai][0][m][1], u0 = acc[ai][1][m][0], u1 = acc[ai][1][m][1];
                u32x4 w; w.x = pk2(silu_f(g0[0]) * u0[0], silu_f(g0[1]) * u0[1]); w.y = pk2(silu_f(g0[2]) * u0[2], silu_f(g0[3]) * u0[3]);
                w.z = pk2(silu_f(g1[0]) * u1[0], silu_f(g1[1]) * u1[1]); w.w = pk2(silu_f(g1[2]) * u1[2], silu_f(g1[3]) * u1[3]);
                *(u32x4*)(O + (size_t)row * DFF + col) = w; }
    }
};
}

__device__ __forceinline__ int rowmap(int mode, int n) { return mode == 0 ? n : mode == 3 ? (n < 672 ? n : n + 32) : (((n >> 7) << 8) + (n & 127) + (mode == 2 ? 128 : 0)); }
__device__ __forceinline__ void transpose_item(const float* W, int K, int N, bf16_t* WT, int mode, const float* gain, LAS float* scr, int item, int lane) {
    const int nblk = N / 32, kb = item / nblk, nb = item % nblk, k0 = 64 * kb, n0 = 32 * nb;
    { const int kq = lane >> 3, nq = lane & 7;
      f32x4 v[8];
#pragma unroll
      for (int i = 0; i < 8; ++i) v[i] = *(const f32x4*)(W + (size_t)(k0 + 8 * i + kq) * N + n0 + 4 * nq);
#pragma unroll
      for (int i = 0; i < 8; ++i) { const int kk = 8 * i + kq; const float gk = gain ? gain[k0 + kk] : 1.0f;
#pragma unroll
          for (int e = 0; e < 4; ++e) scr[kk * 33 + 4 * nq + e] = v[i][e] * gk; } }
    asm volatile("s_waitcnt lgkmcnt(0)" ::: "memory");
    const int c = lane & 7;
#pragma unroll
    for (int j = 0; j < 4; ++j) { const int n = (lane >> 3) + 8 * j; const LAS float* s = scr + (8 * c) * 33 + n;
        u32x4 o; o.x = pk2(s[0 * 33], s[1 * 33]); o.y = pk2(s[2 * 33], s[3 * 33]); o.z = pk2(s[4 * 33], s[5 * 33]); o.w = pk2(s[6 * 33], s[7 * 33]);
        *(u32x4*)(WT + (size_t)rowmap(mode, n0 + n) * K + k0 + 8 * c) = o; }
    asm volatile("s_waitcnt lgkmcnt(0)" ::: "memory");
}

constexpr int WT_I_IN = 16 * 53, WT_I_QB = 6 * 24, WT_I_KVB = 4 * 32, WT_I_OUT = 16 * 32, WT_I_G = 16 * 88, WT_I_D = 44 * 32;
constexpr int WT_NITEMS = WT_I_IN + WT_I_QB + WT_I_KVB + WT_I_OUT + 2 * WT_I_G + WT_I_D;
__device__ __forceinline__ void wt_convert(unsigned char* ws, LAS unsigned char* lds, int l, int it0, int it1, int rank, int nwk, int tid, int lane, int wid) {
    unsigned char* wb = ws + WS_W + (size_t)l * WL;
    if (it0 == 0) {
        const int gtid = rank * 512 + tid, NT = nwk * 512;
        for (int j = gtid; j < 65536; j += NT) { const float* s = INP(16) + (size_t)l * 131072 + 2 * j; ((unsigned*)(wb + OW_S))[j] = pk2(s[0], s[1]); }
        for (int j = gtid; j < 12288; j += NT) { const int r = j >> 7, dr = r < 32 ? 672 + r : 1728 + (r - 32);
            ((u32x4*)(wb + OW_IN))[(size_t)dr * 128 + (j & 127)] = (u32x4){0u, 0u, 0u, 0u}; }
    }
    LAS float* scr = (LAS float*)(lds + 65536) + wid * (64 * 33);
    for (int it = it0 + rank * 8 + wid; it < it1; it += nwk * 8) {
        int r = it;
        if (r < WT_I_IN) { transpose_item(INP(10) + (size_t)l * 1024 * INC, 1024, INC, (bf16_t*)(wb + OW_IN), 3, nullptr, scr, r, lane); continue; } r -= WT_I_IN;
        if (r < WT_I_QB) { transpose_item(INP(12) + (size_t)l * 384 * 768, 384, 768, (bf16_t*)(wb + OW_QB), 0, INP(11) + l * 384, scr, r, lane); continue; } r -= WT_I_QB;
        if (r < WT_I_KVB) { transpose_item(INP(14) + (size_t)l * 256 * 1024, 256, 1024, (bf16_t*)(wb + OW_KVB), 0, INP(13) + l * 256, scr, r, lane); continue; } r -= WT_I_KVB;
        if (r < WT_I_OUT) { const int kb = r / 32; transpose_item(INP(20) + (size_t)l * 1024 * 1024, 1024, 1024, (bf16_t*)(wb + OW_OUT), 0, kb < 8 ? INP(18) + l * 512 : INP(19) + l * 512 - 512, scr, r, lane); continue; } r -= WT_I_OUT;
        if (r < WT_I_G) { transpose_item(INP(21) + (size_t)l * 1024 * DFF, 1024, DFF, (bf16_t*)(wb + OW_GU), 1, nullptr, scr, r, lane); continue; } r -= WT_I_G;
        if (r < WT_I_G) { transpose_item(INP(22) + (size_t)l * 1024 * DFF, 1024, DFF, (bf16_t*)(wb + OW_GU), 2, nullptr, scr, r, lane); continue; } r -= WT_I_G;
        transpose_item(INP(23) + (size_t)l * DFF * 1024, DFF, 1024, (bf16_t*)(wb + OW_D), 0, nullptr, scr, r, lane);
    }
}

__device__ __forceinline__ void p0_phase(unsigned char* ws, LAS unsigned char* lds, const int wv) {
    int tid = wv * 64 + (int)__builtin_amdgcn_mbcnt_hi(~0u, __builtin_amdgcn_mbcnt_lo(~0u, 0u)); asm volatile("" : "+v"(tid)); const int lane = tid & 63, wid = wv;
    const int G = gridDim.x;
    {
        LAS float* cs = (LAS float*)lds; LAS float* red = cs + NCR * 1024;
        float* mod = (float*)(ws + WS_MOD);
        for (int bg = blockIdx.x; bg < 192; bg += G) {
            for (int t = tid; t < NCR * 1024; t += 512) { const int cr = t >> 10, k = t & 1023; const float c = cr < 2 ? INP(2)[cr * 1024 + k] : INP(3)[(cr - 2) * 1024 + k]; cs[t] = silu_f(c); }
            __syncthreads();
            const int l = bg / 96, cb = (bg % 96) * 64;
            const int cg4 = lane & 15, kq = lane >> 4;
            const float* wm = INP(4) + (size_t)l * 1024 * NMODC + cb + 4 * cg4;
            f32x4 acc[NCR];
#pragma unroll
            for (int cr = 0; cr < NCR; ++cr) acc[cr] = (f32x4){0.f, 0.f, 0.f, 0.f};
#pragma unroll 8
            for (int kk = 0; kk < 32; ++kk) { const int k = wid * 128 + 4 * kk + kq; const f32x4 w = *(const f32x4*)(wm + (size_t)k * NMODC);
#pragma unroll
                for (int cr = 0; cr < NCR; ++cr) acc[cr] += w * cs[cr * 1024 + k]; }
#pragma unroll
            for (int cr = 0; cr < NCR; ++cr) {
#pragma unroll
                for (int e = 0; e < 4; ++e) { float s = acc[cr][e]; s += __shfl_xor(s, 16); s += __shfl_xor(s, 32); acc[cr][e] = s; }
                if (kq == 0) *(LAS f32x4*)(red + (wid * NCR + cr) * 64 + 4 * cg4) = acc[cr]; }
            __syncthreads();
            for (int t = tid; t < NCR * 64; t += 512) { const int cr = t >> 6, ln = t & 63; float s = 0.f;
#pragma unroll
                for (int w = 0; w < 8; ++w) s += red[(w * NCR + cr) * 64 + ln];
                mod[(size_t)(l * NCR + cr) * NMODC + cb + ln] = s + INP(5)[l * NMODC + cb + ln]; }
            __syncthreads();
        }
    }
    const int gtid = blockIdx.x * 512 + tid, NT = G * 512;
    {
        float* rope = (float*)(ws + WS_ROPE);
        for (int idx = gtid; idx < 8192 * 16; idx += NT) { const int pos = idx >> 4, i = idx & 15;
            const float inv = exp2f(-(float)i * 0.8304820237218406f);
            const float ang = (float)pos * inv;
            double rev = (double)ang * 0.15915494309189535; rev -= __builtin_rint(rev);
            const float rf = (float)rev;
            rope[2 * idx] = __builtin_amdgcn_cosf(rf); rope[2 * idx + 1] = __builtin_amdgcn_sinf(rf); }
    }
    wt_convert(ws, lds, 0, 0, WT_NITEMS, blockIdx.x, G, tid, lane, wid);
}

struct RowArgs { const bf16_t* src; const float* xin_p; const float* xin_s; float* xout; const float* gpost; const float* ga; const float* gpre; const float* sc; const float* sh; bf16_t* hout; unsigned char* xb; int src_ld, h_ld; };
template <bool HAS_RES, bool HAS_H, bool XIN_BF, bool XOUT_BF>
__device__ __forceinline__ void row_phase(const RowArgs& ra, const int wv) {
    int tid = wv * 64 + (int)__builtin_amdgcn_mbcnt_hi(~0u, __builtin_amdgcn_mbcnt_lo(~0u, 0u)); asm volatile("" : "+v"(tid)); const int lane = tid & 63, wid = wv;
    const int gw = blockIdx.x * 8 + wid, NGW = gridDim.x * 8;
    for (int grp = gw; grp < T / 16; grp += NGW) {
        const int r0 = grp * 16, cr = tok_cr(r0);
        float A[16], B[16], S[16];
#pragma unroll
        for (int j = 0; j < 2; ++j)
#pragma unroll
            for (int q = 0; q < 2; ++q) { const int c = 512 * j + 8 * lane + 4 * q;
                if (HAS_RES) { const f32x4 g = *(const f32x4*)(ra.gpost + c), m = *(const f32x4*)(ra.ga + (size_t)cr * NMODC + c);
#pragma unroll
                    for (int e = 0; e < 4; ++e) A[8 * j + 4 * q + e] = g[e] * m[e]; }
                if (HAS_H) { const f32x4 g = *(const f32x4*)(ra.gpre + c), s1 = *(const f32x4*)(ra.sc + (size_t)cr * NMODC + c), s2 = *(const f32x4*)(ra.sh + (size_t)cr * NMODC + c);
#pragma unroll
                    for (int e = 0; e < 4; ++e) { B[8 * j + 4 * q + e] = g[e] * (1.0f + s1[e]); S[8 * j + 4 * q + e] = s2[e]; } } }
#pragma unroll 2
        for (int i = 0; i < 16; ++i) {
            const int row = r0 + i;
            float x[16];
            if constexpr (XIN_BF) {
#pragma unroll
                for (int j = 0; j < 2; ++j) { const u32x4 w = *(const u32x4*)((const bf16_t*)(ra.xb + (size_t)row * 4096) + 512 * j + 8 * lane);
                    x[8 * j + 0] = bf_lo(w.x); x[8 * j + 1] = bf_hi(w.x); x[8 * j + 2] = bf_lo(w.y); x[8 * j + 3] = bf_hi(w.y);
                    x[8 * j + 4] = bf_lo(w.z); x[8 * j + 5] = bf_hi(w.z); x[8 * j + 6] = bf_lo(w.w); x[8 * j + 7] = bf_hi(w.w); }
            } else {
                const float* xr = row < TP ? ra.xin_p + (size_t)row * DM : ra.xin_s + (size_t)(row - TP) * DM;
#pragma unroll
                for (int j = 0; j < 2; ++j)
#pragma unroll
                    for (int q = 0; q < 2; ++q) { const f32x4 v = *(const f32x4*)(xr + 512 * j + 8 * lane + 4 * q);
#pragma unroll
                        for (int e = 0; e < 4; ++e) x[8 * j + 4 * q + e] = v[e]; }
            }
            if (HAS_RES) {
                float sv[16]; float ss = 0.f;
#pragma unroll
                for (int j = 0; j < 2; ++j) { const u32x4 w = *(const u32x4*)(ra.src + (size_t)row * ra.src_ld + 512 * j + 8 * lane);
                    sv[8 * j + 0] = bf_lo(w.x); sv[8 * j + 1] = bf_hi(w.x); sv[8 * j + 2] = bf_lo(w.y); sv[8 * j + 3] = bf_hi(w.y);
                    sv[8 * j + 4] = bf_lo(w.z); sv[8 * j + 5] = bf_hi(w.z); sv[8 * j + 6] = bf_lo(w.w); sv[8 * j + 7] = bf_hi(w.w); }
#pragma unroll
                for (int e = 0; e < 16; ++e) ss += sv[e] * sv[e];
                const float rs = rsqrtf(wave_sum(ss) * (1.0f / DM) + EPS);
#pragma unroll
                for (int e = 0; e < 16; ++e) x[e] += A[e] * (sv[e] * rs);
                if constexpr (XOUT_BF) {
#pragma unroll
                    for (int j = 0; j < 2; ++j) { u32x4 w; w.x = pk2(x[8 * j], x[8 * j + 1]); w.y = pk2(x[8 * j + 2], x[8 * j + 3]); w.z = pk2(x[8 * j + 4], x[8 * j + 5]); w.w = pk2(x[8 * j + 6], x[8 * j + 7]);
                        *(u32x4*)((bf16_t*)(ra.xb + (size_t)row * 4096) + 512 * j + 8 * lane) = w; }
                } else {
#pragma unroll
                    for (int j = 0; j < 2; ++j)
#pragma unroll
                        for (int q = 0; q < 2; ++q) { const f32x4 v = {x[8 * j + 4 * q], x[8 * j + 4 * q + 1], x[8 * j + 4 * q + 2], x[8 * j + 4 * q + 3]};
                            *(f32x4*)(ra.xout + (size_t)row * DM + 512 * j + 8 * lane + 4 * q) = v; }
                }
            }
            if (HAS_H) {
                float ss = 0.f;
#pragma unroll
                for (int e = 0; e < 16; ++e) ss += x[e] * x[e];
                const float rs = rsqrtf(wave_sum(ss) * (1.0f / DM) + EPS);
#pragma unroll
                for (int j = 0; j < 2; ++j) { u32x4 w; float h[8];
#pragma unroll
                    for (int e = 0; e < 8; ++e) h[e] = x[8 * j + e] * rs * B[8 * j + e] + S[8 * j + e];
                    w.x = pk2(h[0], h[1]); w.y = pk2(h[2], h[3]); w.z = pk2(h[4], h[5]); w.w = pk2(h[6], h[7]);
                    *(u32x4*)(ra.hout + (size_t)row * ra.h_ld + 512 * j + 8 * lane) = w; }
            }
        }
    }
}

__device__ __forceinline__ void mid_phase(unsigned char* ws, int l, LAS unsigned char* lds, const int wv) {
    int tid = wv * 64 + (int)__builtin_amdgcn_mbcnt_hi(~0u, __builtin_amdgcn_mbcnt_lo(~0u, 0u)); asm volatile("" : "+v"(tid)); const int lane = tid & 63, wid = wv;
    bf16_t* z = (bf16_t*)(ws + WS_Z); bf16_t* kr = (bf16_t*)(ws + WS_H) + (size_t)T * 768;
    float* rstdq = (float*)(ws + WS_SSQ); float* rstdkv = rstdq + T;
    const float* rope = (const float*)(ws + WS_ROPE);
    const bf16_t* Wsb = (const bf16_t*)(ws + WS_W + l * WL + OW_S);
    const float* g_sgu = INP(15) + l * 512; const float* b_sp = INP(17) + l * 1024;
    LAS bf16_t* vn = (LAS bf16_t*)lds;
    LAS float* part = (LAS float*)(lds + 131072);
    LAS float* rstd_s = part + 1024;
    const int r32 = lane & 31, hi = lane >> 5;
    for (int ch = blockIdx.x; ch < T / 128; ch += gridDim.x) {
        const int R0 = ch * 128;
        float gs[8];
#pragma unroll
        for (int e = 0; e < 8; ++e) gs[e] = g_sgu[8 * lane + e];
        { const int rrow = R0 + wid * 16 + (lane >> 2), L = lane & 3;
          const u32x4 wr_ = *(const u32x4*)(z + (size_t)rrow * LZ + ZKR + 8 * L);
          const f32x4* tp = (const f32x4*)(rope + ((size_t)tok_pos(rrow) * 16 + 8 * (L & 1)) * 2);
          const f32x4 t0 = tp[0], t1 = tp[1], t2 = tp[2], t3 = tp[3];
          const float cs[8] = {t0[0], t0[2], t1[0], t1[2], t2[0], t2[2], t3[0], t3[2]}, sn[8] = {t0[1], t0[3], t1[1], t1[3], t2[1], t2[3], t3[1], t3[3]};
          float mine[8] = {bf_lo(wr_.x), bf_hi(wr_.x), bf_lo(wr_.y), bf_hi(wr_.y), bf_lo(wr_.z), bf_hi(wr_.z), bf_lo(wr_.w), bf_hi(wr_.w)}; float o[8];
#pragma unroll
          for (int e = 0; e < 8; ++e) { const float oth = __shfl_xor(mine[e], 2); o[e] = L < 2 ? (mine[e] * cs[e] - oth * sn[e]) : (oth * sn[e] + mine[e] * cs[e]); }
          u32x4 w; w.x = pk2(o[0], o[1]); w.y = pk2(o[2], o[3]); w.z = pk2(o[4], o[5]); w.w = pk2(o[6], o[7]);
          *(u32x4*)(kr + (size_t)rrow * 32 + 8 * L) = w; }
#pragma unroll 1
        for (int i0 = 0; i0 < 16; i0 += 4) {
            u32x4 wqa[4], wkva[4], wva[4];
#pragma unroll
            for (int k = 0; k < 4; ++k) { const bf16_t* zr = z + (size_t)(R0 + wid * 16 + i0 + k) * LZ;
                wqa[k] = (u32x4){0u, 0u, 0u, 0u}; wkva[k] = (u32x4){0u, 0u, 0u, 0u};
                if (lane < 48) wqa[k] = *(const u32x4*)(zr + ZQ + 8 * lane);
                if (lane < 32) wkva[k] = *(const u32x4*)(zr + ZKV + 8 * lane);
                wva[k] = *(const u32x4*)(zr + ZV + 8 * lane); }
#pragma unroll
            for (int k = 0; k < 4; ++k) {
                const int lr = wid * 16 + i0 + k, row = R0 + lr; const u32x4 wq = wqa[k], wkv = wkva[k], wv = wva[k];
                float sq = 0.f, skv = 0.f;
                { const float f0 = bf_lo(wq.x), f1 = bf_hi(wq.x), f2 = bf_lo(wq.y), f3 = bf_hi(wq.y), f4 = bf_lo(wq.z), f5 = bf_hi(wq.z), f6 = bf_lo(wq.w), f7 = bf_hi(wq.w);
                  sq = (f0 * f0 + f1 * f1) + (f2 * f2 + f3 * f3) + (f4 * f4 + f5 * f5) + (f6 * f6 + f7 * f7); }
                { const float f0 = bf_lo(wkv.x), f1 = bf_hi(wkv.x), f2 = bf_lo(wkv.y), f3 = bf_hi(wkv.y), f4 = bf_lo(wkv.z), f5 = bf_hi(wkv.z), f6 = bf_lo(wkv.w), f7 = bf_hi(wkv.w);
                  skv = (f0 * f0 + f1 * f1) + (f2 * f2 + f3 * f3) + (f4 * f4 + f5 * f5) + (f6 * f6 + f7 * f7); }
                float gv[8];
                gv[0] = gelu_tanh(bf_lo(wv.x)); gv[1] = gelu_tanh(bf_hi(wv.x)); gv[2] = gelu_tanh(bf_lo(wv.y)); gv[3] = gelu_tanh(bf_hi(wv.y));
                gv[4] = gelu_tanh(bf_lo(wv.z)); gv[5] = gelu_tanh(bf_hi(wv.z)); gv[6] = gelu_tanh(bf_lo(wv.w)); gv[7] = gelu_tanh(bf_hi(wv.w));
                float sv = 0.f;
#pragma unroll
                for (int e = 0; e < 8; ++e) sv += gv[e] * gv[e];
                sq = wave_sum(sq); skv = wave_sum(skv); sv = wave_sum(sv);
                if (lane == 0) { rstdq[row] = rsqrtf(sq * (1.0f / 384.0f) + EPS); rstdkv[row] = rsqrtf(skv * (1.0f / 256.0f) + EPS); }
                const float rv = rsqrtf(sv * (1.0f / 512.0f) + EPS);
                { u32x4 o; o.x = pk2(gv[0] * rv * gs[0], gv[1] * rv * gs[1]); o.y = pk2(gv[2] * rv * gs[2], gv[3] * rv * gs[3]);
                  o.z = pk2(gv[4] * rv * gs[4], gv[5] * rv * gs[5]); o.w = pk2(gv[6] * rv * gs[6], gv[7] * rv * gs[7]);
                  *(LAS u32x4*)(vn + lr * 512 + 8 * lane) = o; }
            }
        }
        __syncthreads();
        const int g = wid;
        f32x16 acc[2][4];
#pragma unroll
        for (int ct = 0; ct < 2; ++ct)
#pragma unroll
            for (int tt = 0; tt < 4; ++tt)
#pragma unroll
                for (int r = 0; r < 16; ++r) acc[ct][tt][r] = 0.f;
#pragma unroll 1
        for (int ks = 0; ks < 8; ++ks) {
            bf16x8 af[2], bfr[4];
#pragma unroll
            for (int ct = 0; ct < 2; ++ct)
#pragma unroll
                for (int e = 0; e < 8; ++e) af[ct][e] = (short)vn[(16 * ks + 8 * hi + e) * 512 + 64 * g + 32 * ct + r32];
#pragma unroll
            for (int tt = 0; tt < 4; ++tt) bfr[tt] = *(const bf16x8*)(Wsb + ((size_t)(g * 128 + 32 * tt + r32) * 128 + 16 * ks + 8 * hi));
#pragma unroll
            for (int ct = 0; ct < 2; ++ct)
#pragma unroll
                for (int tt = 0; tt < 4; ++tt) acc[ct][tt] = __builtin_amdgcn_mfma_f32_32x32x16_bf16(af[ct], bfr[tt], acc[ct][tt], 0, 0, 0);
        }
#pragma unroll
        for (int tt = 0; tt < 4; ++tt) { const int t = 32 * tt + r32; const float bias = b_sp[g * 128 + t]; const bf16_t* zu = z + (size_t)(R0 + t) * LZ + ZU + 64 * g; float s = 0.f;
#pragma unroll
            for (int ct = 0; ct < 2; ++ct)
#pragma unroll
                for (int rq = 0; rq < 4; ++rq) { const u32x2 w = *(const u32x2*)(zu + 32 * ct + 8 * rq + 4 * hi);
                    const float u0 = gelu_tanh(bf_lo(w.x)), u1 = gelu_tanh(bf_hi(w.x)), u2 = gelu_tanh(bf_lo(w.y)), u3 = gelu_tanh(bf_hi(w.y));
                    float v0 = u0 * (acc[ct][tt][4 * rq] + bias), v1 = u1 * (acc[ct][tt][4 * rq + 1] + bias), v2 = u2 * (acc[ct][tt][4 * rq + 2] + bias), v3 = u3 * (acc[ct][tt][4 * rq + 3] + bias);
                    acc[ct][tt][4 * rq] = v0; acc[ct][tt][4 * rq + 1] = v1; acc[ct][tt][4 * rq + 2] = v2; acc[ct][tt][4 * rq + 3] = v3;
                    s += (v0 * v0 + v1 * v1) + (v2 * v2 + v3 * v3); }
            s += __shfl_xor(s, 32);
            if (hi == 0) part[g * 128 + t] = s; }
        __syncthreads();
        if (tid < 128) { float s = 0.f;
#pragma unroll
            for (int w = 0; w < 8; ++w) s += part[w * 128 + tid];
            rstd_s[tid] = rsqrtf(s * (1.0f / 512.0f) + EPS); }
        __syncthreads();
#pragma unroll
        for (int tt = 0; tt < 4; ++tt) { const int t = 32 * tt + r32; const float rs = rstd_s[t]; bf16_t* zu = z + (size_t)(R0 + t) * LZ + ZU + 64 * g;
#pragma unroll
            for (int ct = 0; ct < 2; ++ct)
#pragma unroll
                for (int rq = 0; rq < 4; ++rq) { u32x2 w; w.x = pk2(acc[ct][tt][4 * rq] * rs, acc[ct][tt][4 * rq + 1] * rs); w.y = pk2(acc[ct][tt][4 * rq + 2] * rs, acc[ct][tt][4 * rq + 3] * rs);
                    *(u32x2*)(zu + 32 * ct + 8 * rq + 4 * hi) = w; } }
        __syncthreads();
    }
}

constexpr int KROW = 208, VROW = 144, KTILE_B = 64 * KROW, VTILE_B = 64 * VROW;
__device__ __forceinline__ void attn_phase(unsigned char* ws, LAS unsigned char* lds, const int wv) {
    int tid = wv * 64 + (int)__builtin_amdgcn_mbcnt_hi(~0u, __builtin_amdgcn_mbcnt_lo(~0u, 0u)); asm volatile("" : "+v"(tid)); const int lane = tid & 63, wid = wv;
    const bf16_t* Q = (const bf16_t*)(ws + WS_H); const bf16_t* kr = Q + (size_t)T * 768;
    bf16_t* z = (bf16_t*)(ws + WS_Z); const bf16_t* kn = z + ZV; const bf16_t* Vt = (const bf16_t*)(ws + WS_VT);
    float* ssq = (float*)(ws + WS_SSQ);
    const int r32 = lane & 31, hi = lane >> 5, G = gridDim.x;
    LAS unsigned char* Kl = lds; LAS unsigned char* Vl = lds + 2 * KTILE_B;
    const int kc0 = tid, kc1 = tid + 512;
    const int kr0 = kc0 / 12, kp0 = kc0 % 12, kr1 = kc1 / 12, kp1 = kc1 % 12;
    const int vd = tid >> 3, vch = tid & 7;
    for (int it = 0;; ++it) {
        const int flat = it * G + blockIdx.x; if (flat >= 1024) break;
        int seq, head, qb, s0, len;
        { const int v = flat < 512 ? flat : flat - 512; const int x = v & 7, y = v >> 3;
          if (flat < 512) { qb = y & 31; const int pair = x + 8 * (y >> 5); seq = pair >> 3; head = pair & 7; s0 = seq * 8192; len = 8192; }
          else { qb = y & 7; const int pair = x + 8 * (y >> 3); seq = pair >> 3; head = pair & 7; s0 = TP + seq * 2048; len = 2048; } }
        const int NTL = len / 64;
        const int qrow = s0 + qb * 256 + wid * 32 + r32;
        bf16x8 qf[6];
#pragma unroll
        for (int d0 = 0; d0 < 6; ++d0) qf[d0] = *(const bf16x8*)(Q + (size_t)qrow * 768 + head * 96 + d0 * 16 + hi * 8);
        const unsigned ko0 = kp0 < 8 ? (unsigned)(WS_Z + ((size_t)(s0 + kr0) * LZ + ZV + head * 64 + kp0 * 8) * 2) : (unsigned)(WS_H + ((size_t)T * 768 + (size_t)(s0 + kr0) * 32 + (kp0 - 8) * 8) * 2);
        const unsigned kst0 = kp0 < 8 ? 64u * LZ * 2u : 64u * 32u * 2u;
        const unsigned ko1 = kp1 < 8 ? (unsigned)(WS_Z + ((size_t)(s0 + kr1) * LZ + ZV + head * 64 + kp1 * 8) * 2) : (unsigned)(WS_H + ((size_t)T * 768 + (size_t)(s0 + kr1) * 32 + (kp1 - 8) * 8) * 2);
        const unsigned kst1 = kp1 < 8 ? 64u * LZ * 2u : 64u * 32u * 2u;
        const unsigned vo = (unsigned)(WS_VT + ((size_t)(head * 64 + vd) * T + s0 + vch * 8) * 2);
#define KLD0(t) (*(const u32x4*)(ws + (ko0 + (unsigned)(t) * kst0)))
#define KLD1(t) (*(const u32x4*)(ws + (ko1 + (unsigned)(t) * kst1)))
#define VLD(t) (*(const u32x4*)(ws + (vo + (unsigned)(t) * 128u)))
        const int kd0 = kr0 * KROW + kp0 * 16, kd1 = kr1 * KROW + kp1 * 16, vdst = vd * VROW + vch * 16;
        u32x4 rk0, rk1 = {0u, 0u, 0u, 0u}, rv;
        rk0 = KLD0(0); if (tid < 256) rk1 = KLD1(0); rv = VLD(0);
        *(LAS u32x4*)(Kl + kd0) = rk0; if (tid < 256) *(LAS u32x4*)(Kl + kd1) = rk1; *(LAS u32x4*)(Vl + vdst) = rv;
        rk0 = KLD0(1); if (tid < 256) rk1 = KLD1(1);
        *(LAS u32x4*)(Kl + KTILE_B + kd0) = rk0; if (tid < 256) *(LAS u32x4*)(Kl + KTILE_B + kd1) = rk1;
        rk0 = KLD0(2); if (tid < 256) rk1 = KLD1(2); rv = VLD(1);
        __syncthreads();
        f32x16 o0, o1, negm, sc0, sc1; bf16x8 kf[12];
#pragma unroll
        for (int r = 0; r < 16; ++r) { o0[r] = 0.f; o1[r] = 0.f; negm[r] = 0.f; }
        float lsum = 0.f;
        { const LAS unsigned char* Kb = Kl + r32 * KROW + hi * 16;
#pragma unroll
          for (int d0 = 0; d0 < 6; ++d0) { kf[2 * d0] = *(const LAS bf16x8*)(Kb + d0 * 32); kf[2 * d0 + 1] = *(const LAS bf16x8*)(Kb + 32 * KROW + d0 * 32); }
#pragma unroll
          for (int d0 = 0; d0 < 6; ++d0) {
              sc0 = __builtin_amdgcn_mfma_f32_32x32x16_bf16(kf[2 * d0], qf[d0], d0 == 0 ? negm : sc0, 0, 0, 0);
              sc1 = __builtin_amdgcn_mfma_f32_32x32x16_bf16(kf[2 * d0 + 1], qf[d0], d0 == 0 ? negm : sc1, 0, 0, 0); }
          float rm = fmaxf(fmaxf(sc0[0], sc0[1]), sc1[0]);
#pragma unroll
          for (int r = 2; r < 16; r += 2) rm = fmaxf(fmaxf(rm, sc0[r]), sc0[r + 1]);
#pragma unroll
          for (int r = 1; r < 15; r += 2) rm = fmaxf(fmaxf(rm, sc1[r]), sc1[r + 1]);
          rm = fmaxf(rm, sc1[15]);
          rm = fmaxf(rm, __shfl_xor(rm, 32));
#pragma unroll
          for (int r = 0; r < 16; ++r) { sc0[r] -= rm; sc1[r] -= rm; negm[r] = -rm; }
          const LAS unsigned char* Kb1 = Kb + KTILE_B;
#pragma unroll
          for (int d0 = 0; d0 < 6; ++d0) { kf[2 * d0] = *(const LAS bf16x8*)(Kb1 + d0 * 32); kf[2 * d0 + 1] = *(const LAS bf16x8*)(Kb1 + 32 * KROW + d0 * 32); } }
        __syncthreads();
        int vb3 = 0;
#pragma unroll 2
        for (int kt = 0; kt < NTL; ++kt) {
            const int buf = kt & 1; const int vb3n = vb3 == 2 ? 0 : vb3 + 1;
            const int t3 = kt + 3 < NTL ? kt + 3 : NTL - 1, t2 = kt + 2 < NTL ? kt + 2 : NTL - 1;
            *(LAS u32x4*)(Kl + buf * KTILE_B + kd0) = rk0; if (tid < 256) *(LAS u32x4*)(Kl + buf * KTILE_B + kd1) = rk1;
            *(LAS u32x4*)(Vl + vb3n * VTILE_B + vdst) = rv;
            rk0 = KLD0(t3); if (tid < 256) rk1 = KLD1(t3);
            rv = VLD(t2);
            f32x16 sn0, sn1;
#pragma unroll
            for (int d0 = 0; d0 < 6; ++d0) {
                sn0 = __builtin_amdgcn_mfma_f32_32x32x16_bf16(kf[2 * d0], qf[d0], d0 == 0 ? negm : sn0, 0, 0, 0);
                sn1 = __builtin_amdgcn_mfma_f32_32x32x16_bf16(kf[2 * d0 + 1], qf[d0], d0 == 0 ? negm : sn1, 0, 0, 0); }
#pragma unroll
            for (int r = 0; r < 16; ++r) { sc0[r] = __builtin_amdgcn_exp2f(sc0[r]); sc1[r] = __builtin_amdgcn_exp2f(sc1[r]); }
#pragma unroll
            for (int r = 0; r < 16; ++r) { lsum += sc0[r]; asm volatile("" : "+v"(lsum)); lsum += sc1[r]; asm volatile("" : "+v"(lsum)); }
            float lchk = lsum;
            { auto rr = __builtin_amdgcn_permlane32_swap(__float_as_uint(lchk), __float_as_uint(lchk), false, false); lchk = fmaxf(__uint_as_float(rr[0]), __uint_as_float(rr[1])); }
            u32x4 pw[4];
            pw[0] = (u32x4){pk2(sc0[0], sc0[1]), pk2(sc0[2], sc0[3]), pk2(sc0[4], sc0[5]), pk2(sc0[6], sc0[7])};
            pw[1] = (u32x4){pk2(sc0[8], sc0[9]), pk2(sc0[10], sc0[11]), pk2(sc0[12], sc0[13]), pk2(sc0[14], sc0[15])};
            pw[2] = (u32x4){pk2(sc1[0], sc1[1]), pk2(sc1[2], sc1[3]), pk2(sc1[4], sc1[5]), pk2(sc1[6], sc1[7])};
            pw[3] = (u32x4){pk2(sc1[8], sc1[9]), pk2(sc1[10], sc1[11]), pk2(sc1[12], sc1[13]), pk2(sc1[14], sc1[15])};
            asm volatile("s_waitcnt lgkmcnt(0)" ::: "memory"); __builtin_amdgcn_s_barrier(); asm volatile("" ::: "memory");
            { const LAS unsigned char* Kb = Kl + buf * KTILE_B + r32 * KROW + hi * 16;
#pragma unroll
              for (int d0 = 0; d0 < 6; ++d0) { kf[2 * d0] = *(const LAS bf16x8*)(Kb + d0 * 32); kf[2 * d0 + 1] = *(const LAS bf16x8*)(Kb + 32 * KROW + d0 * 32); } }
            { const LAS unsigned char* Vb = Vl + vb3 * VTILE_B + r32 * VROW + hi * 16;
#pragma unroll
              for (int h2 = 0; h2 < 2; ++h2) { bf16x8 vf[4];
#pragma unroll
                  for (int s = 0; s < 2; ++s) { vf[2 * s] = *(const LAS bf16x8*)(Vb + (2 * h2 + s) * 32); vf[2 * s + 1] = *(const LAS bf16x8*)(Vb + 32 * VROW + (2 * h2 + s) * 32); }
#pragma unroll
                  for (int s = 0; s < 2; ++s) {
                      const bf16x8 pb = __builtin_bit_cast(bf16x8, pw[2 * h2 + s]);
                      o0 = __builtin_amdgcn_mfma_f32_32x32x16_bf16(vf[2 * s], pb, o0, 0, 0, 0);
                      o1 = __builtin_amdgcn_mfma_f32_32x32x16_bf16(vf[2 * s + 1], pb, o1, 0, 0, 0); } } }
            if (__any(lchk > 1.0e12f)) {
                const float dl = fmaxf(floorf(__builtin_amdgcn_logf(lchk)), 0.f); const float f = __builtin_amdgcn_exp2f(-dl);
                lsum *= f; const float nm = negm[0] - dl;
#pragma unroll
                for (int r = 0; r < 16; ++r) { sn0[r] -= dl; sn1[r] -= dl; o0[r] *= f; o1[r] *= f; negm[r] = nm; }
            }
            sc0 = sn0; sc1 = sn1; vb3 = vb3n;
        }
        __syncthreads();
        lsum += __shfl_xor(lsum, 32);
        const float inv = 1.0f / lsum;
        bf16_t* orow = z + (size_t)qrow * LZ + ZATT + head * 64;
        float sq = 0.f;
#pragma unroll
        for (int rq = 0; rq < 4; ++rq) {
            const float a0 = o0[4 * rq] * inv, a1 = o0[4 * rq + 1] * inv, a2 = o0[4 * rq + 2] * inv, a3 = o0[4 * rq + 3] * inv;
            const float b0 = o1[4 * rq] * inv, b1 = o1[4 * rq + 1] * inv, b2 = o1[4 * rq + 2] * inv, b3 = o1[4 * rq + 3] * inv;
            sq += (a0 * a0 + a1 * a1) + (a2 * a2 + a3 * a3) + (b0 * b0 + b1 * b1) + (b2 * b2 + b3 * b3);
            u32x2 w0, w1; w0.x = pk2(a0, a1); w0.y = pk2(a2, a3); w1.x = pk2(b0, b1); w1.y = pk2(b2, b3);
            *(u32x2*)(orow + 8 * rq + 4 * hi) = w0; *(u32x2*)(orow + 32 + 8 * rq + 4 * hi) = w1;
        }
        sq += __shfl_xor(sq, 32);
        if (hi == 0) ssq[(size_t)qrow * 8 + head] = sq;
    }
}

#define XB_TMO      128
#define XB_XCNT(j)  (256  + 64 * (j))
#define XB_XSUB(j)  (1280 + 64 * (j))
#define XB_XGEN(j)  (2304 + 64 * (j))
#define XB_TOP      3328
#define XB_TOPGEN   3392
#define XCD_BAR_WORDS 3456
#define XB_SPIN_CAP (1u << 18)

__device__ __forceinline__ unsigned xb_ld(unsigned* p)              { return __hip_atomic_load(p, __ATOMIC_RELAXED, __HIP_MEMORY_SCOPE_AGENT); }
__device__ __forceinline__ unsigned xb_add(unsigned* p, unsigned v) { return __hip_atomic_fetch_add(p, v, __ATOMIC_RELAXED, __HIP_MEMORY_SCOPE_AGENT); }
__device__ __forceinline__ unsigned xb_xcc_id() { return (unsigned)__builtin_amdgcn_s_getreg((3 << 11) | 20) & 0xFu; }
#define XB_SPIN(cond, bar) do { unsigned _sp = 0; while (cond) { __builtin_amdgcn_s_sleep(1); \
    if ((++_sp & 255u) == 0u) { if (xb_ld(&(bar)[XB_TMO])) break; if (_sp > XB_SPIN_CAP) { atomicAdd(&(bar)[XB_TMO], 1u); break; } } } } while (0)

struct XcdBarrier {
    unsigned* bar; unsigned x;
    volatile LAS unsigned* st;
};

__device__ __forceinline__ XcdBarrier xcd_barrier_post(unsigned* bar, volatile LAS unsigned* st, const bool t0  ) {
    XcdBarrier b; b.bar = bar; b.x = xb_xcc_id(); b.st = st;
    if (t0) (void)xb_add(&bar[XB_XCNT(b.x)], 1u);
    return b;
}
__device__ __forceinline__ void xcd_barrier_complete(unsigned* bar, unsigned x, unsigned& nloc, unsigned& nx) {
    const unsigned G = gridDim.x * gridDim.y * gridDim.z;
    unsigned sum, cnt, mine, sp = 0u;
    for (;;) {
        sum = 0u; cnt = 0u; mine = 0u;
#pragma unroll
        for (unsigned j = 0; j < 16; ++j) { const unsigned c = xb_ld(&bar[XB_XCNT(j)]); sum += c; cnt += (c > 0u) ? 1u : 0u; mine = (j == x) ? c : mine; }
        if (sum == G) break;
        __builtin_amdgcn_s_sleep(1);
        if ((++sp & 255u) == 0u) { if (xb_ld(&bar[XB_TMO])) break; if (sp > XB_SPIN_CAP) { atomicAdd(&bar[XB_TMO], 1u); break; } }
    }
    nloc = mine > 0u ? mine : 1u; nx = cnt > 0u ? cnt : 1u;
}

__device__ __forceinline__ void xcd_barrier(const XcdBarrier& b, const int wv) {
    asm volatile("s_waitcnt vmcnt(0)" ::: "memory");
    __syncthreads();
    if (wv == 0 && (int)__builtin_amdgcn_mbcnt_hi(~0u, __builtin_amdgcn_mbcnt_lo(~0u, 0u)) == 0) {
        unsigned* bar = b.bar; unsigned bx = b.x; asm volatile("" : "+s"(bx));
        __builtin_amdgcn_s_waitcnt(0);
        unsigned nloc = b.st[0], nx = b.st[1];
        if (nloc == 0u) { xcd_barrier_complete(bar, bx, nloc, nx); b.st[0] = nloc; b.st[1] = nx; }
        const unsigned old = xb_add(&bar[XB_XSUB(bx)], 1u);
        const unsigned gen = old / nloc;
        if (old + 1u == (gen + 1u) * nloc) {
            __builtin_amdgcn_fence(__ATOMIC_RELEASE, "agent");
            asm volatile("s_waitcnt vmcnt(0)" ::: "memory");
            const unsigned og = xb_add(&bar[XB_TOP], 1u);
            const unsigned tg = og / nx;
            if (og + 1u == (tg + 1u) * nx) xb_add(&bar[XB_TOPGEN], 1u);
            else XB_SPIN(xb_ld(&bar[XB_TOPGEN]) == tg, bar);
            __builtin_amdgcn_fence(__ATOMIC_ACQUIRE, "agent");
            xb_add(&bar[XB_XGEN(bx)], 1u);
            asm volatile("s_waitcnt vmcnt(0)" ::: "memory");
        } else {
            XB_SPIN(xb_ld(&bar[XB_XGEN(bx)]) == gen, bar);
            __builtin_amdgcn_fence(__ATOMIC_ACQUIRE, "agent");
            asm volatile("s_waitcnt vmcnt(0)" ::: "memory");
        }
    }
    __syncthreads();
}

__global__ void __launch_bounds__(512, 2) fwd_kernel(Args a) {
    __shared__ __attribute__((aligned(16))) unsigned char lds_raw[LDS_BYTES];
    cg::grid_group grid = cg::this_grid();
    LAS unsigned char* lds = (LAS unsigned char*)lds_raw;
    const int wv = __builtin_amdgcn_readfirstlane((int)threadIdx.x >> 6);
    const bool t0 = wv == 0 && (int)__builtin_amdgcn_mbcnt_hi(~0u, __builtin_amdgcn_mbcnt_lo(~0u, 0u)) == 0;
    unsigned char* ws = a.ws;

    if (t0) { LAS long long* tab = (LAS long long*)(lds + TAB_OFF); ((LAS unsigned*)(lds + TAB_OFF + 224))[0] = 0u; ((LAS unsigned*)(lds + TAB_OFF + 224))[1] = 0u;
        tab[0] = (long long)((const unsigned char*)a.in[0] - (const unsigned char*)a.ws);
        tab[1] = (long long)((const unsigned char*)a.in[1] - (const unsigned char*)a.ws);
        tab[2] = (long long)((const unsigned char*)a.in[2] - (const unsigned char*)a.ws);
        tab[3] = (long long)((const unsigned char*)a.in[3] - (const unsigned char*)a.ws);
        tab[4] = (long long)((const unsigned char*)a.in[4] - (const unsigned char*)a.ws);
        tab[5] = (long long)((const unsigned char*)a.in[5] - (const unsigned char*)a.ws);
        tab[6] = (long long)((const unsigned char*)a.in[6] - (const unsigned char*)a.ws);
        tab[7] = (long long)((const unsigned char*)a.in[7] - (const unsigned char*)a.ws);
        tab[8] = (long long)((const unsigned char*)a.in[8] - (const unsigned char*)a.ws);
        tab[9] = (long long)((const unsigned char*)a.in[9] - (const unsigned char*)a.ws);
        tab[10] = (long long)((const unsigned char*)a.in[10] - (const unsigned char*)a.ws);
        tab[11] = (long long)((const unsigned char*)a.in[11] - (const unsigned char*)a.ws);
        tab[12] = (long long)((const unsigned char*)a.in[12] - (const unsigned char*)a.ws);
        tab[13] = (long long)((const unsigned char*)a.in[13] - (const unsigned char*)a.ws);
        tab[14] = (long long)((const unsigned char*)a.in[14] - (const unsigned char*)a.ws);
        tab[15] = (long long)((const unsigned char*)a.in[15] - (const unsigned char*)a.ws);
        tab[16] = (long long)((const unsigned char*)a.in[16] - (const unsigned char*)a.ws);
        tab[17] = (long long)((const unsigned char*)a.in[17] - (const unsigned char*)a.ws);
        tab[18] = (long long)((const unsigned char*)a.in[18] - (const unsigned char*)a.ws);
        tab[19] = (long long)((const unsigned char*)a.in[19] - (const unsigned char*)a.ws);
        tab[20] = (long long)((const unsigned char*)a.in[20] - (const unsigned char*)a.ws);
        tab[21] = (long long)((const unsigned char*)a.in[21] - (const unsigned char*)a.ws);
        tab[22] = (long long)((const unsigned char*)a.in[22] - (const unsigned char*)a.ws);
        tab[23] = (long long)((const unsigned char*)a.in[23] - (const unsigned char*)a.ws);
    }
    __syncthreads();
    const XcdBarrier bar = xcd_barrier_post((unsigned*)ws, (volatile LAS unsigned*)(lds + TAB_OFF + 224), t0);
    float* const xout = a.out;
#define WSL(w) size_t w##_z = 0; asm volatile("" : "+s"(w##_z)); unsigned char* w = ws + w##_z
#define HB(w) ((bf16_t*)((w) + WS_H))
#define ZB(w) ((bf16_t*)((w) + WS_Z))
#define MODP(w) ((const float*)((w) + WS_MOD))
    p0_phase(ws, lds, wv);
    grid.sync();
    { WSL(w); RowArgs ra{nullptr, INP(0), INP(1), nullptr, nullptr, nullptr, INP(6), MODP(w) + 1024, MODP(w), HB(w), nullptr, 0, DM}; row_phase<false, true, false, true>(ra, wv); }
    xcd_barrier(bar, wv);
#pragma unroll 1
    for (int l = 0; l < NLAYER; ++l) {
        { WSL(w); int Gl = gridDim.x, bl = blockIdx.x; asm volatile("" : "+s"(Gl), "+s"(bl));
          pg8::Gemm g{HB(w), (const bf16_t*)(w + WS_W + (size_t)l * WL + OW_IN), T, NIN, 1024, 1024}; pg8::StaticOrder S; S.init(T, NIN, Gl, bl);
          pg8::EpiStore<false> E{ZB(w), LZ, LZ, nullptr}; pg8::gemm_phase<pg8::EpiStore<false>, pg8::StaticOrder, true, true>(lds, g, S, E, wv); }
        if (l == 0) {
            WSL(w2); int G2 = gridDim.x, b2 = blockIdx.x; asm volatile("" : "+s"(G2), "+s"(b2));
            const int nu = (T / 256) * (NIN / 256), rounds = (nu + G2 - 1) / G2, first_idle = nu - (rounds - 1) * G2, nidle = G2 - first_idle;
            int wvl_ = wv; asm volatile("" : "+s"(wvl_)); unsigned z_ = 0u; asm volatile("" : "+v"(z_));
            int tid2 = wvl_ * 64 + (int)__builtin_amdgcn_mbcnt_hi(~0u, __builtin_amdgcn_mbcnt_lo(~0u, z_)); asm volatile("" : "+v"(tid2));
            if (nidle == 0) wt_convert(w2, lds, 1, 0, 3500, b2, G2, tid2, tid2 & 63, wv);
            else if (b2 >= first_idle) wt_convert(w2, lds, 1, 0, 3500, b2 - first_idle, nidle, tid2, tid2 & 63, wv);
            __syncthreads(); }
        xcd_barrier(bar, wv);
        { WSL(w); mid_phase(w, l, lds, wv); }
        xcd_barrier(bar, wv);
        { WSL(w); int Gl = gridDim.x, bl = blockIdx.x; asm volatile("" : "+s"(Gl), "+s"(bl));
          pg8::Gemm g{ZB(w) + ZQ, (const bf16_t*)(w + WS_W + (size_t)l * WL + OW_QB), T, 768, 384, LZ}; pg8::StaticOrder S; S.init(T, 768, Gl, bl);
          pg8::EpiQ E{HB(w), (const float*)(w + WS_ROPE), (const float*)(w + WS_SSQ)}; pg8::gemm_phase<pg8::EpiQ, pg8::StaticOrder, true, true>(lds, g, S, E, wv); }
        if (l == 0) {
            WSL(w2); int G2 = gridDim.x, b2 = blockIdx.x; asm volatile("" : "+s"(G2), "+s"(b2));
            const int nu = (T / 256) * (768 / 256), rounds = (nu + G2 - 1) / G2, first_idle = nu - (rounds - 1) * G2, nidle = G2 - first_idle;
            int wvl_ = wv; asm volatile("" : "+s"(wvl_)); unsigned z_ = 0u; asm volatile("" : "+v"(z_));
            int tid2 = wvl_ * 64 + (int)__builtin_amdgcn_mbcnt_hi(~0u, __builtin_amdgcn_mbcnt_lo(~0u, z_)); asm volatile("" : "+v"(tid2));
            if (nidle == 0) wt_convert(w2, lds, 1, 3500, WT_NITEMS, b2, G2, tid2, tid2 & 63, wv);
            else if (b2 >= first_idle) wt_convert(w2, lds, 1, 3500, WT_NITEMS, b2 - first_idle, nidle, tid2, tid2 & 63, wv);
            __syncthreads(); }
        { WSL(w); int Gl = gridDim.x, bl = blockIdx.x; asm volatile("" : "+s"(Gl), "+s"(bl));
          pg8::Gemm g{ZB(w) + ZKV, (const bf16_t*)(w + WS_W + (size_t)l * WL + OW_KVB), T, 1024, 256, LZ}; pg8::StaticOrder S; S.init(T, 1024, Gl, bl);
          pg8::EpiKV E{ZB(w) + ZV, (bf16_t*)(w + WS_VT), (const float*)(w + WS_SSQ) + T}; pg8::gemm_phase<pg8::EpiKV, pg8::StaticOrder, true, true>(lds, g, S, E, wv); }
        xcd_barrier(bar, wv);
        { WSL(w); attn_phase(w, lds, wv); }
        xcd_barrier(bar, wv);
        { WSL(w); int Gl = gridDim.x, bl = blockIdx.x; asm volatile("" : "+s"(Gl), "+s"(bl));
          pg8::Gemm g{ZB(w) + ZATT, (const bf16_t*)(w + WS_W + (size_t)l * WL + OW_OUT), T, 1024, 1024, LZ}; pg8::StaticOrder S; S.init(T, 1024, Gl, bl);
          pg8::EpiStore<true> E{HB(w), DM, DM, (const float*)(w + WS_SSQ)}; pg8::gemm_phase<pg8::EpiStore<true>, pg8::StaticOrder, true, true>(lds, g, S, E, wv); }
        xcd_barrier(bar, wv);
        { WSL(w); const float* modl = MODP(w) + (size_t)l * NCR * NMODC;
          RowArgs ra{HB(w), INP(0), INP(1), nullptr, INP(7) + l * DM, modl + 2048, INP(8) + l * DM, modl + 4096, modl + 3072, EB(xout), (unsigned char*)xout, DM, 2048};
          if (l == 0) row_phase<true, true, false, true>(ra, wv); else row_phase<true, true, true, true>(ra, wv); }
        xcd_barrier(bar, wv);
        { WSL(w); int Gl = gridDim.x, bl = blockIdx.x; asm volatile("" : "+s"(Gl), "+s"(bl));
          pg8::Gemm g{EB(xout), (const bf16_t*)(w + WS_W + (size_t)l * WL + OW_GU), T, NGU, 1024, 2048}; pg8::StaticOrder S; S.init(T, NGU, Gl, bl);
          pg8::EpiGU E{HB(w)}; pg8::gemm_phase<pg8::EpiGU, pg8::StaticOrder, true, true>(lds, g, S, E, wv); }
        xcd_barrier(bar, wv);
        { WSL(w); int Gl = gridDim.x, bl = blockIdx.x; asm volatile("" : "+s"(Gl), "+s"(bl));
          pg8::Gemm g{HB(w), (const bf16_t*)(w + WS_W + (size_t)l * WL + OW_D), T, 1024, DFF, DFF}; pg8::StaticOrder S; S.init(T, 1024, Gl, bl);
          pg8::EpiStore<false> E{EB(xout), 2048, DM, nullptr}; pg8::gemm_phase<pg8::EpiStore<false>, pg8::StaticOrder, true, true>(lds, g, S, E, wv); }
        xcd_barrier(bar, wv);
        if (l + 1 < NLAYER) {
            WSL(w); const float* modl = MODP(w) + (size_t)l * NCR * NMODC; const float* modn = modl + NCR * NMODC;
            RowArgs ra{EB(xout), nullptr, nullptr, nullptr, INP(9) + l * DM, modl + 5120, INP(6) + (l + 1) * DM, modn + 1024, modn, HB(w), (unsigned char*)xout, 2048, DM};
            row_phase<true, true, true, true>(ra, wv);
            xcd_barrier(bar, wv);
        } else {
            WSL(w); const float* modl = MODP(w) + (size_t)l * NCR * NMODC;
            RowArgs ra{EB(xout), nullptr, nullptr, xout, INP(9) + l * DM, modl + 5120, nullptr, nullptr, nullptr, nullptr, (unsigned char*)xout, 2048, 0};
            row_phase<true, false, true, false>(ra, wv);
        }
    }
}

extern "C" void kernel_launch(void* const* d_in, const int* in_sizes, int n_in, void* d_out, int out_size, void* d_ws, size_t ws_size, hipStream_t stream) {
    static int grid = 0;
    if (grid == 0) {
        if (n_in != 24 || out_size != T * DM || ws_size < WS_END) { fprintf(stderr, "kernel_launch: unexpected problem (n_in %d out %d ws %zu)\n", n_in, out_size, ws_size); grid = -1; return; }
        int dev = 0, cus = 0, per_cu = 0;
        hipGetDevice(&dev); hipDeviceGetAttribute(&cus, hipDeviceAttributeMultiprocessorCount, dev);
        hipOccupancyMaxActiveBlocksPerMultiprocessor(&per_cu, (const void*)fwd_kernel, 512, 0);
        if (per_cu < 1) per_cu = 1;
        grid = cus * per_cu;
        fprintf(stderr, "kernel_launch: grid %d (cus %d x %d)\n", grid, cus, per_cu);
    }
    if (grid < 0) return;
    if (hipMemsetAsync(d_ws, 0, 16384, stream) != hipSuccess) { fprintf(stderr, "kernel_launch: memset failed\n"); return; }
    Args a{};
    for (int i = 0; i < 24; ++i) a.in[i] = (const float*)d_in[i];
    a.out = (float*)d_out; a.ws = (unsigned char*)d_ws;
    void* args[] = {&a};
    hipError_t e = hipLaunchCooperativeKernel((const void*)fwd_kernel, dim3(grid), dim3(512), args, 0, stream);
    if (e != hipSuccess) fprintf(stderr, "cooperative launch failed: %s (grid %d)\n", hipGetErrorString(e), grid);
}
```

```cpp
#include <hip/hip_runtime.h>
#include <hip/hip_cooperative_groups.h>
#include <cstdio>
#include <cstdint>
namespace cg = cooperative_groups;
namespace pg8 {
#define PG8_LAS __attribute__((address_space(3)))
typedef unsigned short bf16_t;
typedef short bf16x8 __attribute__((ext_vector_type(8)));
typedef float f32x4 __attribute__((ext_vector_type(4)));
typedef unsigned u32x4 __attribute__((ext_vector_type(4)));
constexpr int BM = 256, BK = 64, HALF = 128, HTB = HALF * BK * 2  , STAGE_BYTES = 8 * HTB, NXCD = 8, WGM = 8;

__host__ __device__ __forceinline__ int lds_byte(int r, int c) { const int st = (r >> 4) * 2 + (c >> 5), rr = r & 15, cc = c & 31, ob = rr * 64 + cc * 2; return st * 1024 + (ob ^ (((ob >> 9) & 1) << 5)); }
__host__ __device__ __forceinline__ void stage_rc(int b, int& R, int& C) { const int st = b / 1024, sb = b % 1024, swz = sb ^ (((sb >> 9) & 1) << 5); R = (st >> 1) * 16 + swz / 64; C = (st & 1) * 32 + (swz % 64) / 2; }
__host__ __device__ __forceinline__ int perm32(int rho) { const int n = rho >> 4, i = rho & 15; return 8 * (i >> 2) + 4 * n + (i & 3); }

struct Unit { int pm, pn; };
struct Gemm { const bf16_t* A; const bf16_t* Bt; int M, N, K, lda; };

struct StaticOrder {
    int nM, nN, nwg, G, c;
    __host__ __device__ void init(int M, int N, int G_, int c_) { nM = M / BM; nN = N / BM; nwg = nM * nN; G = G_; c = c_; }
    __host__ __device__ bool next(int i, Unit& u) const {
        const long L = (long)i * G + c; if (L >= nwg) return false;
        int wgid = (int)L; { const int q = nwg / NXCD, r = nwg % NXCD, xcd = wgid % NXCD, off = wgid / NXCD; wgid = (xcd < r ? xcd * (q + 1) : r * (q + 1) + (xcd - r) * q) + off; }
        const int nig = WGM * nN, gid = wgid / nig, fm = gid * WGM, gsz = (nM - fm) < WGM ? (nM - fm) : WGM;
        u.pm = fm + ((wgid % nig) % gsz); u.pn = (wgid % nig) / gsz; return true;
    }
    __device__ __forceinline__ void a_ready(const Unit&) const {}
    __device__ __forceinline__ void done(const Unit&) const {}
};

__device__ __forceinline__ unsigned cvt_pk_bf16(float lo, float hi) { unsigned r; asm volatile("v_cvt_pk_bf16_f32 %0, %1, %2" : "=v"(r) : "v"(lo), "v"(hi)); return r; }
typedef float f32x2 __attribute__((ext_vector_type(2)));
template <class Epi, class Sched, bool ALIGN_EPI = false, bool SP2 = false>
__device__ __forceinline__ void gemm_phase(PG8_LAS unsigned char* lds, const Gemm g, const Sched& S, const Epi& E, const int wv  ) {
    int tid0_ = wv * 64 + (int)__builtin_amdgcn_mbcnt_hi(~0u, __builtin_amdgcn_mbcnt_lo(~0u, 0u)); asm volatile("" : "+v"(tid0_));
    const int tid = tid0_, wid = __builtin_amdgcn_readfirstlane(tid >> 6), lane = tid & 63, wr = wid >> 2, wc = wid & 3, fr = lane & 15, fq = lane >> 4;
    const int K = g.K, nt = K / BK;
    unsigned voffA[2], voffB[2];
#pragma unroll
    for (int i = 0; i < 2; ++i) { int R, C; stage_rc(tid * 16 + i * 8192, R, C); const int Rb = Epi::PERM ? ((R & ~31) + perm32(R & 31)) : R;
        voffA[i] = (unsigned)(R * g.lda + C) * 2u; voffB[i] = (unsigned)(Rb * K + C) * 2u; }
    const size_t kstep = (size_t)(BK * 2);
    const size_t hstepB = (size_t)HALF * K * 2, hstepA = (size_t)HALF * g.lda * 2;
    const size_t tstepB = 2 * hstepB, tstepA = 2 * hstepA;
    const unsigned ldsw = (unsigned)wid * 1024u;
    const int aoff = lds_byte(wr * 64 + fr, fq * 8), boff = lds_byte(wc * 32 + fr, fq * 8);
#define PG8_SA(b, h) (((b) * 2 + (h)) * HTB)
#define PG8_SB(b, h) ((4 + (b) * 2 + (h)) * HTB)
#define PG8_STAGE(bufoff, gbase, voff) do { _Pragma("unroll") for (int _i = 0; _i < 2; ++_i) \
        __builtin_amdgcn_global_load_lds((const unsigned*)((const char*)(gbase) + (voff)[_i]), (PG8_LAS unsigned*)(lds + (bufoff) + ldsw + _i * 8192), 16, 0, 0); } while (0)
#define PG8_LDA(dst, b, h) do { _Pragma("unroll") for (int m = 0; m < 4; ++m) _Pragma("unroll") for (int k = 0; k < 2; ++k) dst[m][k] = *(const PG8_LAS bf16x8*)(lds + PG8_SA(b, h) + aoff + m * 2048 + k * 1024); } while (0)
#define PG8_LDB(dst, b, h) do { _Pragma("unroll") for (int n = 0; n < 2; ++n) _Pragma("unroll") for (int k = 0; k < 2; ++k) dst[n][k] = *(const PG8_LAS bf16x8*)(lds + PG8_SB(b, h) + boff + n * 2048 + k * 1024); } while (0)
#define PG8_MMA(ai, bj, At, Bt) do { __builtin_amdgcn_s_setprio(1); _Pragma("unroll") for (int m = 0; m < 4; ++m) _Pragma("unroll") for (int n = 0; n < 2; ++n) _Pragma("unroll") for (int k = 0; k < 2; ++k) \
        acc[ai][bj][m][n] = __builtin_amdgcn_mfma_f32_16x16x32_bf16(Bt[n][k], At[m][k], acc[ai][bj][m][n], 0, 0, 0); __builtin_amdgcn_s_setprio(0); } while (0)
#define PG8_WAIT_V(n) asm volatile("s_waitcnt vmcnt(" #n ")" ::: "memory")
#define PG8_WAIT_L(n) asm volatile("s_waitcnt lgkmcnt(" #n ")" ::: "memory")
#define PG8_BAR __builtin_amdgcn_s_barrier()
#define PG8_SCHED __builtin_amdgcn_sched_barrier(0)
    Unit cur, nxt; int ui = 0;
    if (!S.next(0, cur)) return;
    f32x4 acc[2][2][4][2];
#pragma unroll
    for (int a = 0; a < 2; ++a)
#pragma unroll
        for (int b = 0; b < 2; ++b)
#pragma unroll
            for (int m = 0; m < 4; ++m)
#pragma unroll
                for (int n = 0; n < 2; ++n) acc[a][b][m][n] = (f32x4){0.f, 0.f, 0.f, 0.f};
    bf16x8 At[4][2], B0[2][2], B1[2][2];
    const char* cA = (const char*)g.A + (size_t)cur.pm * tstepA; const char* cB = (const char*)g.Bt + (size_t)cur.pn * tstepB;
    S.a_ready(cur);
    if constexpr (SP2) {
        PG8_STAGE(PG8_SB(0, 0), cB, voffB); PG8_STAGE(PG8_SB(0, 1), cB + hstepB, voffB); PG8_STAGE(PG8_SA(0, 0), cA, voffA); PG8_STAGE(PG8_SA(0, 1), cA + hstepA, voffA);
        if (wr == 1) PG8_BAR;
        PG8_WAIT_V(2); PG8_BAR;
        PG8_STAGE(PG8_SB(1, 0), cB + kstep, voffB); PG8_STAGE(PG8_SA(1, 0), cA + kstep, voffA); PG8_STAGE(PG8_SB(1, 1), cB + hstepB + kstep, voffB);
        PG8_WAIT_V(6); PG8_BAR;
    } else {
        PG8_STAGE(PG8_SB(0, 0), cB, voffB); PG8_STAGE(PG8_SA(0, 0), cA, voffA); PG8_STAGE(PG8_SB(0, 1), cB + hstepB, voffB); PG8_STAGE(PG8_SA(0, 1), cA + hstepA, voffA);
        if (wr == 1) PG8_BAR;
        PG8_WAIT_V(4); PG8_BAR;
        PG8_STAGE(PG8_SB(1, 0), cB + kstep, voffB); PG8_STAGE(PG8_SA(1, 0), cA + kstep, voffA); PG8_STAGE(PG8_SB(1, 1), cB + hstepB + kstep, voffB);
        PG8_WAIT_V(6); PG8_BAR;
    }
    for (;;) {
        const bool has_next = S.next(ui + 1, nxt);
        const char* nA = has_next ? (const char*)g.A + (size_t)nxt.pm * tstepA : cA; const char* nB = has_next ? (const char*)g.Bt + (size_t)nxt.pn * tstepB : cB;
#pragma unroll 1
        for (int t = 0; t < nt; t += 2) {
            const bool last = (t == nt - 2);
            if constexpr (Epi::MIDK) { if (t == 8) E.midk(acc, cur, wr, fr); }
            const char* a1 = cA + (size_t)(t + 1) * kstep;
            const char* a2 = last ? nA : cA + (size_t)(t + 2) * kstep; const char* b2 = last ? nB : cB + (size_t)(t + 2) * kstep;
            const char* a3 = a2 + kstep; const char* b3 = b2 + kstep;
            if (last && has_next) S.a_ready(nxt);
            if constexpr (SP2) {
            PG8_LDB(B0, 0, 0); PG8_LDB(B1, 0, 1); PG8_SCHED; PG8_LDA(At, 0, 0); PG8_STAGE(PG8_SA(1, 1), a1 + hstepA, voffA);
            PG8_WAIT_V(8); PG8_WAIT_L(0); PG8_BAR; PG8_MMA(0, 0, At, B0); PG8_MMA(0, 1, At, B1); PG8_BAR; PG8_SCHED;
            PG8_LDA(At, 0, 1); PG8_STAGE(PG8_SB(0, 0), b2, voffB); PG8_STAGE(PG8_SB(0, 1), b2 + hstepB, voffB); PG8_STAGE(PG8_SA(0, 0), a2, voffA);
            PG8_WAIT_V(8); PG8_WAIT_L(0); PG8_BAR; PG8_MMA(1, 0, At, B0); PG8_MMA(1, 1, At, B1); PG8_BAR; PG8_SCHED;
            PG8_LDB(B0, 1, 0); PG8_LDB(B1, 1, 1); PG8_SCHED; PG8_LDA(At, 1, 0); PG8_STAGE(PG8_SA(0, 1), a2 + hstepA, voffA);
            PG8_WAIT_V(8); PG8_WAIT_L(0); PG8_BAR; PG8_MMA(0, 0, At, B0); PG8_MMA(0, 1, At, B1); PG8_BAR; PG8_SCHED;
            PG8_LDA(At, 1, 1); PG8_STAGE(PG8_SB(1, 0), b3, voffB); PG8_STAGE(PG8_SB(1, 1), b3 + hstepB, voffB); PG8_STAGE(PG8_SA(1, 0), a3, voffA);
            PG8_WAIT_V(8); PG8_WAIT_L(0); PG8_BAR; PG8_MMA(1, 0, At, B0); PG8_MMA(1, 1, At, B1); PG8_BAR; PG8_SCHED;
            } else {
            PG8_LDB(B0, 0, 0); PG8_SCHED; PG8_LDA(At, 0, 0); PG8_STAGE(PG8_SA(1, 1), a1 + hstepA, voffA);
            PG8_WAIT_L(8); PG8_BAR; PG8_WAIT_L(0); PG8_MMA(0, 0, At, B0); PG8_BAR; PG8_SCHED;
            PG8_LDB(B1, 0, 1); PG8_STAGE(PG8_SB(0, 0), b2, voffB);
            PG8_BAR; PG8_WAIT_L(0); PG8_MMA(0, 1, At, B1); PG8_BAR;
            PG8_LDA(At, 0, 1); PG8_STAGE(PG8_SA(0, 0), a2, voffA);
            PG8_BAR; PG8_WAIT_L(0); PG8_MMA(1, 0, At, B0); PG8_BAR; PG8_SCHED;
            PG8_STAGE(PG8_SB(0, 1), b2 + hstepB, voffB);
            PG8_WAIT_V(6); PG8_BAR; PG8_MMA(1, 1, At, B1); PG8_BAR;
            PG8_LDB(B0, 1, 0); PG8_SCHED; PG8_LDA(At, 1, 0); PG8_STAGE(PG8_SA(0, 1), a2 + hstepA, voffA);
            PG8_WAIT_L(8); PG8_BAR; PG8_WAIT_L(0); PG8_MMA(0, 0, At, B0); PG8_BAR; PG8_SCHED;
            PG8_LDB(B1, 1, 1); PG8_STAGE(PG8_SB(1, 0), b3, voffB);
            PG8_BAR; PG8_WAIT_L(0); PG8_MMA(0, 1, At, B1); PG8_BAR;
            PG8_LDA(At, 1, 1); PG8_STAGE(PG8_SA(1, 0), a3, voffA);
            PG8_BAR; PG8_WAIT_L(0); PG8_MMA(1, 0, At, B0); PG8_BAR; PG8_SCHED;
            PG8_STAGE(PG8_SB(1, 1), b3 + hstepB, voffB);
            PG8_WAIT_V(6); PG8_BAR; PG8_MMA(1, 1, At, B1); PG8_BAR;
            }
        }
        if constexpr (ALIGN_EPI) { if (wr == 0) PG8_BAR; }
        if constexpr (!Epi::AFTER_DRAIN) { E(acc, cur, wr, wc, fr, fq); S.done(cur); }
        if (!has_next) break;
#pragma unroll
        for (int a = 0; a < 2; ++a)
#pragma unroll
            for (int b = 0; b < 2; ++b)
#pragma unroll
                for (int m = 0; m < 4; ++m)
#pragma unroll
                    for (int n = 0; n < 2; ++n) acc[a][b][m][n] = (f32x4){0.f, 0.f, 0.f, 0.f};
        cur = nxt; cA = nA; cB = nB; ++ui;
        if constexpr (ALIGN_EPI) { if (wr == 1) PG8_BAR; }
    }
    PG8_WAIT_V(0);
    if constexpr (!ALIGN_EPI) { if (wr == 0) PG8_BAR; }
    PG8_BAR;
    if constexpr (Epi::AFTER_DRAIN) { E.fused(acc, cur, wr, wc, fr, fq, lds, wid, lane); S.done(cur); }
#undef PG8_SA
#undef PG8_SB
#undef PG8_STAGE
#undef PG8_LDA
#undef PG8_LDB
#undef PG8_MMA
#undef PG8_WAIT_V
#undef PG8_WAIT_L
#undef PG8_BAR
#undef PG8_SCHED
}
}

#define LAS __attribute__((address_space(3)))
using pg8::bf16_t; using pg8::bf16x8; using pg8::f32x4; using pg8::u32x4;
typedef float f32x16 __attribute__((ext_vector_type(16)));
typedef float f32x2v __attribute__((ext_vector_type(2)));
typedef __bf16 bf16x2v __attribute__((ext_vector_type(2)));
typedef unsigned u32x2 __attribute__((ext_vector_type(2)));

constexpr int T = 32768, TP = 16384, DM = 1024, NLAYER = 2, NCR = 10, NMODC = 6144;
constexpr int INC = 1696, LZ = 1728, ZQ = 0, ZKV = 384, ZKR = 640, ZU = 704, ZV = 1216, ZATT = 192, NIN = 1792;
constexpr int DFF = 2816, NGU = 5632;
constexpr float EPS = 1e-6f;
constexpr float QSCALE = 0.10206207261596577f * 1.4426950408889634f;
constexpr size_t MiB = 1u << 20;
constexpr size_t WS_MOD = 512 * 1024, WS_ROPE = 1 * MiB, WS_SSQ = 2 * MiB, WS_W = 3 * MiB;
constexpr size_t OW_IN = 0, OW_QB = 3670016, OW_KVB = 4259840, OW_OUT = 4784128, OW_GU = 6881280, OW_D = 18415616, OW_S = 24182784, WL = 24444928;
constexpr size_t WS_H = 50 * MiB, WS_Z = 114 * MiB, WS_VT = 222 * MiB, WS_END = 254 * MiB;
static_assert(WS_Z + (size_t)32768 * LZ * 2 <= WS_VT, "z fits");
static_assert(WS_W + 2 * WL <= WS_H, "weights fit");
constexpr int LDS_BYTES = 147456;

struct Args { const float* in[24]; float* out; unsigned char* ws; };
constexpr int TAB_OFF = LDS_BYTES - 256;
typedef const float* cfptr;
#define GAS __attribute__((address_space(1)))
#define EB(xo) ((bf16_t*)((unsigned char*)(xo) + 2048))
#define INP(k) ((const float*)(ws + ((LAS long long*)(lds + TAB_OFF))[k]))

__device__ __forceinline__ float bf_lo(unsigned w) { return __uint_as_float(w << 16); }
__device__ __forceinline__ float bf_hi(unsigned w) { return __uint_as_float(w & 0xffff0000u); }
__device__ __forceinline__ unsigned pk2(float lo, float hi) { f32x2v v = {lo, hi}; bf16x2v b = __builtin_convertvector(v, bf16x2v); return __builtin_bit_cast(unsigned, b); }
__device__ __forceinline__ float wave_sum(float v) {
#pragma unroll
    for (int o = 1; o < 64; o <<= 1) v += __shfl_xor(v, o);
    return v;
}
__device__ __forceinline__ float gelu_tanh(float x) {
    const float u = 0.7978845608028654f * (x + 0.044715f * x * x * x);
    const float e = __builtin_amdgcn_exp2f(-2.8853900817779268f * u);
    return x * __builtin_amdgcn_rcpf(1.0f + e);
}
__device__ __forceinline__ float silu_f(float x) { return x * __builtin_amdgcn_rcpf(1.0f + __builtin_amdgcn_exp2f(-1.4426950408889634f * x)); }
__device__ __forceinline__ int tok_pos(int row) { return row < TP ? (row & 8191) : (row & 2047); }
__device__ __forceinline__ int tok_cr(int row) { return row < TP ? (row >> 13) : 2 + ((row - TP) >> 11); }

namespace pg8 {
template <bool MK> struct EpiStore {
    static constexpr bool PERM = true, AFTER_DRAIN = false, MIDK = MK;
    bf16_t* O; int ldc; int ncols; const float* ssq;
    __device__ __forceinline__ void operator()(const f32x4 (&acc)[2][2][4][2], const Unit& u, int wr, int wc, int fr, int fq) const {
        const int row0 = u.pm * BM + wr * 64 + fr, col0 = u.pn * BM + wc * 32 + 8 * fq;
#pragma unroll
        for (int ai = 0; ai < 2; ++ai)
#pragma unroll
            for (int m = 0; m < 4; ++m) { bf16_t* rowp = O + (size_t)(row0 + ai * HALF + m * 16) * ldc + col0;
#pragma unroll
                for (int bj = 0; bj < 2; ++bj) if (col0 + bj * HALF < ncols) { const f32x4 v0 = acc[ai][bj][m][0], v1 = acc[ai][bj][m][1];
                    u32x4 w; w.x = pk2(v0[0], v0[1]); w.y = pk2(v0[2], v0[3]); w.z = pk2(v1[0], v1[1]); w.w = pk2(v1[2], v1[3]);
                    *(u32x4*)(rowp + bj * HALF) = w; } }
    }
    __device__ __forceinline__ void midk(f32x4 (&acc)[2][2][4][2], const Unit& u, int wr, int fr) const {
#pragma unroll
        for (int ai = 0; ai < 2; ++ai)
#pragma unroll
            for (int m = 0; m < 4; ++m) { int row = u.pm * BM + ai * HALF + wr * 64 + m * 16 + fr; asm volatile("" : "+v"(row) :: "memory"); const f32x4* p = (const f32x4*)(ssq + (size_t)row * 8);
                const f32x4 s0 = p[0], s1 = p[1]; const float s = ((s0[0] + s0[1]) + (s0[2] + s0[3])) + ((s1[0] + s1[1]) + (s1[2] + s1[3]));
                const float rs = rsqrtf(s * (1.0f / 512.0f) + EPS);
#pragma unroll
                for (int bj = 0; bj < 2; ++bj)
#pragma unroll
                    for (int n = 0; n < 2; ++n) acc[ai][bj][m][n] *= rs; }
    }
};
struct EpiQ {
    static constexpr bool PERM = false, AFTER_DRAIN = false, MIDK = false;
    bf16_t* Q; const float* rope; const float* rstd;
    __device__ __forceinline__ void midk(f32x4 (&)[2][2][4][2], const Unit&, int, int) const {}
    __device__ __forceinline__ void operator()(const f32x4 (&acc)[2][2][4][2], const Unit& u, int wr, int wc, int fr, int fq) const {
        const int G0 = 8 * u.pn + wc, part0 = G0 % 3, part1 = (G0 + 4) % 3;
#pragma unroll
        for (int ai = 0; ai < 2; ++ai)
#pragma unroll
            for (int m = 0; m < 4; ++m) { int row = u.pm * BM + ai * HALF + wr * 64 + m * 16 + fr; asm volatile("" : "+v"(row)); bf16_t* rp = Q + (size_t)row * 768 + 32 * G0 + 4 * fq;
                const float rs = rstd[row] * QSCALE;
                f32x4 cs = {1.f, 1.f, 1.f, 1.f}, sn = {0.f, 0.f, 0.f, 0.f};
                if (part0 == 2 || part1 == 2) { const f32x4* t = (const f32x4*)(rope + ((size_t)tok_pos(row) * 16 + 4 * fq) * 2); const f32x4 c0 = t[0], c1 = t[1];
                    cs = (f32x4){c0[0], c0[2], c1[0], c1[2]}; sn = (f32x4){c0[1], c0[3], c1[1], c1[3]}; }
#pragma unroll
                for (int bj = 0; bj < 2; ++bj) { const bool rp2 = (bj == 0 ? part0 : part1) == 2;
                    f32x4 x1 = acc[ai][bj][m][0] * rs, x2 = acc[ai][bj][m][1] * rs;
                    if (rp2) { const f32x4 o1 = x1 * cs - x2 * sn, o2 = x1 * sn + x2 * cs; x1 = o1; x2 = o2; }
                    u32x2 w1, w2; w1.x = pk2(x1[0], x1[1]); w1.y = pk2(x1[2], x1[3]); w2.x = pk2(x2[0], x2[1]); w2.y = pk2(x2[2], x2[3]);
                    *(u32x2*)(rp + 128 * bj) = w1; *(u32x2*)(rp + 128 * bj + 16) = w2; }
                asm volatile("" ::: "memory"); }
    }
};
struct EpiKV {
    static constexpr bool PERM = true, AFTER_DRAIN = false, MIDK = false;
    bf16_t* kn; bf16_t* vt; const float* rstd;
    __device__ __forceinline__ void midk(f32x4 (&)[2][2][4][2], const Unit&, int, int) const {}
    __device__ __forceinline__ void operator()(const f32x4 (&acc)[2][2][4][2], const Unit& u, int wr, int wc, int fr, int fq) const {
        const int sfr = (fr & 3) | ((fr & 4) << 1) | ((fr & 8) >> 1); const int within = 32 * wc + 8 * fq;
#pragma unroll
        for (int ai = 0; ai < 2; ++ai)
#pragma unroll
            for (int m = 0; m < 4; ++m) { int row = u.pm * BM + ai * HALF + wr * 64 + m * 16 + fr; asm volatile("" : "+v"(row)); const float rs = rstd[row];
#pragma unroll
                for (int bj = 0; bj < 2; ++bj) { const int head = 2 * u.pn + bj;
                    const f32x4 v0 = acc[ai][bj][m][0] * rs, v1 = acc[ai][bj][m][1] * rs;
                    u32x4 w; w.x = pk2(v0[0], v0[1]); w.y = pk2(v0[2], v0[3]); w.z = pk2(v1[0], v1[1]); w.w = pk2(v1[2], v1[3]);
                    if (wc < 2) { *(u32x4*)(kn + (size_t)row * LZ + head * 64 + within) = w; }
                    else { bf16_t* vp = vt + (size_t)(head * 64 + within - 64) * T + ((row & ~15) | sfr);
                        vp[0] = (bf16_t)(w.x & 0xffffu); vp[(size_t)T] = (bf16_t)(w.x >> 16); vp[(size_t)2 * T] = (bf16_t)(w.y & 0xffffu); vp[(size_t)3 * T] = (bf16_t)(w.y >> 16);
                        vp[(size_t)4 * T] = (bf16_t)(w.z & 0xffffu); vp[(size_t)5 * T] = (bf16_t)(w.z >> 16); vp[(size_t)6 * T] = (bf16_t)(w.w & 0xffffu); vp[(size_t)7 * T] = (bf16_t)(w.w >> 16); } }
                asm volatile("" ::: "memory"); }
    }
};
struct EpiGU {
    static constexpr bool PERM = true, AFTER_DRAIN = false, MIDK = false;
    bf16_t* O;
    __device__ __forceinline__ void midk(f32x4 (&)[2][2][4][2], const Unit&, int, int) const {}
    __device__ __forceinline__ void operator()(const f32x4 (&acc)[2][2][4][2], const Unit& u, int wr, int wc, int fr, int fq) const {
        const int col = 128 * u.pn + 32 * wc + 8 * fq;
#pragma unroll
        for (int ai = 0; ai < 2; ++ai)
#pragma unroll
            for (int m = 0; m < 4; ++m) { const int row = u.pm * BM + ai * HALF + wr * 64 + m * 16 + fr;
                const f32x4 g0 = acc[ai][0][m][0], g1 = acc[ai][0][m][1], u0 = acc[ai][1][m][0], u1 = acc[ai][1][m][1];
                u32x4 w; w.x = pk2(silu_f(g0[0]) * u0[0], silu_f(g0[1]) * u0[1]); w.y = pk2(silu_f(g0[2]) * u0[2], silu_f(g0[3]) * u0[3]);
                w.z = pk2(silu_f(g1[0]) * u1[0], silu_f(g1[1]) * u1[1]); w.w = pk2(silu_f(g1[2]) * u1[2], silu_f(g1[3]) * u1[3]);
                *(u32x4*)(O + (size_t)row * DFF + col) = w; }
    }
};
}

__device__ __forceinline__ int rowmap(int mode, int n) { return mode == 0 ? n : mode == 3 ? (n < 672 ? n : n + 32) : (((n >> 7) << 8) + (n & 127) + (mode == 2 ? 128 : 0)); }
__device__ __forceinline__ void transpose_item(const float* W, int K, int N, bf16_t* WT, int mode, const float* gain, LAS float* scr, int item, int lane) {
    const int nblk = N / 32, kb = item / nblk, nb = item % nblk, k0 = 64 * kb, n0 = 32 * nb;
    { const int kq = lane >> 3, nq = lane & 7;
      f32x4 v[8];
#pragma unroll
      for (int i = 0; i < 8; ++i) v[i] = *(const f32x4*)(W + (size_t)(k0 + 8 * i + kq) * N + n0 + 4 * nq);
#pragma unroll
      for (int i = 0; i < 8; ++i) { const int kk = 8 * i + kq; const float gk = gain ? gain[k0 + kk] : 1.0f;
#pragma unroll
          for (int e = 0; e < 4; ++e) scr[kk * 33 + 4 * nq + e] = v[i][e] * gk; } }
    asm volatile("s_waitcnt lgkmcnt(0)" ::: "memory");
    const int c = lane & 7;
#pragma unroll
    for (int j = 0; j < 4; ++j) { const int n = (lane >> 3) + 8 * j; const LAS float* s = scr + (8 * c) * 33 + n;
        u32x4 o; o.x = pk2(s[0 * 33], s[1 * 33]); o.y = pk2(s[2 * 33], s[3 * 33]); o.z = pk2(s[4 * 33], s[5 * 33]); o.w = pk2(s[6 * 33], s[7 * 33]);
        *(u32x4*)(WT + (size_t)rowmap(mode, n0 + n) * K + k0 + 8 * c) = o; }
    asm volatile("s_waitcnt lgkmcnt(0)" ::: "memory");
}

constexpr int WT_I_IN = 16 * 53, WT_I_QB = 6 * 24, WT_I_KVB = 4 * 32, WT_I_OUT = 16 * 32, WT_I_G = 16 * 88, WT_I_D = 44 * 32;
constexpr int WT_NITEMS = WT_I_IN + WT_I_QB + WT_I_KVB + WT_I_OUT + 2 * WT_I_G + WT_I_D;
__device__ __forceinline__ void wt_convert(unsigned char* ws, LAS unsigned char* lds, int l, int it0, int it1, int rank, int nwk, int tid, int lane, int wid) {
    unsigned char* wb = ws + WS_W + (size_t)l * WL;
    if (it0 == 0) {
        const int gtid = rank * 512 + tid, NT = nwk * 512;
        for (int j = gtid; j < 65536; j += NT) { const float* s = INP(16) + (size_t)l * 131072 + 2 * j; ((unsigned*)(wb + OW_S))[j] = pk2(s[0], s[1]); }
        for (int j = gtid; j < 12288; j += NT) { const int r = j >> 7, dr = r < 32 ? 672 + r : 1728 + (r - 32);
            ((u32x4*)(wb + OW_IN))[(size_t)dr * 128 + (j & 127)] = (u32x4){0u, 0u, 0u, 0u}; }
    }
    LAS float* scr = (LAS float*)(lds + 65536) + wid * (64 * 33);
    for (int it = it0 + rank * 8 + wid; it < it1; it += nwk * 8) {
        int r = it;
        if (r < WT_I_IN) { transpose_item(INP(10) + (size_t)l * 1024 * INC, 1024, INC, (bf16_t*)(wb + OW_IN), 3, nullptr, scr, r, lane); continue; } r -= WT_I_IN;
        if (r < WT_I_QB) { transpose_item(INP(12) + (size_t)l * 384 * 768, 384, 768, (bf16_t*)(wb + OW_QB), 0, INP(11) + l * 384, scr, r, lane); continue; } r -= WT_I_QB;
        if (r < WT_I_KVB) { transpose_item(INP(14) + (size_t)l * 256 * 1024, 256, 1024, (bf16_t*)(wb + OW_KVB), 0, INP(13) + l * 256, scr, r, lane); continue; } r -= WT_I_KVB;
        if (r < WT_I_OUT) { const int kb = r / 32; transpose_item(INP(20) + (size_t)l * 1024 * 1024, 1024, 1024, (bf16_t*)(wb + OW_OUT), 0, kb < 8 ? INP(18) + l * 512 : INP(19) + l * 512 - 512, scr, r, lane); continue; } r -= WT_I_OUT;
        if (r < WT_I_G) { transpose_item(INP(21) + (size_t)l * 1024 * DFF, 1024, DFF, (bf16_t*)(wb + OW_GU), 1, nullptr, scr, r, lane); continue; } r -= WT_I_G;
        if (r < WT_I_G) { transpose_item(INP(22) + (size_t)l * 1024 * DFF, 1024, DFF, (bf16_t*)(wb + OW_GU), 2, nullptr, scr, r, lane); continue; } r -= WT_I_G;
        transpose_item(INP(23) + (size_t)l * DFF * 1024, DFF, 1024, (bf16_t*)(wb + OW_D), 0, nullptr, scr, r, lane);
    }
}

__device__ __forceinline__ void p0_phase(unsigned char* ws, LAS unsigned char* lds, const int wv) {
    int tid = wv * 64 + (int)__builtin_amdgcn_mbcnt_hi(~0u, __builtin_amdgcn_mbcnt_lo(~0u, 0u)); asm volatile("" : "+v"(tid)); const int lane = tid & 63, wid = wv;
    const int G = gridDim.x;
    {
        LAS float* cs = (LAS float*)lds; LAS float* red = cs + NCR * 1024;
        float* mod = (float*)(ws + WS_MOD);
        for (int bg = blockIdx.x; bg < 192; bg += G) {
            for (int t = tid; t < NCR * 1024; t += 512) { const int cr = t >> 10, k = t & 1023; const float c = cr < 2 ? INP(2)[cr * 1024 + k] : INP(3)[(cr - 2) * 1024 + k]; cs[t] = silu_f(c); }
            __syncthreads();
            const int l = bg / 96, cb = (bg % 96) * 64;
            const int cg4 = lane & 15, kq = lane >> 4;
            const float* wm = INP(4) + (size_t)l * 1024 * NMODC + cb + 4 * cg4;
            f32x4 acc[NCR];
#pragma unroll
            for (int cr = 0; cr < NCR; ++cr) acc[cr] = (f32x4){0.f, 0.f, 0.f, 0.f};
#pragma unroll 8
            for (int kk = 0; kk < 32; ++kk) { const int k = wid * 128 + 4 * kk + kq; const f32x4 w = *(const f32x4*)(wm + (size_t)k * NMODC);
#pragma unroll
                for (int cr = 0; cr < NCR; ++cr) acc[cr] += w * cs[cr * 1024 + k]; }
#pragma unroll
            for (int cr = 0; cr < NCR; ++cr) {
#pragma unroll
                for (int e = 0; e < 4; ++e) { float s = acc[cr][e]; s += __shfl_xor(s, 16); s += __shfl_xor(s, 32); acc[cr][e] = s; }
                if (kq == 0) *(LAS f32x4*)(red + (wid * NCR + cr) * 64 + 4 * cg4) = acc[cr]; }
            __syncthreads();
            for (int t = tid; t < NCR * 64; t += 512) { const int cr = t >> 6, ln = t & 63; float s = 0.f;
#pragma unroll
                for (int w = 0; w < 8; ++w) s += red[(w * NCR + cr) * 64 + ln];
                mod[(size_t)(l * NCR + cr) * NMODC + cb + ln] = s + INP(5)[l * NMODC + cb + ln]; }
            __syncthreads();
        }
    }
    const int gtid = blockIdx.x * 512 + tid, NT = G * 512;
    {
        float* rope = (float*)(ws + WS_ROPE);
        for (int idx = gtid; idx < 8192 * 16; idx += NT) { const int pos = idx >> 4, i = idx & 15;
            const float inv = exp2f(-(float)i * 0.8304820237218406f);
            const float ang = (float)pos * inv;
            double rev = (double)ang * 0.15915494309189535; rev -= __builtin_rint(rev);
            const float rf = (float)rev;
            rope[2 * idx] = __builtin_amdgcn_cosf(rf); rope[2 * idx + 1] = __builtin_amdgcn_sinf(rf); }
    }
    wt_convert(ws, lds, 0, 0, WT_NITEMS, blockIdx.x, G, tid, lane, wid);
    wt_convert(ws, lds, 1, 0, WT_NITEMS, blockIdx.x, G, tid, lane, wid);
}

struct RowArgs { const bf16_t* src; const float* xin_p; const float* xin_s; float* xout; const float* gpost; const float* ga; const float* gpre; const float* sc; const float* sh; bf16_t* hout; unsigned char* xb; int src_ld, h_ld; };
template <bool HAS_RES, bool HAS_H, bool XIN_BF, bool XOUT_BF>
__device__ __forceinline__ void row_phase(const RowArgs& ra, const int wv) {
    int tid = wv * 64 + (int)__builtin_amdgcn_mbcnt_hi(~0u, __builtin_amdgcn_mbcnt_lo(~0u, 0u)); asm volatile("" : "+v"(tid)); const int lane = tid & 63, wid = wv;
    const int gw = blockIdx.x * 8 + wid, NGW = gridDim.x * 8;
    for (int grp = gw; grp < T / 16; grp += NGW) {
        const int r0 = grp * 16, cr = tok_cr(r0);
        float A[16], B[16], S[16];
#pragma unroll
        for (int j = 0; j < 2; ++j)
#pragma unroll
            for (int q = 0; q < 2; ++q) { const int c = 512 * j + 8 * lane + 4 * q;
                if (HAS_RES) { const f32x4 g = *(const f32x4*)(ra.gpost + c), m = *(const f32x4*)(ra.ga + (size_t)cr * NMODC + c);
#pragma unroll
                    for (int e = 0; e < 4; ++e) A[8 * j + 4 * q + e] = g[e] * m[e]; }
                if (HAS_H) { const f32x4 g = *(const f32x4*)(ra.gpre + c), s1 = *(const f32x4*)(ra.sc + (size_t)cr * NMODC + c), s2 = *(const f32x4*)(ra.sh + (size_t)cr * NMODC + c);
#pragma unroll
                    for (int e = 0; e < 4; ++e) { B[8 * j + 4 * q + e] = g[e] * (1.0f + s1[e]); S[8 * j + 4 * q + e] = s2[e]; } } }
#pragma unroll 2
        for (int i = 0; i < 16; ++i) {
            const int row = r0 + i;
            float x[16];
            if constexpr (XIN_BF) {
#pragma unroll
                for (int j = 0; j < 2; ++j) { const u32x4 w = __builtin_nontemporal_load((const u32x4*)((const bf16_t*)(ra.xb + (size_t)row * 4096) + 512 * j + 8 * lane));
                    x[8 * j + 0] = bf_lo(w.x); x[8 * j + 1] = bf_hi(w.x); x[8 * j + 2] = bf_lo(w.y); x[8 * j + 3] = bf_hi(w.y);
                    x[8 * j + 4] = bf_lo(w.z); x[8 * j + 5] = bf_hi(w.z); x[8 * j + 6] = bf_lo(w.w); x[8 * j + 7] = bf_hi(w.w); }
            } else {
                const float* xr = row < TP ? ra.xin_p + (size_t)row * DM : ra.xin_s + (size_t)(row - TP) * DM;
#pragma unroll
                for (int j = 0; j < 2; ++j)
#pragma unroll
                    for (int q = 0; q < 2; ++q) { const f32x4 v = __builtin_nontemporal_load((const f32x4*)(xr + 512 * j + 8 * lane + 4 * q));
#pragma unroll
                        for (int e = 0; e < 4; ++e) x[8 * j + 4 * q + e] = v[e]; }
            }
            if (HAS_RES) {
                float sv[16]; float ss = 0.f;
#pragma unroll
                for (int j = 0; j < 2; ++j) { const u32x4 w = __builtin_nontemporal_load((const u32x4*)(ra.src + (size_t)row * ra.src_ld + 512 * j + 8 * lane));
                    sv[8 * j + 0] = bf_lo(w.x); sv[8 * j + 1] = bf_hi(w.x); sv[8 * j + 2] = bf_lo(w.y); sv[8 * j + 3] = bf_hi(w.y);
                    sv[8 * j + 4] = bf_lo(w.z); sv[8 * j + 5] = bf_hi(w.z); sv[8 * j + 6] = bf_lo(w.w); sv[8 * j + 7] = bf_hi(w.w); }
#pragma unroll
                for (int e = 0; e < 16; ++e) ss += sv[e] * sv[e];
                const float rs = rsqrtf(wave_sum(ss) * (1.0f / DM) + EPS);
#pragma unroll
                for (int e = 0; e < 16; ++e) x[e] += A[e] * (sv[e] * rs);
                if constexpr (XOUT_BF) {
#pragma unroll
                    for (int j = 0; j < 2; ++j) { u32x4 w; w.x = pk2(x[8 * j], x[8 * j + 1]); w.y = pk2(x[8 * j + 2], x[8 * j + 3]); w.z = pk2(x[8 * j + 4], x[8 * j + 5]); w.w = pk2(x[8 * j + 6], x[8 * j + 7]);
                        __builtin_nontemporal_store(w, (u32x4*)((bf16_t*)(ra.xb + (size_t)row * 4096) + 512 * j + 8 * lane)); }
                } else {
#pragma unroll
                    for (int j = 0; j < 2; ++j)
#pragma unroll
                        for (int q = 0; q < 2; ++q) { const f32x4 v = {x[8 * j + 4 * q], x[8 * j + 4 * q + 1], x[8 * j + 4 * q + 2], x[8 * j + 4 * q + 3]};
                            __builtin_nontemporal_store(v, (f32x4*)(ra.xout + (size_t)row * DM + 512 * j + 8 * lane + 4 * q)); }
                }
            }
            if (HAS_H) {
                float ss = 0.f;
#pragma unroll
                for (int e = 0; e < 16; ++e) ss += x[e] * x[e];
                const float rs = rsqrtf(wave_sum(ss) * (1.0f / DM) + EPS);
#pragma unroll
                for (int j = 0; j < 2; ++j) { u32x4 w; float h[8];
#pragma unroll
                    for (int e = 0; e < 8; ++e) h[e] = x[8 * j + e] * rs * B[8 * j + e] + S[8 * j + e];
                    w.x = pk2(h[0], h[1]); w.y = pk2(h[2], h[3]); w.z = pk2(h[4], h[5]); w.w = pk2(h[6], h[7]);
                    *(u32x4*)(ra.hout + (size_t)row * ra.h_ld + 512 * j + 8 * lane) = w; }
            }
        }
    }
}

__device__ __forceinline__ void mid_phase(unsigned char* ws, int l, LAS unsigned char* lds, const int wv) {
    int tid = wv * 64 + (int)__builtin_amdgcn_mbcnt_hi(~0u, __builtin_amdgcn_mbcnt_lo(~0u, 0u)); asm volatile("" : "+v"(tid)); const int lane = tid & 63, wid = wv;
    bf16_t* z = (bf16_t*)(ws + WS_Z); bf16_t* kr = (bf16_t*)(ws + WS_H) + (size_t)T * 768;
    float* rstdq = (float*)(ws + WS_SSQ); float* rstdkv = rstdq + T;
    const float* rope = (const float*)(ws + WS_ROPE);
    const bf16_t* Wsb = (const bf16_t*)(ws + WS_W + l * WL + OW_S);
    const float* g_sgu = INP(15) + l * 512; const float* b_sp = INP(17) + l * 1024;
    LAS bf16_t* vn = (LAS bf16_t*)lds;
    LAS float* part = (LAS float*)(lds + 131072);
    LAS float* rstd_s = part + 1024;
    const int r32 = lane & 31, hi = lane >> 5;
    for (int ch = blockIdx.x; ch < T / 128; ch += gridDim.x) {
        const int R0 = ch * 128;
        float gs[8];
#pragma unroll
        for (int e = 0; e < 8; ++e) gs[e] = g_sgu[8 * lane + e];
        { const int rrow = R0 + wid * 16 + (lane >> 2), L = lane & 3;
          const u32x4 wr_ = *(const u32x4*)(z + (size_t)rrow * LZ + ZKR + 8 * L);
          const f32x4* tp = (const f32x4*)(rope + ((size_t)tok_pos(rrow) * 16 + 8 * (L & 1)) * 2);
          const f32x4 t0 = tp[0], t1 = tp[1], t2 = tp[2], t3 = tp[3];
          const float cs[8] = {t0[0], t0[2], t1[0], t1[2], t2[0], t2[2], t3[0], t3[2]}, sn[8] = {t0[1], t0[3], t1[1], t1[3], t2[1], t2[3], t3[1], t3[3]};
          float mine[8] = {bf_lo(wr_.x), bf_hi(wr_.x), bf_lo(wr_.y), bf_hi(wr_.y), bf_lo(wr_.z), bf_hi(wr_.z), bf_lo(wr_.w), bf_hi(wr_.w)}; float o[8];
#pragma unroll
          for (int e = 0; e < 8; ++e) { const float oth = __shfl_xor(mine[e], 2); o[e] = L < 2 ? (mine[e] * cs[e] - oth * sn[e]) : (oth * sn[e] + mine[e] * cs[e]); }
          u32x4 w; w.x = pk2(o[0], o[1]); w.y = pk2(o[2], o[3]); w.z = pk2(o[4], o[5]); w.w = pk2(o[6], o[7]);
          *(u32x4*)(kr + (size_t)rrow * 32 + 8 * L) = w; }
#pragma unroll 1
        for (int i0 = 0; i0 < 16; i0 += 4) {
            u32x4 wqa[4], wkva[4], wva[4];
#pragma unroll
            for (int k = 0; k < 4; ++k) { const bf16_t* zr = z + (size_t)(R0 + wid * 16 + i0 + k) * LZ;
                wqa[k] = (u32x4){0u, 0u, 0u, 0u}; wkva[k] = (u32x4){0u, 0u, 0u, 0u};
                if (lane < 48) wqa[k] = *(const u32x4*)(zr + ZQ + 8 * lane);
                if (lane < 32) wkva[k] = *(const u32x4*)(zr + ZKV + 8 * lane);
                wva[k] = *(const u32x4*)(zr + ZV + 8 * lane); }
#pragma unroll
            for (int k = 0; k < 4; ++k) {
                const int lr = wid * 16 + i0 + k, row = R0 + lr; const u32x4 wq = wqa[k], wkv = wkva[k], wv = wva[k];
                float sq = 0.f, skv = 0.f;
                { const float f0 = bf_lo(wq.x), f1 = bf_hi(wq.x), f2 = bf_lo(wq.y), f3 = bf_hi(wq.y), f4 = bf_lo(wq.z), f5 = bf_hi(wq.z), f6 = bf_lo(wq.w), f7 = bf_hi(wq.w);
                  sq = (f0 * f0 + f1 * f1) + (f2 * f2 + f3 * f3) + (f4 * f4 + f5 * f5) + (f6 * f6 + f7 * f7); }
                { const float f0 = bf_lo(wkv.x), f1 = bf_hi(wkv.x), f2 = bf_lo(wkv.y), f3 = bf_hi(wkv.y), f4 = bf_lo(wkv.z), f5 = bf_hi(wkv.z), f6 = bf_lo(wkv.w), f7 = bf_hi(wkv.w);
                  skv = (f0 * f0 + f1 * f1) + (f2 * f2 + f3 * f3) + (f4 * f4 + f5 * f5) + (f6 * f6 + f7 * f7); }
                float gv[8];
                gv[0] = gelu_tanh(bf_lo(wv.x)); gv[1] = gelu_tanh(bf_hi(wv.x)); gv[2] = gelu_tanh(bf_lo(wv.y)); gv[3] = gelu_tanh(bf_hi(wv.y));
                gv[4] = gelu_tanh(bf_lo(wv.z)); gv[5] = gelu_tanh(bf_hi(wv.z)); gv[6] = gelu_tanh(bf_lo(wv.w)); gv[7] = gelu_tanh(bf_hi(wv.w));
                float sv = 0.f;
#pragma unroll
                for (int e = 0; e < 8; ++e) sv += gv[e] * gv[e];
                sq = wave_sum(sq); skv = wave_sum(skv); sv = wave_sum(sv);
                if (lane == 0) { rstdq[row] = rsqrtf(sq * (1.0f / 384.0f) + EPS); rstdkv[row] = rsqrtf(skv * (1.0f / 256.0f) + EPS); }
                const float rv = rsqrtf(sv * (1.0f / 512.0f) + EPS);
                { u32x4 o; o.x = pk2(gv[0] * rv * gs[0], gv[1] * rv * gs[1]); o.y = pk2(gv[2] * rv * gs[2], gv[3] * rv * gs[3]);
                  o.z = pk2(gv[4] * rv * gs[4], gv[5] * rv * gs[5]); o.w = pk2(gv[6] * rv * gs[6], gv[7] * rv * gs[7]);
                  *(LAS u32x4*)(vn + lr * 512 + 8 * lane) = o; }
            }
        }
        __syncthreads();
        const int g = wid;
        f32x16 acc[2][4];
#pragma unroll
        for (int ct = 0; ct < 2; ++ct)
#pragma unroll
            for (int tt = 0; tt < 4; ++tt)
#pragma unroll
                for (int r = 0; r < 16; ++r) acc[ct][tt][r] = 0.f;
#pragma unroll 1
        for (int ks = 0; ks < 8; ++ks) {
            bf16x8 af[2], bfr[4];
#pragma unroll
            for (int ct = 0; ct < 2; ++ct)
#pragma unroll
                for (int e = 0; e < 8; ++e) af[ct][e] = (short)vn[(16 * ks + 8 * hi + e) * 512 + 64 * g + 32 * ct + r32];
#pragma unroll
            for (int tt = 0; tt < 4; ++tt) bfr[tt] = *(const bf16x8*)(Wsb + ((size_t)(g * 128 + 32 * tt + r32) * 128 + 16 * ks + 8 * hi));
#pragma unroll
            for (int ct = 0; ct < 2; ++ct)
#pragma unroll
                for (int tt = 0; tt < 4; ++tt) acc[ct][tt] = __builtin_amdgcn_mfma_f32_32x32x16_bf16(af[ct], bfr[tt], acc[ct][tt], 0, 0, 0);
        }
#pragma unroll
        for (int tt = 0; tt < 4; ++tt) { const int t = 32 * tt + r32; const float bias = b_sp[g * 128 + t]; const bf16_t* zu = z + (size_t)(R0 + t) * LZ + ZU + 64 * g; float s = 0.f;
#pragma unroll
            for (int ct = 0; ct < 2; ++ct)
#pragma unroll
                for (int rq = 0; rq < 4; ++rq) { const u32x2 w = *(const u32x2*)(zu + 32 * ct + 8 * rq + 4 * hi);
                    const float u0 = gelu_tanh(bf_lo(w.x)), u1 = gelu_tanh(bf_hi(w.x)), u2 = gelu_tanh(bf_lo(w.y)), u3 = gelu_tanh(bf_hi(w.y));
                    float v0 = u0 * (acc[ct][tt][4 * rq] + bias), v1 = u1 * (acc[ct][tt][4 * rq + 1] + bias), v2 = u2 * (acc[ct][tt][4 * rq + 2] + bias), v3 = u3 * (acc[ct][tt][4 * rq + 3] + bias);
                    acc[ct][tt][4 * rq] = v0; acc[ct][tt][4 * rq + 1] = v1; acc[ct][tt][4 * rq + 2] = v2; acc[ct][tt][4 * rq + 3] = v3;
                    s += (v0 * v0 + v1 * v1) + (v2 * v2 + v3 * v3); }
            s += __shfl_xor(s, 32);
            if (hi == 0) part[g * 128 + t] = s; }
        __syncthreads();
        if (tid < 128) { float s = 0.f;
#pragma unroll
            for (int w = 0; w < 8; ++w) s += part[w * 128 + tid];
            rstd_s[tid] = rsqrtf(s * (1.0f / 512.0f) + EPS); }
        __syncthreads();
#pragma unroll
        for (int tt = 0; tt < 4; ++tt) { const int t = 32 * tt + r32; const float rs = rstd_s[t]; bf16_t* zu = z + (size_t)(R0 + t) * LZ + ZU + 64 * g;
#pragma unroll
            for (int ct = 0; ct < 2; ++ct)
#pragma unroll
                for (int rq = 0; rq < 4; ++rq) { u32x2 w; w.x = pk2(acc[ct][tt][4 * rq] * rs, acc[ct][tt][4 * rq + 1] * rs); w.y = pk2(acc[ct][tt][4 * rq + 2] * rs, acc[ct][tt][4 * rq + 3] * rs);
                    *(u32x2*)(zu + 32 * ct + 8 * rq + 4 * hi) = w; } }
        __syncthreads();
    }
}

constexpr int KROW = 208, VROW = 144, KTILE_B = 64 * KROW, VTILE_B = 64 * VROW;
__device__ __forceinline__ void attn_phase(unsigned char* ws, LAS unsigned char* lds, const int wv) {
    int tid = wv * 64 + (int)__builtin_amdgcn_mbcnt_hi(~0u, __builtin_amdgcn_mbcnt_lo(~0u, 0u)); asm volatile("" : "+v"(tid)); const int lane = tid & 63, wid = wv;
    const bf16_t* Q = (const bf16_t*)(ws + WS_H); const bf16_t* kr = Q + (size_t)T * 768;
    bf16_t* z = (bf16_t*)(ws + WS_Z); const bf16_t* kn = z + ZV; const bf16_t* Vt = (const bf16_t*)(ws + WS_VT);
    float* ssq = (float*)(ws + WS_SSQ);
    const int r32 = lane & 31, hi = lane >> 5, G = gridDim.x;
    LAS unsigned char* Kl = lds; LAS unsigned char* Vl = lds + 2 * KTILE_B;
    const int kc0 = tid, kc1 = tid + 512;
    const int kr0 = kc0 / 12, kp0 = kc0 % 12, kr1 = kc1 / 12, kp1 = kc1 % 12;
    const int vd = tid >> 3, vch = tid & 7;
    for (int it = 0;; ++it) {
        const int flat = it * G + blockIdx.x; if (flat >= 1024) break;
        int seq, head, qb, s0, len;
        { const int v = flat < 512 ? flat : flat - 512; const int x = v & 7, y = v >> 3;
          if (flat < 512) { qb = y & 31; const int pair = x + 8 * (y >> 5); seq = pair >> 3; head = pair & 7; s0 = seq * 8192; len = 8192; }
          else { qb = y & 7; const int pair = x + 8 * (y >> 3); seq = pair >> 3; head = pair & 7; s0 = TP + seq * 2048; len = 2048; } }
        const int NTL = len / 64;
        const int qrow = s0 + qb * 256 + wid * 32 + r32;
        bf16x8 qf[6];
#pragma unroll
        for (int d0 = 0; d0 < 6; ++d0) qf[d0] = *(const bf16x8*)(Q + (size_t)qrow * 768 + head * 96 + d0 * 16 + hi * 8);
        const unsigned ko0 = kp0 < 8 ? (unsigned)(WS_Z + ((size_t)(s0 + kr0) * LZ + ZV + head * 64 + kp0 * 8) * 2) : (unsigned)(WS_H + ((size_t)T * 768 + (size_t)(s0 + kr0) * 32 + (kp0 - 8) * 8) * 2);
        const unsigned kst0 = kp0 < 8 ? 64u * LZ * 2u : 64u * 32u * 2u;
        const unsigned ko1 = kp1 < 8 ? (unsigned)(WS_Z + ((size_t)(s0 + kr1) * LZ + ZV + head * 64 + kp1 * 8) * 2) : (unsigned)(WS_H + ((size_t)T * 768 + (size_t)(s0 + kr1) * 32 + (kp1 - 8) * 8) * 2);
        const unsigned kst1 = kp1 < 8 ? 64u * LZ * 2u : 64u * 32u * 2u;
        const unsigned vo = (unsigned)(WS_VT + ((size_t)(head * 64 + vd) * T + s0 + vch * 8) * 2);
#define KLD0(t) (*(const u32x4*)(ws + (ko0 + (unsigned)(t) * kst0)))
#define KLD1(t) (*(const u32x4*)(ws + (ko1 + (unsigned)(t) * kst1)))
#define VLD(t) (*(const u32x4*)(ws + (vo + (unsigned)(t) * 128u)))
        const int kd0 = kr0 * KROW + kp0 * 16, kd1 = kr1 * KROW + kp1 * 16, vdst = vd * VROW + vch * 16;
        u32x4 rk0, rk1 = {0u, 0u, 0u, 0u}, rv;
        rk0 = KLD0(0); if (tid < 256) rk1 = KLD1(0); rv = VLD(0);
        *(LAS u32x4*)(Kl + kd0) = rk0; if (tid < 256) *(LAS u32x4*)(Kl + kd1) = rk1; *(LAS u32x4*)(Vl + vdst) = rv;
        rk0 = KLD0(1); if (tid < 256) rk1 = KLD1(1);
        *(LAS u32x4*)(Kl + KTILE_B + kd0) = rk0; if (tid < 256) *(LAS u32x4*)(Kl + KTILE_B + kd1) = rk1;
        rk0 = KLD0(2); if (tid < 256) rk1 = KLD1(2); rv = VLD(1);
        __syncthreads();
        f32x16 o0, o1, negm, sc0, sc1; bf16x8 kf[12];
#pragma unroll
        for (int r = 0; r < 16; ++r) { o0[r] = 0.f; o1[r] = 0.f; negm[r] = 0.f; }
        float lsum = 0.f;
        { const LAS unsigned char* Kb = Kl + r32 * KROW + hi * 16;
#pragma unroll
          for (int d0 = 0; d0 < 6; ++d0) { kf[2 * d0] = *(const LAS bf16x8*)(Kb + d0 * 32); kf[2 * d0 + 1] = *(const LAS bf16x8*)(Kb + 32 * KROW + d0 * 32); }
#pragma unroll
          for (int d0 = 0; d0 < 6; ++d0) {
              sc0 = __builtin_amdgcn_mfma_f32_32x32x16_bf16(kf[2 * d0], qf[d0], d0 == 0 ? negm : sc0, 0, 0, 0);
              sc1 = __builtin_amdgcn_mfma_f32_32x32x16_bf16(kf[2 * d0 + 1], qf[d0], d0 == 0 ? negm : sc1, 0, 0, 0); }
          float rm = fmaxf(fmaxf(sc0[0], sc0[1]), sc1[0]);
#pragma unroll
          for (int r = 2; r < 16; r += 2) rm = fmaxf(fmaxf(rm, sc0[r]), sc0[r + 1]);
#pragma unroll
          for (int r = 1; r < 15; r += 2) rm = fmaxf(fmaxf(rm, sc1[r]), sc1[r + 1]);
          rm = fmaxf(rm, sc1[15]);
          rm = fmaxf(rm, __shfl_xor(rm, 32));
#pragma unroll
          for (int r = 0; r < 16; ++r) { sc0[r] -= rm; sc1[r] -= rm; negm[r] = -rm; }
          const LAS unsigned char* Kb1 = Kb + KTILE_B;
#pragma unroll
          for (int d0 = 0; d0 < 6; ++d0) { kf[2 * d0] = *(const LAS bf16x8*)(Kb1 + d0 * 32); kf[2 * d0 + 1] = *(const LAS bf16x8*)(Kb1 + 32 * KROW + d0 * 32); } }
        __syncthreads();
        int vb3 = 0;
#pragma unroll 2
        for (int kt = 0; kt < NTL; ++kt) {
            const int buf = kt & 1; const int vb3n = vb3 == 2 ? 0 : vb3 + 1;
            const int t3 = kt + 3 < NTL ? kt + 3 : NTL - 1, t2 = kt + 2 < NTL ? kt + 2 : NTL - 1;
            *(LAS u32x4*)(Kl + buf * KTILE_B + kd0) = rk0; if (tid < 256) *(LAS u32x4*)(Kl + buf * KTILE_B + kd1) = rk1;
            *(LAS u32x4*)(Vl + vb3n * VTILE_B + vdst) = rv;
            rk0 = KLD0(t3); if (tid < 256) rk1 = KLD1(t3);
            rv = VLD(t2);
            f32x16 sn0, sn1;
#pragma unroll
            for (int d0 = 0; d0 < 6; ++d0) {
                sn0 = __builtin_amdgcn_mfma_f32_32x32x16_bf16(kf[2 * d0], qf[d0], d0 == 0 ? negm : sn0, 0, 0, 0);
                sn1 = __builtin_amdgcn_mfma_f32_32x32x16_bf16(kf[2 * d0 + 1], qf[d0], d0 == 0 ? negm : sn1, 0, 0, 0); }
#pragma unroll
            for (int r = 0; r < 16; ++r) { sc0[r] = __builtin_amdgcn_exp2f(sc0[r]); sc1[r] = __builtin_amdgcn_exp2f(sc1[r]); }
#pragma unroll
            for (int r = 0; r < 16; ++r) { lsum += sc0[r]; asm volatile("" : "+v"(lsum)); lsum += sc1[r]; asm volatile("" : "+v"(lsum)); }
            float lchk = lsum;
            { auto rr = __builtin_amdgcn_permlane32_swap(__float_as_uint(lchk), __float_as_uint(lchk), false, false); lchk = fmaxf(__uint_as_float(rr[0]), __uint_as_float(rr[1])); }
            u32x4 pw[4];
            pw[0] = (u32x4){pk2(sc0[0], sc0[1]), pk2(sc0[2], sc0[3]), pk2(sc0[4], sc0[5]), pk2(sc0[6], sc0[7])};
            pw[1] = (u32x4){pk2(sc0[8], sc0[9]), pk2(sc0[10], sc0[11]), pk2(sc0[12], sc0[13]), pk2(sc0[14], sc0[15])};
            pw[2] = (u32x4){pk2(sc1[0], sc1[1]), pk2(sc1[2], sc1[3]), pk2(sc1[4], sc1[5]), pk2(sc1[6], sc1[7])};
            pw[3] = (u32x4){pk2(sc1[8], sc1[9]), pk2(sc1[10], sc1[11]), pk2(sc1[12], sc1[13]), pk2(sc1[14], sc1[15])};
            asm volatile("s_waitcnt lgkmcnt(0)" ::: "memory"); __builtin_amdgcn_s_barrier(); asm volatile("" ::: "memory");
            { const LAS unsigned char* Kb = Kl + buf * KTILE_B + r32 * KROW + hi * 16;
#pragma unroll
              for (int d0 = 0; d0 < 6; ++d0) { kf[2 * d0] = *(const LAS bf16x8*)(Kb + d0 * 32); kf[2 * d0 + 1] = *(const LAS bf16x8*)(Kb + 32 * KROW + d0 * 32); } }
            { const LAS unsigned char* Vb = Vl + vb3 * VTILE_B + r32 * VROW + hi * 16;
#pragma unroll
              for (int h2 = 0; h2 < 2; ++h2) { bf16x8 vf[4];
#pragma unroll
                  for (int s = 0; s < 2; ++s) { vf[2 * s] = *(const LAS bf16x8*)(Vb + (2 * h2 + s) * 32); vf[2 * s + 1] = *(const LAS bf16x8*)(Vb + 32 * VROW + (2 * h2 + s) * 32); }
#pragma unroll
                  for (int s = 0; s < 2; ++s) {
                      const bf16x8 pb = __builtin_bit_cast(bf16x8, pw[2 * h2 + s]);
                      o0 = __builtin_amdgcn_mfma_f32_32x32x16_bf16(vf[2 * s], pb, o0, 0, 0, 0);
                      o1 = __builtin_amdgcn_mfma_f32_32x32x16_bf16(vf[2 * s + 1], pb, o1, 0, 0, 0); } } }
            if (__any(lchk > 1.0e12f)) {
                const float dl = fmaxf(floorf(__builtin_amdgcn_logf(lchk)), 0.f); const float f = __builtin_amdgcn_exp2f(-dl);
                lsum *= f; const float nm = negm[0] - dl;
#pragma unroll
                for (int r = 0; r < 16; ++r) { sn0[r] -= dl; sn1[r] -= dl; o0[r] *= f; o1[r] *= f; negm[r] = nm; }
            }
            sc0 = sn0; sc1 = sn1; vb3 = vb3n;
        }
        __syncthreads();
        lsum += __shfl_xor(lsum, 32);
        const float inv = 1.0f / lsum;
        bf16_t* orow = z + (size_t)qrow * LZ + ZATT + head * 64;
        float sq = 0.f;
#pragma unroll
        for (int rq = 0; rq < 4; ++rq) {
            const float a0 = o0[4 * rq] * inv, a1 = o0[4 * rq + 1] * inv, a2 = o0[4 * rq + 2] * inv, a3 = o0[4 * rq + 3] * inv;
            const float b0 = o1[4 * rq] * inv, b1 = o1[4 * rq + 1] * inv, b2 = o1[4 * rq + 2] * inv, b3 = o1[4 * rq + 3] * inv;
            sq += (a0 * a0 + a1 * a1) + (a2 * a2 + a3 * a3) + (b0 * b0 + b1 * b1) + (b2 * b2 + b3 * b3);
            u32x2 w0, w1; w0.x = pk2(a0, a1); w0.y = pk2(a2, a3); w1.x = pk2(b0, b1); w1.y = pk2(b2, b3);
            *(u32x2*)(orow + 8 * rq + 4 * hi) = w0; *(u32x2*)(orow + 32 + 8 * rq + 4 * hi) = w1;
        }
        sq += __shfl_xor(sq, 32);
        if (hi == 0) ssq[(size_t)qrow * 8 + head] = sq;
    }
}

#define XB_TMO      128
#define XB_XCNT(j)  (256  + 64 * (j))
#define XB_XSUB(j)  (1280 + 64 * (j))
#define XB_XGEN(j)  (2304 + 64 * (j))
#define XB_TOP      3328
#define XB_TOPGEN   3392
#define XCD_BAR_WORDS 3456
#define XB_SPIN_CAP (1u << 18)

__device__ __forceinline__ unsigned xb_ld(unsigned* p)              { return __hip_atomic_load(p, __ATOMIC_RELAXED, __HIP_MEMORY_SCOPE_AGENT); }
__device__ __forceinline__ unsigned xb_add(unsigned* p, unsigned v) { return __hip_atomic_fetch_add(p, v, __ATOMIC_RELAXED, __HIP_MEMORY_SCOPE_AGENT); }
__device__ __forceinline__ unsigned xb_xcc_id() { return (unsigned)__builtin_amdgcn_s_getreg((3 << 11) | 20) & 0xFu; }
#define XB_SPIN(cond, bar) do { unsigned _sp = 0; while (cond) { __builtin_amdgcn_s_sleep(1); \
    if ((++_sp & 255u) == 0u) { if (xb_ld(&(bar)[XB_TMO])) break; if (_sp > XB_SPIN_CAP) { atomicAdd(&(bar)[XB_TMO], 1u); break; } } } } while (0)

struct XcdBarrier {
    unsigned* bar; unsigned x;
    volatile LAS unsigned* st;
};

__device__ __forceinline__ XcdBarrier xcd_barrier_post(unsigned* bar, volatile LAS unsigned* st, const bool t0  ) {
    XcdBarrier b; b.bar = bar; b.x = xb_xcc_id(); b.st = st;
    if (t0) (void)xb_add(&bar[XB_XCNT(b.x)], 1u);
    return b;
}
__device__ __forceinline__ void xcd_barrier_complete(unsigned* bar, unsigned x, unsigned& nloc, unsigned& nx) {
    const unsigned G = gridDim.x * gridDim.y * gridDim.z;
    unsigned sum, cnt, mine, sp = 0u;
    for (;;) {
        sum = 0u; cnt = 0u; mine = 0u;
#pragma unroll
        for (unsigned j = 0; j < 16; ++j) { const unsigned c = xb_ld(&bar[XB_XCNT(j)]); sum += c; cnt += (c > 0u) ? 1u : 0u; mine = (j == x) ? c : mine; }
        if (sum == G) break;
        __builtin_amdgcn_s_sleep(1);
        if ((++sp & 255u) == 0u) { if (xb_ld(&bar[XB_TMO])) break; if (sp > XB_SPIN_CAP) { atomicAdd(&bar[XB_TMO], 1u); break; } }
    }
    nloc = mine > 0u ? mine : 1u; nx = cnt > 0u ? cnt : 1u;
}

__device__ __forceinline__ void xcd_barrier(const XcdBarrier& b, const int wv) {
    asm volatile("s_waitcnt vmcnt(0)" ::: "memory");
    __syncthreads();
    if (wv == 0 && (int)__builtin_amdgcn_mbcnt_hi(~0u, __builtin_amdgcn_mbcnt_lo(~0u, 0u)) == 0) {
        unsigned* bar = b.bar; unsigned bx = b.x; asm volatile("" : "+s"(bx));
        __builtin_amdgcn_s_waitcnt(0);
        unsigned nloc = b.st[0], nx = b.st[1];
        if (nloc == 0u) { xcd_barrier_complete(bar, bx, nloc, nx); b.st[0] = nloc; b.st[1] = nx; }
        const unsigned old = xb_add(&bar[XB_XSUB(bx)], 1u);
        const unsigned gen = old / nloc;
        if (old + 1u == (gen + 1u) * nloc) {
            __builtin_amdgcn_fence(__ATOMIC_RELEASE, "agent");
            asm volatile("s_waitcnt vmcnt(0)" ::: "memory");
            const unsigned og = xb_add(&bar[XB_TOP], 1u);
            const unsigned tg = og / nx;
            if (og + 1u == (tg + 1u) * nx) xb_add(&bar[XB_TOPGEN], 1u);
            else XB_SPIN(xb_ld(&bar[XB_TOPGEN]) == tg, bar);
            __builtin_amdgcn_fence(__ATOMIC_ACQUIRE, "agent");
            xb_add(&bar[XB_XGEN(bx)], 1u);
            asm volatile("s_waitcnt vmcnt(0)" ::: "memory");
        } else {
            XB_SPIN(xb_ld(&bar[XB_XGEN(bx)]) == gen, bar);
            __builtin_amdgcn_fence(__ATOMIC_ACQUIRE, "agent");
            asm volatile("s_waitcnt vmcnt(0)" ::: "memory");
        }
    }
    __syncthreads();
}

__global__ void __launch_bounds__(512, 2) fwd_kernel(Args a) {
    __shared__ __attribute__((aligned(16))) unsigned char lds_raw[LDS_BYTES];
    cg::grid_group grid = cg::this_grid();
    LAS unsigned char* lds = (LAS unsigned char*)lds_raw;
    const int wv = __builtin_amdgcn_readfirstlane((int)threadIdx.x >> 6);
    const bool t0 = wv == 0 && (int)__builtin_amdgcn_mbcnt_hi(~0u, __builtin_amdgcn_mbcnt_lo(~0u, 0u)) == 0;
    unsigned char* ws = a.ws;

    if (t0) { LAS long long* tab = (LAS long long*)(lds + TAB_OFF); ((LAS unsigned*)(lds + TAB_OFF + 224))[0] = 0u; ((LAS unsigned*)(lds + TAB_OFF + 224))[1] = 0u;
        tab[0] = (long long)((const unsigned char*)a.in[0] - (const unsigned char*)a.ws);
        tab[1] = (long long)((const unsigned char*)a.in[1] - (const unsigned char*)a.ws);
        tab[2] = (long long)((const unsigned char*)a.in[2] - (const unsigned char*)a.ws);
        tab[3] = (long long)((const unsigned char*)a.in[3] - (const unsigned char*)a.ws);
        tab[4] = (long long)((const unsigned char*)a.in[4] - (const unsigned char*)a.ws);
        tab[5] = (long long)((const unsigned char*)a.in[5] - (const unsigned char*)a.ws);
        tab[6] = (long long)((const unsigned char*)a.in[6] - (const unsigned char*)a.ws);
        tab[7] = (long long)((const unsigned char*)a.in[7] - (const unsigned char*)a.ws);
        tab[8] = (long long)((const unsigned char*)a.in[8] - (const unsigned char*)a.ws);
        tab[9] = (long long)((const unsigned char*)a.in[9] - (const unsigned char*)a.ws);
        tab[10] = (long long)((const unsigned char*)a.in[10] - (const unsigned char*)a.ws);
        tab[11] = (long long)((const unsigned char*)a.in[11] - (const unsigned char*)a.ws);
        tab[12] = (long long)((const unsigned char*)a.in[12] - (const unsigned char*)a.ws);
        tab[13] = (long long)((const unsigned char*)a.in[13] - (const unsigned char*)a.ws);
        tab[14] = (long long)((const unsigned char*)a.in[14] - (const unsigned char*)a.ws);
        tab[15] = (long long)((const unsigned char*)a.in[15] - (const unsigned char*)a.ws);
        tab[16] = (long long)((const unsigned char*)a.in[16] - (const unsigned char*)a.ws);
        tab[17] = (long long)((const unsigned char*)a.in[17] - (const unsigned char*)a.ws);
        tab[18] = (long long)((const unsigned char*)a.in[18] - (const unsigned char*)a.ws);
        tab[19] = (long long)((const unsigned char*)a.in[19] - (const unsigned char*)a.ws);
        tab[20] = (long long)((const unsigned char*)a.in[20] - (const unsigned char*)a.ws);
        tab[21] = (long long)((const unsigned char*)a.in[21] - (const unsigned char*)a.ws);
        tab[22] = (long long)((const unsigned char*)a.in[22] - (const unsigned char*)a.ws);
        tab[23] = (long long)((const unsigned char*)a.in[23] - (const unsigned char*)a.ws);
    }
    __syncthreads();
    const XcdBarrier bar = xcd_barrier_post((unsigned*)ws, (volatile LAS unsigned*)(lds + TAB_OFF + 224), t0);
    float* const xout = a.out;
#define WSL(w) size_t w##_z = 0; asm volatile("" : "+s"(w##_z)); unsigned char* w = ws + w##_z
#define HB(w) ((bf16_t*)((w) + WS_H))
#define ZB(w) ((bf16_t*)((w) + WS_Z))
#define MODP(w) ((const float*)((w) + WS_MOD))
    p0_phase(ws, lds, wv);
    grid.sync();
    { WSL(w); RowArgs ra{nullptr, INP(0), INP(1), nullptr, nullptr, nullptr, INP(6), MODP(w) + 1024, MODP(w), HB(w), nullptr, 0, DM}; row_phase<false, true, false, true>(ra, wv); }
    xcd_barrier(bar, wv);
#pragma unroll 1
    for (int l = 0; l < NLAYER; ++l) {
        { WSL(w); int Gl = gridDim.x, bl = blockIdx.x; asm volatile("" : "+s"(Gl), "+s"(bl));
          pg8::Gemm g{HB(w), (const bf16_t*)(w + WS_W + (size_t)l * WL + OW_IN), T, NIN, 1024, 1024}; pg8::StaticOrder S; S.init(T, NIN, Gl, bl);
          pg8::EpiStore<false> E{ZB(w), LZ, LZ, nullptr}; pg8::gemm_phase<pg8::EpiStore<false>, pg8::StaticOrder, true, true>(lds, g, S, E, wv); }
        xcd_barrier(bar, wv);
        { WSL(w); mid_phase(w, l, lds, wv); }
        xcd_barrier(bar, wv);
        { WSL(w); int Gl = gridDim.x, bl = blockIdx.x; asm volatile("" : "+s"(Gl), "+s"(bl));
          pg8::Gemm g{ZB(w) + ZQ, (const bf16_t*)(w + WS_W + (size_t)l * WL + OW_QB), T, 768, 384, LZ}; pg8::StaticOrder S; S.init(T, 768, Gl, bl);
          pg8::EpiQ E{HB(w), (const float*)(w + WS_ROPE), (const float*)(w + WS_SSQ)}; pg8::gemm_phase<pg8::EpiQ, pg8::StaticOrder, true, true>(lds, g, S, E, wv); }
        { WSL(w); int Gl = gridDim.x, bl = blockIdx.x; asm volatile("" : "+s"(Gl), "+s"(bl));
          pg8::Gemm g{ZB(w) + ZKV, (const bf16_t*)(w + WS_W + (size_t)l * WL + OW_KVB), T, 1024, 256, LZ}; pg8::StaticOrder S; S.init(T, 1024, Gl, bl);
          pg8::EpiKV E{ZB(w) + ZV, (bf16_t*)(w + WS_VT), (const float*)(w + WS_SSQ) + T}; pg8::gemm_phase<pg8::EpiKV, pg8::StaticOrder, true, true>(lds, g, S, E, wv); }
        xcd_barrier(bar, wv);
        { WSL(w); attn_phase(w, lds, wv); }
        xcd_barrier(bar, wv);
        { WSL(w); int Gl = gridDim.x, bl = blockIdx.x; asm volatile("" : "+s"(Gl), "+s"(bl));
          pg8::Gemm g{ZB(w) + ZATT, (const bf16_t*)(w + WS_W + (size_t)l * WL + OW_OUT), T, 1024, 1024, LZ}; pg8::StaticOrder S; S.init(T, 1024, Gl, bl);
          pg8::EpiStore<true> E{HB(w), DM, DM, (const float*)(w + WS_SSQ)}; pg8::gemm_phase<pg8::EpiStore<true>, pg8::StaticOrder, true, true>(lds, g, S, E, wv); }
        xcd_barrier(bar, wv);
        { WSL(w); const float* modl = MODP(w) + (size_t)l * NCR * NMODC;
          RowArgs ra{HB(w), INP(0), INP(1), nullptr, INP(7) + l * DM, modl + 2048, INP(8) + l * DM, modl + 4096, modl + 3072, EB(xout), (unsigned char*)xout, DM, 2048};
          if (l == 0) row_phase<true, true, false, true>(ra, wv); else row_phase<true, true, true, true>(ra, wv); }
        xcd_barrier(bar, wv);
        { WSL(w); int Gl = gridDim.x, bl = blockIdx.x; asm volatile("" : "+s"(Gl), "+s"(bl));
          pg8::Gemm g{EB(xout), (const bf16_t*)(w + WS_W + (size_t)l * WL + OW_GU), T, NGU, 1024, 2048}; pg8::StaticOrder S; S.init(T, NGU, Gl, bl);
          pg8::EpiGU E{HB(w)}; pg8::gemm_phase<pg8::EpiGU, pg8::StaticOrder, true, true>(lds, g, S, E, wv); }
        xcd_barrier(bar, wv);
        { WSL(w); int Gl = gridDim.x, bl = blockIdx.x; asm volatile("" : "+s"(Gl), "+s"(bl));
          pg8::Gemm g{HB(w), (const bf16_t*)(w + WS_W + (size_t)l * WL + OW_D), T, 1024, DFF, DFF}; pg8::StaticOrder S; S.init(T, 1024, Gl, bl);
          pg8::EpiStore<false> E{EB(xout), 2048, DM, nullptr}; pg8::gemm_phase<pg8::EpiStore<false>, pg8::StaticOrder, true, true>(lds, g, S, E, wv); }
        xcd_barrier(bar, wv);
        if (l + 1 < NLAYER) {
            WSL(w); const float* modl = MODP(w) + (size_t)l * NCR * NMODC; const float* modn = modl + NCR * NMODC;
            RowArgs ra{EB(xout), nullptr, nullptr, nullptr, INP(9) + l * DM, modl + 5120, INP(6) + (l + 1) * DM, modn + 1024, modn, HB(w), (unsigned char*)xout, 2048, DM};
            row_phase<true, true, true, true>(ra, wv);
            xcd_barrier(bar, wv);
        } else {
            WSL(w); const float* modl = MODP(w) + (size_t)l * NCR * NMODC;
            RowArgs ra{EB(xout), nullptr, nullptr, xout, INP(9) + l * DM, modl + 5120, nullptr, nullptr, nullptr, nullptr, (unsigned char*)xout, 2048, 0};
            row_phase<true, false, true, false>(ra, wv);
        }
    }
}

extern "C" void kernel_launch(void* const* d_in, const int* in_sizes, int n_in, void* d_out, int out_size, void* d_ws, size_t ws_size, hipStream_t stream) {
    static int grid = 0;
    if (grid == 0) {
        if (n_in != 24 || out_size != T * DM || ws_size < WS_END) { fprintf(stderr, "kernel_launch: unexpected problem (n_in %d out %d ws %zu)\n", n_in, out_size, ws_size); grid = -1; return; }
        int dev = 0, cus = 0, per_cu = 0;
        hipGetDevice(&dev); hipDeviceGetAttribute(&cus, hipDeviceAttributeMultiprocessorCount, dev);
        hipOccupancyMaxActiveBlocksPerMultiprocessor(&per_cu, (const void*)fwd_kernel, 512, 0);
        if (per_cu < 1) per_cu = 1;
        grid = cus * per_cu;
        fprintf(stderr, "kernel_launch: grid %d (cus %d x %d)\n", grid, cus, per_cu);
    }
    if (grid < 0) return;
    if (hipMemsetAsync(d_ws, 0, 16384, stream) != hipSuccess) { fprintf(stderr, "kernel_launch: memset failed\n"); return; }
    Args a{};
    for (int i = 0; i < 24; ++i) a.in[i] = (const float*)d_in[i];
    a.out = (float*)d_out; a.ws = (unsigned char*)d_ws;
    void* args[] = {&a};
    hipError_t e = hipLaunchCooperativeKernel((const void*)fwd_kernel, dim3(grid), dim3(512), args, 0, stream);
    if (e != hipSuccess) fprintf(stderr, "cooperative launch failed: %s (grid %d)\n", hipGetErrorString(e), grid);
}
```

```cpp
#include <hip/hip_runtime.h>
#include <hip/hip_cooperative_groups.h>
#include <cstdio>
#include <cstdint>
namespace cg = cooperative_groups;
namespace pg8 {
#define PG8_LAS __attribute__((address_space(3)))
typedef unsigned short bf16_t;
typedef short bf16x8 __attribute__((ext_vector_type(8)));
typedef float f32x4 __attribute__((ext_vector_type(4)));
typedef unsigned u32x4 __attribute__((ext_vector_type(4)));
constexpr int BM = 256, BK = 64, HALF = 128, HTB = HALF * BK * 2  , STAGE_BYTES = 8 * HTB, NXCD = 8, WGM = 8;

__host__ __device__ __forceinline__ int lds_byte(int r, int c) { const int st = (r >> 4) * 2 + (c >> 5), rr = r & 15, cc = c & 31, ob = rr * 64 + cc * 2; return st * 1024 + (ob ^ (((ob >> 9) & 1) << 5)); }
__host__ __device__ __forceinline__ void stage_rc(int b, int& R, int& C) { const int st = b / 1024, sb = b % 1024, swz = sb ^ (((sb >> 9) & 1) << 5); R = (st >> 1) * 16 + swz / 64; C = (st & 1) * 32 + (swz % 64) / 2; }
__host__ __device__ __forceinline__ int perm32(int rho) { const int n = rho >> 4, i = rho & 15; return 8 * (i >> 2) + 4 * n + (i & 3); }

struct Unit { int pm, pn; };
struct Gemm { const bf16_t* A; const bf16_t* Bt; int M, N, K, lda; };

struct StaticOrder {
    int nM, nN, nwg, G, c;
    __host__ __device__ void init(int M, int N, int G_, int c_) { nM = M / BM; nN = N / BM; nwg = nM * nN; G = G_; c = c_; }
    __host__ __device__ bool next(int i, Unit& u) const {
        const long L = (long)i * G + c; if (L >= nwg) return false;
        int wgid = (int)L; { const int q = nwg / NXCD, r = nwg % NXCD, xcd = wgid % NXCD, off = wgid / NXCD; wgid = (xcd < r ? xcd * (q + 1) : r * (q + 1) + (xcd - r) * q) + off; }
        const int nig = WGM * nN, gid = wgid / nig, fm = gid * WGM, gsz = (nM - fm) < WGM ? (nM - fm) : WGM;
        u.pm = fm + ((wgid % nig) % gsz); u.pn = (wgid % nig) / gsz; return true;
    }
    __device__ __forceinline__ void a_ready(const Unit&) const {}
    __device__ __forceinline__ void done(const Unit&) const {}
};

__device__ __forceinline__ unsigned cvt_pk_bf16(float lo, float hi) { unsigned r; asm volatile("v_cvt_pk_bf16_f32 %0, %1, %2" : "=v"(r) : "v"(lo), "v"(hi)); return r; }
typedef float f32x2 __attribute__((ext_vector_type(2)));
template <class Epi, class Sched, bool ALIGN_EPI = false, bool SP2 = false>
__device__ __forceinline__ void gemm_phase(PG8_LAS unsigned char* lds, const Gemm g, const Sched& S, const Epi& E, const int wv  ) {
    int tid0_ = wv * 64 + (int)__builtin_amdgcn_mbcnt_hi(~0u, __builtin_amdgcn_mbcnt_lo(~0u, 0u)); asm volatile("" : "+v"(tid0_));
    const int tid = tid0_, wid = __builtin_amdgcn_readfirstlane(tid >> 6), lane = tid & 63, wr = wid >> 2, wc = wid & 3, fr = lane & 15, fq = lane >> 4;
    const int K = g.K, nt = K / BK;
    unsigned voffA[2], voffB[2];
#pragma unroll
    for (int i = 0; i < 2; ++i) { int R, C; stage_rc(tid * 16 + i * 8192, R, C); const int Rb = Epi::PERM ? ((R & ~31) + perm32(R & 31)) : R;
        voffA[i] = (unsigned)(R * g.lda + C) * 2u; voffB[i] = (unsigned)(Rb * K + C) * 2u; }
    const size_t kstep = (size_t)(BK * 2);
    const size_t hstepB = (size_t)HALF * K * 2, hstepA = (size_t)HALF * g.lda * 2;
    const size_t tstepB = 2 * hstepB, tstepA = 2 * hstepA;
    const unsigned ldsw = (unsigned)wid * 1024u;
    const int aoff = lds_byte(wr * 64 + fr, fq * 8), boff = lds_byte(wc * 32 + fr, fq * 8);
#define PG8_SA(b, h) (((b) * 2 + (h)) * HTB)
#define PG8_SB(b, h) ((4 + (b) * 2 + (h)) * HTB)
#define PG8_STAGE(bufoff, gbase, voff) do { _Pragma("unroll") for (int _i = 0; _i < 2; ++_i) \
        __builtin_amdgcn_global_load_lds((const unsigned*)((const char*)(gbase) + (voff)[_i]), (PG8_LAS unsigned*)(lds + (bufoff) + ldsw + _i * 8192), 16, 0, 0); } while (0)
#define PG8_LDA(dst, b, h) do { _Pragma("unroll") for (int m = 0; m < 4; ++m) _Pragma("unroll") for (int k = 0; k < 2; ++k) dst[m][k] = *(const PG8_LAS bf16x8*)(lds + PG8_SA(b, h) + aoff + m * 2048 + k * 1024); } while (0)
#define PG8_LDB(dst, b, h) do { _Pragma("unroll") for (int n = 0; n < 2; ++n) _Pragma("unroll") for (int k = 0; k < 2; ++k) dst[n][k] = *(const PG8_LAS bf16x8*)(lds + PG8_SB(b, h) + boff + n * 2048 + k * 1024); } while (0)
#define PG8_MMA(ai, bj, At, Bt) do { __builtin_amdgcn_s_setprio(1); _Pragma("unroll") for (int m = 0; m < 4; ++m) _Pragma("unroll") for (int n = 0; n < 2; ++n) _Pragma("unroll") for (int k = 0; k < 2; ++k) \
        acc[ai][bj][m][n] = __builtin_amdgcn_mfma_f32_16x16x32_bf16(Bt[n][k], At[m][k], acc[ai][bj][m][n], 0, 0, 0); __builtin_amdgcn_s_setprio(0); } while (0)
#define PG8_WAIT_V(n) asm volatile("s_waitcnt vmcnt(" #n ")" ::: "memory")
#define PG8_WAIT_L(n) asm volatile("s_waitcnt lgkmcnt(" #n ")" ::: "memory")
#define PG8_BAR __builtin_amdgcn_s_barrier()
#define PG8_SCHED __builtin_amdgcn_sched_barrier(0)
    Unit cur, nxt; int ui = 0;
    if (!S.next(0, cur)) return;
    f32x4 acc[2][2][4][2];
#pragma unroll
    for (int a = 0; a < 2; ++a)
#pragma unroll
        for (int b = 0; b < 2; ++b)
#pragma unroll
            for (int m = 0; m < 4; ++m)
#pragma unroll
                for (int n = 0; n < 2; ++n) acc[a][b][m][n] = (f32x4){0.f, 0.f, 0.f, 0.f};
    bf16x8 At[4][2], B0[2][2], B1[2][2];
    const char* cA = (const char*)g.A + (size_t)cur.pm * tstepA; const char* cB = (const char*)g.Bt + (size_t)cur.pn * tstepB;
    S.a_ready(cur);
    if constexpr (SP2) {
        PG8_STAGE(PG8_SB(0, 0), cB, voffB); PG8_STAGE(PG8_SB(0, 1), cB + hstepB, voffB); PG8_STAGE(PG8_SA(0, 0), cA, voffA); PG8_STAGE(PG8_SA(0, 1), cA + hstepA, voffA);
        if (wr == 1) PG8_BAR;
        PG8_WAIT_V(2); PG8_BAR;
        PG8_STAGE(PG8_SB(1, 0), cB + kstep, voffB); PG8_STAGE(PG8_SA(1, 0), cA + kstep, voffA); PG8_STAGE(PG8_SB(1, 1), cB + hstepB + kstep, voffB);
        PG8_WAIT_V(6); PG8_BAR;
    } else {
        PG8_STAGE(PG8_SB(0, 0), cB, voffB); PG8_STAGE(PG8_SA(0, 0), cA, voffA); PG8_STAGE(PG8_SB(0, 1), cB + hstepB, voffB); PG8_STAGE(PG8_SA(0, 1), cA + hstepA, voffA);
        if (wr == 1) PG8_BAR;
        PG8_WAIT_V(4); PG8_BAR;
        PG8_STAGE(PG8_SB(1, 0), cB + kstep, voffB); PG8_STAGE(PG8_SA(1, 0), cA + kstep, voffA); PG8_STAGE(PG8_SB(1, 1), cB + hstepB + kstep, voffB);
        PG8_WAIT_V(6); PG8_BAR;
    }
    for (;;) {
        const bool has_next = S.next(ui + 1, nxt);
        const char* nA = has_next ? (const char*)g.A + (size_t)nxt.pm * tstepA : cA; const char* nB = has_next ? (const char*)g.Bt + (size_t)nxt.pn * tstepB : cB;
#pragma unroll 1
        for (int t = 0; t < nt; t += 2) {
            const bool last = (t == nt - 2);
            if constexpr (Epi::MIDK) { if (t == 8) E.midk(acc, cur, wr, fr); }
            const char* a1 = cA + (size_t)(t + 1) * kstep;
            const char* a2 = last ? nA : cA + (size_t)(t + 2) * kstep; const char* b2 = last ? nB : cB + (size_t)(t + 2) * kstep;
            const char* a3 = a2 + kstep; const char* b3 = b2 + kstep;
            if (last && has_next) S.a_ready(nxt);
            if constexpr (SP2) {
            PG8_LDB(B0, 0, 0); PG8_LDB(B1, 0, 1); PG8_SCHED; PG8_LDA(At, 0, 0); PG8_STAGE(PG8_SA(1, 1), a1 + hstepA, voffA);
            PG8_WAIT_V(8); PG8_WAIT_L(0); PG8_BAR; PG8_MMA(0, 0, At, B0); PG8_MMA(0, 1, At, B1); PG8_BAR; PG8_SCHED;
            PG8_LDA(At, 0, 1); PG8_STAGE(PG8_SB(0, 0), b2, voffB); PG8_STAGE(PG8_SB(0, 1), b2 + hstepB, voffB); PG8_STAGE(PG8_SA(0, 0), a2, voffA);
            PG8_WAIT_V(8); PG8_WAIT_L(0); PG8_BAR; PG8_MMA(1, 0, At, B0); PG8_MMA(1, 1, At, B1); PG8_BAR; PG8_SCHED;
            PG8_LDB(B0, 1, 0); PG8_LDB(B1, 1, 1); PG8_SCHED; PG8_LDA(At, 1, 0); PG8_STAGE(PG8_SA(0, 1), a2 + hstepA, voffA);
            PG8_WAIT_V(8); PG8_WAIT_L(0); PG8_BAR; PG8_MMA(0, 0, At, B0); PG8_MMA(0, 1, At, B1); PG8_BAR; PG8_SCHED;
            PG8_LDA(At, 1, 1); PG8_STAGE(PG8_SB(1, 0), b3, voffB); PG8_STAGE(PG8_SB(1, 1), b3 + hstepB, voffB); PG8_STAGE(PG8_SA(1, 0), a3, voffA);
            PG8_WAIT_V(8); PG8_WAIT_L(0); PG8_BAR; PG8_MMA(1, 0, At, B0); PG8_MMA(1, 1, At, B1); PG8_BAR; PG8_SCHED;
            } else {
            PG8_LDB(B0, 0, 0); PG8_SCHED; PG8_LDA(At, 0, 0); PG8_STAGE(PG8_SA(1, 1), a1 + hstepA, voffA);
            PG8_WAIT_L(8); PG8_BAR; PG8_WAIT_L(0); PG8_MMA(0, 0, At, B0); PG8_BAR; PG8_SCHED;
            PG8_LDB(B1, 0, 1); PG8_STAGE(PG8_SB(0, 0), b2, voffB);
            PG8_BAR; PG8_WAIT_L(0); PG8_MMA(0, 1, At, B1); PG8_BAR;
            PG8_LDA(At, 0, 1); PG8_STAGE(PG8_SA(0, 0), a2, voffA);
            PG8_BAR; PG8_WAIT_L(0); PG8_MMA(1, 0, At, B0); PG8_BAR; PG8_SCHED;
            PG8_STAGE(PG8_SB(0, 1), b2 + hstepB, voffB);
            PG8_WAIT_V(6); PG8_BAR; PG8_MMA(1, 1, At, B1); PG8_BAR;
            PG8_LDB(B0, 1, 0); PG8_SCHED; PG8_LDA(At, 1, 0); PG8_STAGE(PG8_SA(0, 1), a2 + hstepA, voffA);
            PG8_WAIT_L(8); PG8_BAR; PG8_WAIT_L(0); PG8_MMA(0, 0, At, B0); PG8_BAR; PG8_SCHED;
            PG8_LDB(B1, 1, 1); PG8_STAGE(PG8_SB(1, 0), b3, voffB);
            PG8_BAR; PG8_WAIT_L(0); PG8_MMA(0, 1, At, B1); PG8_BAR;
            PG8_LDA(At, 1, 1); PG8_STAGE(PG8_SA(1, 0), a3, voffA);
            PG8_BAR; PG8_WAIT_L(0); PG8_MMA(1, 0, At, B0); PG8_BAR; PG8_SCHED;
            PG8_STAGE(PG8_SB(1, 1), b3 + hstepB, voffB);
            PG8_WAIT_V(6); PG8_BAR; PG8_MMA(1, 1, At, B1); PG8_BAR;
            }
        }
        if constexpr (ALIGN_EPI) { if (wr == 0) PG8_BAR; }
        if constexpr (!Epi::AFTER_DRAIN) { E(acc, cur, wr, wc, fr, fq); S.done(cur); }
        if (!has_next) break;
#pragma unroll
        for (int a = 0; a < 2; ++a)
#pragma unroll
            for (int b = 0; b < 2; ++b)
#pragma unroll
                for (int m = 0; m < 4; ++m)
#pragma unroll
                    for (int n = 0; n < 2; ++n) acc[a][b][m][n] = (f32x4){0.f, 0.f, 0.f, 0.f};
        cur = nxt; cA = nA; cB = nB; ++ui;
        if constexpr (ALIGN_EPI) { if (wr == 1) PG8_BAR; }
    }
    PG8_WAIT_V(0);
    if constexpr (!ALIGN_EPI) { if (wr == 0) PG8_BAR; }
    PG8_BAR;
    if constexpr (Epi::AFTER_DRAIN) { E.fused(acc, cur, wr, wc, fr, fq, lds, wid, lane); S.done(cur); }
#undef PG8_SA
#undef PG8_SB
#undef PG8_STAGE
#undef PG8_LDA
#undef PG8_LDB
#undef PG8_MMA
#undef PG8_WAIT_V
#undef PG8_WAIT_L
#undef PG8_BAR
#undef PG8_SCHED
}
}

#define LAS __attribute__((address_space(3)))
using pg8::bf16_t; using pg8::bf16x8; using pg8::f32x4; using pg8::u32x4;
typedef float f32x16 __attribute__((ext_vector_type(16)));
typedef float f32x2v __attribute__((ext_vector_type(2)));
typedef __bf16 bf16x2v __attribute__((ext_vector_type(2)));
typedef unsigned u32x2 __attribute__((ext_vector_type(2)));

constexpr int T = 32768, TP = 16384, DM = 1024, NLAYER = 2, NCR = 10, NMODC = 6144;
constexpr int INC = 1696, LZ = 1728, ZQ = 0, ZKV = 384, ZKR = 640, ZU = 704, ZV = 1216, ZATT = 192, NIN = 1792;
constexpr int DFF = 2816, NGU = 5632;
constexpr float EPS = 1e-6f;
constexpr float QSCALE = 0.10206207261596577f * 1.4426950408889634f;
constexpr size_t MiB = 1u << 20;
constexpr size_t WS_MOD = 512 * 1024, WS_ROPE = 1 * MiB, WS_SSQ = 2 * MiB, WS_W = 3 * MiB;
constexpr size_t OW_IN = 0, OW_QB = 3670016, OW_KVB = 4259840, OW_OUT = 4784128, OW_GU = 6881280, OW_D = 18415616, OW_S = 24182784, WL = 24444928;
constexpr size_t WS_H = 50 * MiB, WS_Z = 114 * MiB, WS_VT = 222 * MiB, WS_END = 254 * MiB;
static_assert(WS_Z + (size_t)32768 * LZ * 2 <= WS_VT, "z fits");
static_assert(WS_W + 2 * WL <= WS_H, "weights fit");
constexpr int LDS_BYTES = 147456;

struct Args { const float* in[24]; float* out; unsigned char* ws; };
constexpr int TAB_OFF = LDS_BYTES - 256;
typedef const float* cfptr;
#define GAS __attribute__((address_space(1)))
#define EB(xo) ((bf16_t*)((unsigned char*)(xo) + 2048))
#define INP(k) ((const float*)(ws + ((LAS long long*)(lds + TAB_OFF))[k]))

__device__ __forceinline__ float bf_lo(unsigned w) { return __uint_as_float(w << 16); }
__device__ __forceinline__ float bf_hi(unsigned w) { return __uint_as_float(w & 0xffff0000u); }
__device__ __forceinline__ unsigned pk2(float lo, float hi) { f32x2v v = {lo, hi}; bf16x2v b = __builtin_convertvector(v, bf16x2v); return __builtin_bit_cast(unsigned, b); }
__device__ __forceinline__ float wave_sum(float v) {
#pragma unroll
    for (int o = 1; o < 64; o <<= 1) v += __shfl_xor(v, o);
    return v;
}
__device__ __forceinline__ float gelu_tanh(float x) {
    const float u = 0.7978845608028654f * (x + 0.044715f * x * x * x);
    const float e = __builtin_amdgcn_exp2f(-2.8853900817779268f * u);
    return x * __builtin_amdgcn_rcpf(1.0f + e);
}
__device__ __forceinline__ float silu_f(float x) { return x * __builtin_amdgcn_rcpf(1.0f + __builtin_amdgcn_exp2f(-1.4426950408889634f * x)); }
__device__ __forceinline__ int tok_pos(int row) { return row < TP ? (row & 8191) : (row & 2047); }
__device__ __forceinline__ int tok_cr(int row) { return row < TP ? (row >> 13) : 2 + ((row - TP) >> 11); }

namespace pg8 {
template <bool MK> struct EpiStore {
    static constexpr bool PERM = true, AFTER_DRAIN = false, MIDK = MK;
    bf16_t* O; int ldc; int ncols; const float* ssq;
    __device__ __forceinline__ void operator()(const f32x4 (&acc)[2][2][4][2], const Unit& u, int wr, int wc, int fr, int fq) const {
        const int row0 = u.pm * BM + wr * 64 + fr, col0 = u.pn * BM + wc * 32 + 8 * fq;
#pragma unroll
        for (int ai = 0; ai < 2; ++ai)
#pragma unroll
            for (int m = 0; m < 4; ++m) { bf16_t* rowp = O + (size_t)(row0 + ai * HALF + m * 16) * ldc + col0;
#pragma unroll
                for (int bj = 0; bj < 2; ++bj) if (col0 + bj * HALF < ncols) { const f32x4 v0 = acc[ai][bj][m][0], v1 = acc[ai][bj][m][1];
                    u32x4 w; w.x = pk2(v0[0], v0[1]); w.y = pk2(v0[2], v0[3]); w.z = pk2(v1[0], v1[1]); w.w = pk2(v1[2], v1[3]);
                    *(u32x4*)(rowp + bj * HALF) = w; } }
    }
    __device__ __forceinline__ void midk(f32x4 (&acc)[2][2][4][2], const Unit& u, int wr, int fr) const {
#pragma unroll
        for (int ai = 0; ai < 2; ++ai)
#pragma unroll
            for (int m = 0; m < 4; ++m) { int row = u.pm * BM + ai * HALF + wr * 64 + m * 16 + fr; asm volatile("" : "+v"(row) :: "memory"); const f32x4* p = (const f32x4*)(ssq + (size_t)row * 8);
                const f32x4 s0 = p[0], s1 = p[1]; const float s = ((s0[0] + s0[1]) + (s0[2] + s0[3])) + ((s1[0] + s1[1]) + (s1[2] + s1[3]));
                const float rs = rsqrtf(s * (1.0f / 512.0f) + EPS);
#pragma unroll
                for (int bj = 0; bj < 2; ++bj)
#pragma unroll
                    for (int n = 0; n < 2; ++n) acc[ai][bj][m][n] *= rs; }
    }
};
struct EpiQ {
    static constexpr bool PERM = false, AFTER_DRAIN = false, MIDK = false;
    bf16_t* Q; const float* rope; const float* rstd;
    __device__ __forceinline__ void midk(f32x4 (&)[2][2][4][2], const Unit&, int, int) const {}
    __device__ __forceinline__ void operator()(const f32x4 (&acc)[2][2][4][2], const Unit& u, int wr, int wc, int fr, int fq) const {
        const int G0 = 8 * u.pn + wc, part0 = G0 % 3, part1 = (G0 + 4) % 3;
#pragma unroll
        for (int ai = 0; ai < 2; ++ai)
#pragma unroll
            for (int m = 0; m < 4; ++m) { int row = u.pm * BM + ai * HALF + wr * 64 + m * 16 + fr; asm volatile("" : "+v"(row)); bf16_t* rp = Q + (size_t)row * 768 + 32 * G0 + 4 * fq;
                const float rs = rstd[row] * QSCALE;
                f32x4 cs = {1.f, 1.f, 1.f, 1.f}, sn = {0.f, 0.f, 0.f, 0.f};
                if (part0 == 2 || part1 == 2) { const f32x4* t = (const f32x4*)(rope + ((size_t)tok_pos(row) * 16 + 4 * fq) * 2); const f32x4 c0 = t[0], c1 = t[1];
                    cs = (f32x4){c0[0], c0[2], c1[0], c1[2]}; sn = (f32x4){c0[1], c0[3], c1[1], c1[3]}; }
#pragma unroll
                for (int bj = 0; bj < 2; ++bj) { const bool rp2 = (bj == 0 ? part0 : part1) == 2;
                    f32x4 x1 = acc[ai][bj][m][0] * rs, x2 = acc[ai][bj][m][1] * rs;
                    if (rp2) { const f32x4 o1 = x1 * cs - x2 * sn, o2 = x1 * sn + x2 * cs; x1 = o1; x2 = o2; }
                    u32x2 w1, w2; w1.x = pk2(x1[0], x1[1]); w1.y = pk2(x1[2], x1[3]); w2.x = pk2(x2[0], x2[1]); w2.y = pk2(x2[2], x2[3]);
                    *(u32x2*)(rp + 128 * bj) = w1; *(u32x2*)(rp + 128 * bj + 16) = w2; }
                asm volatile("" ::: "memory"); }
    }
};
struct EpiKV {
    static constexpr bool PERM = true, AFTER_DRAIN = false, MIDK = false;
    bf16_t* kn; bf16_t* vt; const float* rstd;
    __device__ __forceinline__ void midk(f32x4 (&)[2][2][4][2], const Unit&, int, int) const {}
    __device__ __forceinline__ void operator()(const f32x4 (&acc)[2][2][4][2], const Unit& u, int wr, int wc, int fr, int fq) const {
        const int sfr = (fr & 3) | ((fr & 4) << 1) | ((fr & 8) >> 1); const int within = 32 * wc + 8 * fq;
#pragma unroll
        for (int ai = 0; ai < 2; ++ai)
#pragma unroll
            for (int m = 0; m < 4; ++m) { int row = u.pm * BM + ai * HALF + wr * 64 + m * 16 + fr; asm volatile("" : "+v"(row)); const float rs = rstd[row];
#pragma unroll
                for (int bj = 0; bj < 2; ++bj) { const int head = 2 * u.pn + bj;
                    const f32x4 v0 = acc[ai][bj][m][0] * rs, v1 = acc[ai][bj][m][1] * rs;
                    u32x4 w; w.x = pk2(v0[0], v0[1]); w.y = pk2(v0[2], v0[3]); w.z = pk2(v1[0], v1[1]); w.w = pk2(v1[2], v1[3]);
                    if (wc < 2) { *(u32x4*)(kn + (size_t)row * LZ + head * 64 + within) = w; }
                    else { bf16_t* vp = vt + (size_t)(head * 64 + within - 64) * T + ((row & ~15) | sfr);
                        vp[0] = (bf16_t)(w.x & 0xffffu); vp[(size_t)T] = (bf16_t)(w.x >> 16); vp[(size_t)2 * T] = (bf16_t)(w.y & 0xffffu); vp[(size_t)3 * T] = (bf16_t)(w.y >> 16);
                        vp[(size_t)4 * T] = (bf16_t)(w.z & 0xffffu); vp[(size_t)5 * T] = (bf16_t)(w.z >> 16); vp[(size_t)6 * T] = (bf16_t)(w.w & 0xffffu); vp[(size_t)7 * T] = (bf16_t)(w.w >> 16); } }
                asm volatile("" ::: "memory"); }
    }
};
struct EpiGU {
    static constexpr bool PERM = true, AFTER_DRAIN = false, MIDK = false;
    bf16_t* O;
    __device__ __forceinline__ void midk(f32x4 (&)[2][2][4][2], const Unit&, int, int) const {}
    __device__ __forceinline__ void operator()(const f32x4 (&acc)[2][2][4][2], const Unit& u, int wr, int wc, int fr, int fq) const {
        const int col = 128 * u.pn + 32 * wc + 8 * fq;
#pragma unroll
        for (int ai = 0; ai < 2; ++ai)
#pragma unroll
            for (int m = 0; m < 4; ++m) { const int row = u.pm * BM + ai * HALF + wr * 64 + m * 16 + fr;
                const f32x4 g0 = acc[ai][0][m][0], g1 = acc[ai][0][m][1], u0 = acc[ai][1][m][0], u1 = acc[ai][1][m][1];
                u32x4 w; w.x = pk2(silu_f(g0[0]) * u0[0], silu_f(g0[1]) * u0[1]); w.y = pk2(silu_f(g0[2]) * u0[2], silu_f(g0[3]) * u0[3]);
                w.z = pk2(silu_f(g1[0]) * u1[0], silu_f(g1[1]) * u1[1]); w.w = pk2(silu_f(g1[2]) * u1[2], silu_f(g1[3]) * u1[3]);
                *(u32x4*)(O + (size_t)row * DFF + col) = w; }
    }
};
}

__device__ __forceinline__ int rowmap(int mode, int n) { return mode == 0 ? n : mode == 3 ? (n < 672 ? n : n + 32) : (((n >> 7) << 8) + (n & 127) + (mode == 2 ? 128 : 0)); }
__device__ __forceinline__ void transpose_item(const float* W, int K, int N, bf16_t* WT, int mode, const float* gain, LAS float* scr, int item, int lane) {
    const int nblk = N / 32, kb = item / nblk, nb = item % nblk, k0 = 64 * kb, n0 = 32 * nb;
    { const int kq = lane >> 3, nq = lane & 7;
      f32x4 v[8];
#pragma unroll
      for (int i = 0; i < 8; ++i) v[i] = __builtin_nontemporal_load((const f32x4*)(W + (size_t)(k0 + 8 * i + kq) * N + n0 + 4 * nq));
#pragma unroll
      for (int i = 0; i < 8; ++i) { const int kk = 8 * i + kq; const float gk = gain ? gain[k0 + kk] : 1.0f;
#pragma unroll
          for (int e = 0; e < 4; ++e) scr[kk * 33 + 4 * nq + e] = v[i][e] * gk; } }
    asm volatile("s_waitcnt lgkmcnt(0)" ::: "memory");
    const int c = lane & 7;
#pragma unroll
    for (int j = 0; j < 4; ++j) { const int n = (lane >> 3) + 8 * j; const LAS float* s = scr + (8 * c) * 33 + n;
        u32x4 o; o.x = pk2(s[0 * 33], s[1 * 33]); o.y = pk2(s[2 * 33], s[3 * 33]); o.z = pk2(s[4 * 33], s[5 * 33]); o.w = pk2(s[6 * 33], s[7 * 33]);
        *(u32x4*)(WT + (size_t)rowmap(mode, n0 + n) * K + k0 + 8 * c) = o; }
    asm volatile("s_waitcnt lgkmcnt(0)" ::: "memory");
}

constexpr int WT_I_IN = 16 * 53, WT_I_QB = 6 * 24, WT_I_KVB = 4 * 32, WT_I_OUT = 16 * 32, WT_I_G = 16 * 88, WT_I_D = 44 * 32;
constexpr int WT_NITEMS = WT_I_IN + WT_I_QB + WT_I_KVB + WT_I_OUT + 2 * WT_I_G + WT_I_D;
__device__ __forceinline__ void wt_convert(unsigned char* ws, LAS unsigned char* lds, int l, int it0, int it1, int rank, int nwk, int tid, int lane, int wid) {
    unsigned char* wb = ws + WS_W + (size_t)l * WL;
    if (it0 == 0) {
        const int gtid = rank * 512 + tid, NT = nwk * 512;
        for (int j = gtid; j < 65536; j += NT) { const float* s = INP(16) + (size_t)l * 131072 + 2 * j; ((unsigned*)(wb + OW_S))[j] = pk2(s[0], s[1]); }
        for (int j = gtid; j < 12288; j += NT) { const int r = j >> 7, dr = r < 32 ? 672 + r : 1728 + (r - 32);
            ((u32x4*)(wb + OW_IN))[(size_t)dr * 128 + (j & 127)] = (u32x4){0u, 0u, 0u, 0u}; }
    }
    LAS float* scr = (LAS float*)(lds + 65536) + wid * (64 * 33);
    for (int it = it0 + rank * 8 + wid; it < it1; it += nwk * 8) {
        int r = it;
        if (r < WT_I_IN) { transpose_item(INP(10) + (size_t)l * 1024 * INC, 1024, INC, (bf16_t*)(wb + OW_IN), 3, nullptr, scr, r, lane); continue; } r -= WT_I_IN;
        if (r < WT_I_QB) { transpose_item(INP(12) + (size_t)l * 384 * 768, 384, 768, (bf16_t*)(wb + OW_QB), 0, INP(11) + l * 384, scr, r, lane); continue; } r -= WT_I_QB;
        if (r < WT_I_KVB) { transpose_item(INP(14) + (size_t)l * 256 * 1024, 256, 1024, (bf16_t*)(wb + OW_KVB), 0, INP(13) + l * 256, scr, r, lane); continue; } r -= WT_I_KVB;
        if (r < WT_I_OUT) { const int kb = r / 32; transpose_item(INP(20) + (size_t)l * 1024 * 1024, 1024, 1024, (bf16_t*)(wb + OW_OUT), 0, kb < 8 ? INP(18) + l * 512 : INP(19) + l * 512 - 512, scr, r, lane); continue; } r -= WT_I_OUT;
        if (r < WT_I_G) { transpose_item(INP(21) + (size_t)l * 1024 * DFF, 1024, DFF, (bf16_t*)(wb + OW_GU), 1, nullptr, scr, r, lane); continue; } r -= WT_I_G;
        if (r < WT_I_G) { transpose_item(INP(22) + (size_t)l * 1024 * DFF, 1024, DFF, (bf16_t*)(wb + OW_GU), 2, nullptr, scr, r, lane); continue; } r -= WT_I_G;
        transpose_item(INP(23) + (size_t)l * DFF * 1024, DFF, 1024, (bf16_t*)(wb + OW_D), 0, nullptr, scr, r, lane);
    }
}

__device__ __forceinline__ void p0_phase(unsigned char* ws, LAS unsigned char* lds, const int wv) {
    int tid = wv * 64 + (int)__builtin_amdgcn_mbcnt_hi(~0u, __builtin_amdgcn_mbcnt_lo(~0u, 0u)); asm volatile("" : "+v"(tid)); const int lane = tid & 63, wid = wv;
    const int G = gridDim.x;
    {
        LAS float* cs = (LAS float*)lds; LAS float* red = cs + NCR * 1024;
        float* mod = (float*)(ws + WS_MOD);
        for (int bg = blockIdx.x; bg < 192; bg += G) {
            for (int t = tid; t < NCR * 1024; t += 512) { const int cr = t >> 10, k = t & 1023; const float c = cr < 2 ? INP(2)[cr * 1024 + k] : INP(3)[(cr - 2) * 1024 + k]; cs[t] = silu_f(c); }
            __syncthreads();
            const int l = bg / 96, cb = (bg % 96) * 64;
            const int cg4 = lane & 15, kq = lane >> 4;
            const float* wm = INP(4) + (size_t)l * 1024 * NMODC + cb + 4 * cg4;
            f32x4 acc[NCR];
#pragma unroll
            for (int cr = 0; cr < NCR; ++cr) acc[cr] = (f32x4){0.f, 0.f, 0.f, 0.f};
#pragma unroll 8
            for (int kk = 0; kk < 32; ++kk) { const int k = wid * 128 + 4 * kk + kq; const f32x4 w = __builtin_nontemporal_load((const f32x4*)(wm + (size_t)k * NMODC));
#pragma unroll
                for (int cr = 0; cr < NCR; ++cr) acc[cr] += w * cs[cr * 1024 + k]; }
#pragma unroll
            for (int cr = 0; cr < NCR; ++cr) {
#pragma unroll
                for (int e = 0; e < 4; ++e) { float s = acc[cr][e]; s += __shfl_xor(s, 16); s += __shfl_xor(s, 32); acc[cr][e] = s; }
                if (kq == 0) *(LAS f32x4*)(red + (wid * NCR + cr) * 64 + 4 * cg4) = acc[cr]; }
            __syncthreads();
            for (int t = tid; t < NCR * 64; t += 512) { const int cr = t >> 6, ln = t & 63; float s = 0.f;
#pragma unroll
                for (int w = 0; w < 8; ++w) s += red[(w * NCR + cr) * 64 + ln];
                mod[(size_t)(l * NCR + cr) * NMODC + cb + ln] = s + INP(5)[l * NMODC + cb + ln]; }
            __syncthreads();
        }
    }
    const int gtid = blockIdx.x * 512 + tid, NT = G * 512;
    {
        float* rope = (float*)(ws + WS_ROPE);
        for (int idx = gtid; idx < 8192 * 16; idx += NT) { const int pos = idx >> 4, i = idx & 15;
            const float inv = exp2f(-(float)i * 0.8304820237218406f);
            const float ang = (float)pos * inv;
            double rev = (double)ang * 0.15915494309189535; rev -= __builtin_rint(rev);
            const float rf = (float)rev;
            rope[2 * idx] = __builtin_amdgcn_cosf(rf); rope[2 * idx + 1] = __builtin_amdgcn_sinf(rf); }
    }
    wt_convert(ws, lds, 0, 0, WT_NITEMS, blockIdx.x, G, tid, lane, wid);
    wt_convert(ws, lds, 1, 0, WT_NITEMS, blockIdx.x, G, tid, lane, wid);
}

struct RowArgs { const bf16_t* src; const float* xin_p; const float* xin_s; float* xout; const float* gpost; const float* ga; const float* gpre; const float* sc; const float* sh; bf16_t* hout; unsigned char* xb; int src_ld, h_ld; };
template <bool HAS_RES, bool HAS_H, bool XIN_BF, bool XOUT_BF>
__device__ __forceinline__ void row_phase(const RowArgs& ra, const int wv) {
    int tid = wv * 64 + (int)__builtin_amdgcn_mbcnt_hi(~0u, __builtin_amdgcn_mbcnt_lo(~0u, 0u)); asm volatile("" : "+v"(tid)); const int lane = tid & 63, wid = wv;
    const int gw = blockIdx.x * 8 + wid, NGW = gridDim.x * 8;
    for (int grp = gw; grp < T / 16; grp += NGW) {
        const int r0 = grp * 16, cr = tok_cr(r0);
        float A[16], B[16], S[16];
#pragma unroll
        for (int j = 0; j < 2; ++j)
#pragma unroll
            for (int q = 0; q < 2; ++q) { const int c = 512 * j + 8 * lane + 4 * q;
                if (HAS_RES) { const f32x4 g = *(const f32x4*)(ra.gpost + c), m = *(const f32x4*)(ra.ga + (size_t)cr * NMODC + c);
#pragma unroll
                    for (int e = 0; e < 4; ++e) A[8 * j + 4 * q + e] = g[e] * m[e]; }
                if (HAS_H) { const f32x4 g = *(const f32x4*)(ra.gpre + c), s1 = *(const f32x4*)(ra.sc + (size_t)cr * NMODC + c), s2 = *(const f32x4*)(ra.sh + (size_t)cr * NMODC + c);
#pragma unroll
                    for (int e = 0; e < 4; ++e) { B[8 * j + 4 * q + e] = g[e] * (1.0f + s1[e]); S[8 * j + 4 * q + e] = s2[e]; } } }
#pragma unroll 2
        for (int i = 0; i < 16; ++i) {
            const int row = r0 + i;
            float x[16];
            if constexpr (XIN_BF) {
#pragma unroll
                for (int j = 0; j < 2; ++j) { const u32x4 w = __builtin_nontemporal_load((const u32x4*)((const bf16_t*)(ra.xb + (size_t)row * 4096) + 512 * j + 8 * lane));
                    x[8 * j + 0] = bf_lo(w.x); x[8 * j + 1] = bf_hi(w.x); x[8 * j + 2] = bf_lo(w.y); x[8 * j + 3] = bf_hi(w.y);
                    x[8 * j + 4] = bf_lo(w.z); x[8 * j + 5] = bf_hi(w.z); x[8 * j + 6] = bf_lo(w.w); x[8 * j + 7] = bf_hi(w.w); }
            } else {
                const float* xr = row < TP ? ra.xin_p + (size_t)row * DM : ra.xin_s + (size_t)(row - TP) * DM;
#pragma unroll
                for (int j = 0; j < 2; ++j)
#pragma unroll
                    for (int q = 0; q < 2; ++q) { const f32x4 v = __builtin_nontemporal_load((const f32x4*)(xr + 512 * j + 8 * lane + 4 * q));
#pragma unroll
                        for (int e = 0; e < 4; ++e) x[8 * j + 4 * q + e] = v[e]; }
            }
            if (HAS_RES) {
                float sv[16]; float ss = 0.f;
#pragma unroll
                for (int j = 0; j < 2; ++j) { const u32x4 w = __builtin_nontemporal_load((const u32x4*)(ra.src + (size_t)row * ra.src_ld + 512 * j + 8 * lane));
                    sv[8 * j + 0] = bf_lo(w.x); sv[8 * j + 1] = bf_hi(w.x); sv[8 * j + 2] = bf_lo(w.y); sv[8 * j + 3] = bf_hi(w.y);
                    sv[8 * j + 4] = bf_lo(w.z); sv[8 * j + 5] = bf_hi(w.z); sv[8 * j + 6] = bf_lo(w.w); sv[8 * j + 7] = bf_hi(w.w); }
#pragma unroll
                for (int e = 0; e < 16; ++e) ss += sv[e] * sv[e];
                const float rs = rsqrtf(wave_sum(ss) * (1.0f / DM) + EPS);
#pragma unroll
                for (int e = 0; e < 16; ++e) x[e] += A[e] * (sv[e] * rs);
                if constexpr (XOUT_BF) {
#pragma unroll
                    for (int j = 0; j < 2; ++j) { u32x4 w; w.x = pk2(x[8 * j], x[8 * j + 1]); w.y = pk2(x[8 * j + 2], x[8 * j + 3]); w.z = pk2(x[8 * j + 4], x[8 * j + 5]); w.w = pk2(x[8 * j + 6], x[8 * j + 7]);
                        __builtin_nontemporal_store(w, (u32x4*)((bf16_t*)(ra.xb + (size_t)row * 4096) + 512 * j + 8 * lane)); }
                } else {
#pragma unroll
                    for (int j = 0; j < 2; ++j)
#pragma unroll
                        for (int q = 0; q < 2; ++q) { const f32x4 v = {x[8 * j + 4 * q], x[8 * j + 4 * q + 1], x[8 * j + 4 * q + 2], x[8 * j + 4 * q + 3]};
                            __builtin_nontemporal_store(v, (f32x4*)(ra.xout + (size_t)row * DM + 512 * j + 8 * lane + 4 * q)); }
                }
            }
            if (HAS_H) {
                float ss = 0.f;
#pragma unroll
                for (int e = 0; e < 16; ++e) ss += x[e] * x[e];
                const float rs = rsqrtf(wave_sum(ss) * (1.0f / DM) + EPS);
#pragma unroll
                for (int j = 0; j < 2; ++j) { u32x4 w; float h[8];
#pragma unroll
                    for (int e = 0; e < 8; ++e) h[e] = x[8 * j + e] * rs * B[8 * j + e] + S[8 * j + e];
                    w.x = pk2(h[0], h[1]); w.y = pk2(h[2], h[3]); w.z = pk2(h[4], h[5]); w.w = pk2(h[6], h[7]);
                    *(u32x4*)(ra.hout + (size_t)row * ra.h_ld + 512 * j + 8 * lane) = w; }
            }
        }
    }
}

__device__ __forceinline__ void mid_phase(unsigned char* ws, int l, LAS unsigned char* lds, const int wv) {
    int tid = wv * 64 + (int)__builtin_amdgcn_mbcnt_hi(~0u, __builtin_amdgcn_mbcnt_lo(~0u, 0u)); asm volatile("" : "+v"(tid)); const int lane = tid & 63, wid = wv;
    bf16_t* z = (bf16_t*)(ws + WS_Z); bf16_t* kr = (bf16_t*)(ws + WS_H) + (size_t)T * 768;
    float* rstdq = (float*)(ws + WS_SSQ); float* rstdkv = rstdq + T;
    const float* rope = (const float*)(ws + WS_ROPE);
    const bf16_t* Wsb = (const bf16_t*)(ws + WS_W + l * WL + OW_S);
    const float* g_sgu = INP(15) + l * 512; const float* b_sp = INP(17) + l * 1024;
    LAS bf16_t* vn = (LAS bf16_t*)lds;
    LAS float* part = (LAS float*)(lds + 131072);
    LAS float* rstd_s = part + 1024;
    const int r32 = lane & 31, hi = lane >> 5;
    for (int ch = blockIdx.x; ch < T / 128; ch += gridDim.x) {
        const int R0 = ch * 128;
        float gs[8];
#pragma unroll
        for (int e = 0; e < 8; ++e) gs[e] = g_sgu[8 * lane + e];
        { const int rrow = R0 + wid * 16 + (lane >> 2), L = lane & 3;
          const u32x4 wr_ = *(const u32x4*)(z + (size_t)rrow * LZ + ZKR + 8 * L);
          const f32x4* tp = (const f32x4*)(rope + ((size_t)tok_pos(rrow) * 16 + 8 * (L & 1)) * 2);
          const f32x4 t0 = tp[0], t1 = tp[1], t2 = tp[2], t3 = tp[3];
          const float cs[8] = {t0[0], t0[2], t1[0], t1[2], t2[0], t2[2], t3[0], t3[2]}, sn[8] = {t0[1], t0[3], t1[1], t1[3], t2[1], t2[3], t3[1], t3[3]};
          float mine[8] = {bf_lo(wr_.x), bf_hi(wr_.x), bf_lo(wr_.y), bf_hi(wr_.y), bf_lo(wr_.z), bf_hi(wr_.z), bf_lo(wr_.w), bf_hi(wr_.w)}; float o[8];
#pragma unroll
          for (int e = 0; e < 8; ++e) { const float oth = __shfl_xor(mine[e], 2); o[e] = L < 2 ? (mine[e] * cs[e] - oth * sn[e]) : (oth * sn[e] + mine[e] * cs[e]); }
          u32x4 w; w.x = pk2(o[0], o[1]); w.y = pk2(o[2], o[3]); w.z = pk2(o[4], o[5]); w.w = pk2(o[6], o[7]);
          *(u32x4*)(kr + (size_t)rrow * 32 + 8 * L) = w; }
#pragma unroll 1
        for (int i0 = 0; i0 < 16; i0 += 4) {
            u32x4 wqa[4], wkva[4], wva[4];
#pragma unroll
            for (int k = 0; k < 4; ++k) { const bf16_t* zr = z + (size_t)(R0 + wid * 16 + i0 + k) * LZ;
                wqa[k] = (u32x4){0u, 0u, 0u, 0u}; wkva[k] = (u32x4){0u, 0u, 0u, 0u};
                if (lane < 48) wqa[k] = *(const u32x4*)(zr + ZQ + 8 * lane);
                if (lane < 32) wkva[k] = *(const u32x4*)(zr + ZKV + 8 * lane);
                wva[k] = *(const u32x4*)(zr + ZV + 8 * lane); }
#pragma unroll
            for (int k = 0; k < 4; ++k) {
                const int lr = wid * 16 + i0 + k, row = R0 + lr; const u32x4 wq = wqa[k], wkv = wkva[k], wv = wva[k];
                float sq = 0.f, skv = 0.f;
                { const float f0 = bf_lo(wq.x), f1 = bf_hi(wq.x), f2 = bf_lo(wq.y), f3 = bf_hi(wq.y), f4 = bf_lo(wq.z), f5 = bf_hi(wq.z), f6 = bf_lo(wq.w), f7 = bf_hi(wq.w);
                  sq = (f0 * f0 + f1 * f1) + (f2 * f2 + f3 * f3) + (f4 * f4 + f5 * f5) + (f6 * f6 + f7 * f7); }
                { const float f0 = bf_lo(wkv.x), f1 = bf_hi(wkv.x), f2 = bf_lo(wkv.y), f3 = bf_hi(wkv.y), f4 = bf_lo(wkv.z), f5 = bf_hi(wkv.z), f6 = bf_lo(wkv.w), f7 = bf_hi(wkv.w);
                  skv = (f0 * f0 + f1 * f1) + (f2 * f2 + f3 * f3) + (f4 * f4 + f5 * f5) + (f6 * f6 + f7 * f7); }
                float gv[8];
                gv[0] = gelu_tanh(bf_lo(wv.x)); gv[1] = gelu_tanh(bf_hi(wv.x)); gv[2] = gelu_tanh(bf_lo(wv.y)); gv[3] = gelu_tanh(bf_hi(wv.y));
                gv[4] = gelu_tanh(bf_lo(wv.z)); gv[5] = gelu_tanh(bf_hi(wv.z)); gv[6] = gelu_tanh(bf_lo(wv.w)); gv[7] = gelu_tanh(bf_hi(wv.w));
                float sv = 0.f;
#pragma unroll
                for (int e = 0; e < 8; ++e) sv += gv[e] * gv[e];
                sq = wave_sum(sq); skv = wave_sum(skv); sv = wave_sum(sv);
                if (lane == 0) { rstdq[row] = rsqrtf(sq * (1.0f / 384.0f) + EPS); rstdkv[row] = rsqrtf(skv * (1.0f / 256.0f) + EPS); }
                const float rv = rsqrtf(sv * (1.0f / 512.0f) + EPS);
                { u32x4 o; o.x = pk2(gv[0] * rv * gs[0], gv[1] * rv * gs[1]); o.y = pk2(gv[2] * rv * gs[2], gv[3] * rv * gs[3]);
                  o.z = pk2(gv[4] * rv * gs[4], gv[5] * rv * gs[5]); o.w = pk2(gv[6] * rv * gs[6], gv[7] * rv * gs[7]);
                  *(LAS u32x4*)(vn + lr * 512 + 8 * lane) = o; }
            }
        }
        __syncthreads();
        const int g = wid;
        f32x16 acc[2][4];
#pragma unroll
        for (int ct = 0; ct < 2; ++ct)
#pragma unroll
            for (int tt = 0; tt < 4; ++tt)
#pragma unroll
                for (int r = 0; r < 16; ++r) acc[ct][tt][r] = 0.f;
#pragma unroll 1
        for (int ks = 0; ks < 8; ++ks) {
            bf16x8 af[2], bfr[4];
#pragma unroll
            for (int ct = 0; ct < 2; ++ct)
#pragma unroll
                for (int e = 0; e < 8; ++e) af[ct][e] = (short)vn[(16 * ks + 8 * hi + e) * 512 + 64 * g + 32 * ct + r32];
#pragma unroll
            for (int tt = 0; tt < 4; ++tt) bfr[tt] = *(const bf16x8*)(Wsb + ((size_t)(g * 128 + 32 * tt + r32) * 128 + 16 * ks + 8 * hi));
#pragma unroll
            for (int ct = 0; ct < 2; ++ct)
#pragma unroll
                for (int tt = 0; tt < 4; ++tt) acc[ct][tt] = __builtin_amdgcn_mfma_f32_32x32x16_bf16(af[ct], bfr[tt], acc[ct][tt], 0, 0, 0);
        }
#pragma unroll
        for (int tt = 0; tt < 4; ++tt) { const int t = 32 * tt + r32; const float bias = b_sp[g * 128 + t]; const bf16_t* zu = z + (size_t)(R0 + t) * LZ + ZU + 64 * g; float s = 0.f;
#pragma unroll
            for (int ct = 0; ct < 2; ++ct)
#pragma unroll
                for (int rq = 0; rq < 4; ++rq) { const u32x2 w = *(const u32x2*)(zu + 32 * ct + 8 * rq + 4 * hi);
                    const float u0 = gelu_tanh(bf_lo(w.x)), u1 = gelu_tanh(bf_hi(w.x)), u2 = gelu_tanh(bf_lo(w.y)), u3 = gelu_tanh(bf_hi(w.y));
                    float v0 = u0 * (acc[ct][tt][4 * rq] + bias), v1 = u1 * (acc[ct][tt][4 * rq + 1] + bias), v2 = u2 * (acc[ct][tt][4 * rq + 2] + bias), v3 = u3 * (acc[ct][tt][4 * rq + 3] + bias);
                    acc[ct][tt][4 * rq] = v0; acc[ct][tt][4 * rq + 1] = v1; acc[ct][tt][4 * rq + 2] = v2; acc[ct][tt][4 * rq + 3] = v3;
                    s += (v0 * v0 + v1 * v1) + (v2 * v2 + v3 * v3); }
            s += __shfl_xor(s, 32);
            if (hi == 0) part[g * 128 + t] = s; }
        __syncthreads();
        if (tid < 128) { float s = 0.f;
#pragma unroll
            for (int w = 0; w < 8; ++w) s += part[w * 128 + tid];
            rstd_s[tid] = rsqrtf(s * (1.0f / 512.0f) + EPS); }
        __syncthreads();
#pragma unroll
        for (int tt = 0; tt < 4; ++tt) { const int t = 32 * tt + r32; const float rs = rstd_s[t]; bf16_t* zu = z + (size_t)(R0 + t) * LZ + ZU + 64 * g;
#pragma unroll
            for (int ct = 0; ct < 2; ++ct)
#pragma unroll
                for (int rq = 0; rq < 4; ++rq) { u32x2 w; w.x = pk2(acc[ct][tt][4 * rq] * rs, acc[ct][tt][4 * rq + 1] * rs); w.y = pk2(acc[ct][tt][4 * rq + 2] * rs, acc[ct][tt][4 * rq + 3] * rs);
                    *(u32x2*)(zu + 32 * ct + 8 * rq + 4 * hi) = w; } }
        __syncthreads();
    }
}

constexpr int KROW = 208, VROW = 144, KTILE_B = 64 * KROW, VTILE_B = 64 * VROW;
__device__ __forceinline__ void attn_phase(unsigned char* ws, LAS unsigned char* lds, const int wv) {
    int tid = wv * 64 + (int)__builtin_amdgcn_mbcnt_hi(~0u, __builtin_amdgcn_mbcnt_lo(~0u, 0u)); asm volatile("" : "+v"(tid)); const int lane = tid & 63, wid = wv;
    const bf16_t* Q = (const bf16_t*)(ws + WS_H); const bf16_t* kr = Q + (size_t)T * 768;
    bf16_t* z = (bf16_t*)(ws + WS_Z); const bf16_t* kn = z + ZV; const bf16_t* Vt = (const bf16_t*)(ws + WS_VT);
    float* ssq = (float*)(ws + WS_SSQ);
    const int r32 = lane & 31, hi = lane >> 5, G = gridDim.x;
    if (wid >= 4) __builtin_amdgcn_s_setprio(1);
    LAS unsigned char* Kl = lds; LAS unsigned char* Vl = lds + 2 * KTILE_B;
    const int kc0 = tid, kc1 = tid + 512;
    const int kr0 = kc0 / 12, kp0 = kc0 % 12, kr1 = kc1 / 12, kp1 = kc1 % 12;
    const int vd = tid >> 3, vch = tid & 7;
    for (int it = 0;; ++it) {
        const int flat = it * G + blockIdx.x; if (flat >= 1024) break;
        int seq, head, qb, s0, len;
        { const int v = flat < 512 ? flat : flat - 512; const int x = v & 7, y = v >> 3;
          if (flat < 512) { qb = y & 31; const int pair = x + 8 * (y >> 5); seq = pair >> 3; head = pair & 7; s0 = seq * 8192; len = 8192; }
          else { qb = y & 7; const int pair = x + 8 * (y >> 3); seq = pair >> 3; head = pair & 7; s0 = TP + seq * 2048; len = 2048; } }
        const int NTL = len / 64;
        const int qrow = s0 + qb * 256 + wid * 32 + r32;
        bf16x8 qf[6];
#pragma unroll
        for (int d0 = 0; d0 < 6; ++d0) qf[d0] = *(const bf16x8*)(Q + (size_t)qrow * 768 + head * 96 + d0 * 16 + hi * 8);
        const unsigned ko0 = kp0 < 8 ? (unsigned)(WS_Z + ((size_t)(s0 + kr0) * LZ + ZV + head * 64 + kp0 * 8) * 2) : (unsigned)(WS_H + ((size_t)T * 768 + (size_t)(s0 + kr0) * 32 + (kp0 - 8) * 8) * 2);
        const unsigned kst0 = kp0 < 8 ? 64u * LZ * 2u : 64u * 32u * 2u;
        const unsigned ko1 = kp1 < 8 ? (unsigned)(WS_Z + ((size_t)(s0 + kr1) * LZ + ZV + head * 64 + kp1 * 8) * 2) : (unsigned)(WS_H + ((size_t)T * 768 + (size_t)(s0 + kr1) * 32 + (kp1 - 8) * 8) * 2);
        const unsigned kst1 = kp1 < 8 ? 64u * LZ * 2u : 64u * 32u * 2u;
        const unsigned vo = (unsigned)(WS_VT + ((size_t)(head * 64 + vd) * T + s0 + vch * 8) * 2);
#define KLD0(t) (*(const u32x4*)(ws + (ko0 + (unsigned)(t) * kst0)))
#define KLD1(t) (*(const u32x4*)(ws + (ko1 + (unsigned)(t) * kst1)))
#define VLD(t) (*(const u32x4*)(ws + (vo + (unsigned)(t) * 128u)))
        const int kd0 = kr0 * KROW + kp0 * 16, kd1 = kr1 * KROW + kp1 * 16, vdst = vd * VROW + vch * 16;
        u32x4 rk0, rk1 = {0u, 0u, 0u, 0u}, rv;
        rk0 = KLD0(0); if (tid < 256) rk1 = KLD1(0); rv = VLD(0);
        *(LAS u32x4*)(Kl + kd0) = rk0; if (tid < 256) *(LAS u32x4*)(Kl + kd1) = rk1; *(LAS u32x4*)(Vl + vdst) = rv;
        rk0 = KLD0(1); if (tid < 256) rk1 = KLD1(1);
        *(LAS u32x4*)(Kl + KTILE_B + kd0) = rk0; if (tid < 256) *(LAS u32x4*)(Kl + KTILE_B + kd1) = rk1;
        rk0 = KLD0(2); if (tid < 256) rk1 = KLD1(2); rv = VLD(1);
        __syncthreads();
        f32x16 o0, o1, negm, sc0, sc1; bf16x8 kf[12];
#pragma unroll
        for (int r = 0; r < 16; ++r) { o0[r] = 0.f; o1[r] = 0.f; negm[r] = 0.f; }
        float lsum = 0.f;
        { const LAS unsigned char* Kb = Kl + r32 * KROW + hi * 16;
#pragma unroll
          for (int d0 = 0; d0 < 6; ++d0) { kf[2 * d0] = *(const LAS bf16x8*)(Kb + d0 * 32); kf[2 * d0 + 1] = *(const LAS bf16x8*)(Kb + 32 * KROW + d0 * 32); }
#pragma unroll
          for (int d0 = 0; d0 < 6; ++d0) {
              sc0 = __builtin_amdgcn_mfma_f32_32x32x16_bf16(kf[2 * d0], qf[d0], d0 == 0 ? negm : sc0, 0, 0, 0);
              sc1 = __builtin_amdgcn_mfma_f32_32x32x16_bf16(kf[2 * d0 + 1], qf[d0], d0 == 0 ? negm : sc1, 0, 0, 0); }
          float rm = fmaxf(fmaxf(sc0[0], sc0[1]), sc1[0]);
#pragma unroll
          for (int r = 2; r < 16; r += 2) rm = fmaxf(fmaxf(rm, sc0[r]), sc0[r + 1]);
#pragma unroll
          for (int r = 1; r < 15; r += 2) rm = fmaxf(fmaxf(rm, sc1[r]), sc1[r + 1]);
          rm = fmaxf(rm, sc1[15]);
          rm = fmaxf(rm, __shfl_xor(rm, 32));
#pragma unroll
          for (int r = 0; r < 16; ++r) { sc0[r] -= rm; sc1[r] -= rm; negm[r] = -rm; }
          const LAS unsigned char* Kb1 = Kb + KTILE_B;
#pragma unroll
          for (int d0 = 0; d0 < 6; ++d0) { kf[2 * d0] = *(const LAS bf16x8*)(Kb1 + d0 * 32); kf[2 * d0 + 1] = *(const LAS bf16x8*)(Kb1 + 32 * KROW + d0 * 32); } }
        __syncthreads();
        int vb3 = 0;
#pragma unroll 2
        for (int kt = 0; kt < NTL; ++kt) {
            const int buf = kt & 1; const int vb3n = vb3 == 2 ? 0 : vb3 + 1;
            const int t3 = kt + 3 < NTL ? kt + 3 : NTL - 1, t2 = kt + 2 < NTL ? kt + 2 : NTL - 1;
            *(LAS u32x4*)(Kl + buf * KTILE_B + kd0) = rk0; if (tid < 256) *(LAS u32x4*)(Kl + buf * KTILE_B + kd1) = rk1;
            *(LAS u32x4*)(Vl + vb3n * VTILE_B + vdst) = rv;
            rk0 = KLD0(t3); if (tid < 256) rk1 = KLD1(t3);
            rv = VLD(t2);
            f32x16 sn0, sn1;
#pragma unroll
            for (int d0 = 0; d0 < 6; ++d0) {
                sn0 = __builtin_amdgcn_mfma_f32_32x32x16_bf16(kf[2 * d0], qf[d0], d0 == 0 ? negm : sn0, 0, 0, 0);
                sn1 = __builtin_amdgcn_mfma_f32_32x32x16_bf16(kf[2 * d0 + 1], qf[d0], d0 == 0 ? negm : sn1, 0, 0, 0); }
#pragma unroll
            for (int r = 0; r < 16; ++r) { sc0[r] = __builtin_amdgcn_exp2f(sc0[r]); sc1[r] = __builtin_amdgcn_exp2f(sc1[r]); }
#pragma unroll
            for (int r = 0; r < 16; ++r) { lsum += sc0[r]; asm volatile("" : "+v"(lsum)); lsum += sc1[r]; asm volatile("" : "+v"(lsum)); }
            float lchk = lsum;
            { auto rr = __builtin_amdgcn_permlane32_swap(__float_as_uint(lchk), __float_as_uint(lchk), false, false); lchk = fmaxf(__uint_as_float(rr[0]), __uint_as_float(rr[1])); }
            u32x4 pw[4];
            pw[0] = (u32x4){pk2(sc0[0], sc0[1]), pk2(sc0[2], sc0[3]), pk2(sc0[4], sc0[5]), pk2(sc0[6], sc0[7])};
            pw[1] = (u32x4){pk2(sc0[8], sc0[9]), pk2(sc0[10], sc0[11]), pk2(sc0[12], sc0[13]), pk2(sc0[14], sc0[15])};
            pw[2] = (u32x4){pk2(sc1[0], sc1[1]), pk2(sc1[2], sc1[3]), pk2(sc1[4], sc1[5]), pk2(sc1[6], sc1[7])};
            pw[3] = (u32x4){pk2(sc1[8], sc1[9]), pk2(sc1[10], sc1[11]), pk2(sc1[12], sc1[13]), pk2(sc1[14], sc1[15])};
            asm volatile("s_waitcnt lgkmcnt(0)" ::: "memory"); __builtin_amdgcn_s_barrier(); asm volatile("" ::: "memory");
            { const LAS unsigned char* Kb = Kl + buf * KTILE_B + r32 * KROW + hi * 16;
#pragma unroll
              for (int d0 = 0; d0 < 6; ++d0) { kf[2 * d0] = *(const LAS bf16x8*)(Kb + d0 * 32); kf[2 * d0 + 1] = *(const LAS bf16x8*)(Kb + 32 * KROW + d0 * 32); } }
            { const LAS unsigned char* Vb = Vl + vb3 * VTILE_B + r32 * VROW + hi * 16;
#pragma unroll
              for (int h2 = 0; h2 < 2; ++h2) { bf16x8 vf[4];
#pragma unroll
                  for (int s = 0; s < 2; ++s) { vf[2 * s] = *(const LAS bf16x8*)(Vb + (2 * h2 + s) * 32); vf[2 * s + 1] = *(const LAS bf16x8*)(Vb + 32 * VROW + (2 * h2 + s) * 32); }
#pragma unroll
                  for (int s = 0; s < 2; ++s) {
                      const bf16x8 pb = __builtin_bit_cast(bf16x8, pw[2 * h2 + s]);
                      o0 = __builtin_amdgcn_mfma_f32_32x32x16_bf16(vf[2 * s], pb, o0, 0, 0, 0);
                      o1 = __builtin_amdgcn_mfma_f32_32x32x16_bf16(vf[2 * s + 1], pb, o1, 0, 0, 0); } } }
            if (__any(lchk > 1.0e12f)) {
                const float dl = fmaxf(floorf(__builtin_amdgcn_logf(lchk)), 0.f); const float f = __builtin_amdgcn_exp2f(-dl);
                lsum *= f; const float nm = negm[0] - dl;
#pragma unroll
                for (int r = 0; r < 16; ++r) { sn0[r] -= dl; sn1[r] -= dl; o0[r] *= f; o1[r] *= f; negm[r] = nm; }
            }
            sc0 = sn0; sc1 = sn1; vb3 = vb3n;
        }
        __syncthreads();
        lsum += __shfl_xor(lsum, 32);
        const float inv = 1.0f / lsum;
        bf16_t* orow = z + (size_t)qrow * LZ + ZATT + head * 64;
        float sq = 0.f;
#pragma unroll
        for (int rq = 0; rq < 4; ++rq) {
            const float a0 = o0[4 * rq] * inv, a1 = o0[4 * rq + 1] * inv, a2 = o0[4 * rq + 2] * inv, a3 = o0[4 * rq + 3] * inv;
            const float b0 = o1[4 * rq] * inv, b1 = o1[4 * rq + 1] * inv, b2 = o1[4 * rq + 2] * inv, b3 = o1[4 * rq + 3] * inv;
            sq += (a0 * a0 + a1 * a1) + (a2 * a2 + a3 * a3) + (b0 * b0 + b1 * b1) + (b2 * b2 + b3 * b3);
            u32x2 w0, w1; w0.x = pk2(a0, a1); w0.y = pk2(a2, a3); w1.x = pk2(b0, b1); w1.y = pk2(b2, b3);
            *(u32x2*)(orow + 8 * rq + 4 * hi) = w0; *(u32x2*)(orow + 32 + 8 * rq + 4 * hi) = w1;
        }
        sq += __shfl_xor(sq, 32);
        if (hi == 0) ssq[(size_t)qrow * 8 + head] = sq;
    }
    __builtin_amdgcn_s_setprio(0);
}

#define XB_TMO      128
#define XB_XCNT(j)  (256  + 64 * (j))
#define XB_XSUB(j)  (1280 + 64 * (j))
#define XB_XGEN(j)  (2304 + 64 * (j))
#define XB_TOP      3328
#define XB_TOPGEN   3392
#define XCD_BAR_WORDS 3456
#define XB_SPIN_CAP (1u << 18)

__device__ __forceinline__ unsigned xb_ld(unsigned* p)              { return __hip_atomic_load(p, __ATOMIC_RELAXED, __HIP_MEMORY_SCOPE_AGENT); }
__device__ __forceinline__ unsigned xb_add(unsigned* p, unsigned v) { return __hip_atomic_fetch_add(p, v, __ATOMIC_RELAXED, __HIP_MEMORY_SCOPE_AGENT); }
__device__ __forceinline__ unsigned xb_xcc_id() { return (unsigned)__builtin_amdgcn_s_getreg((3 << 11) | 20) & 0xFu; }
#define XB_SPIN(cond, bar) do { unsigned _sp = 0; while (cond) { __builtin_amdgcn_s_sleep(1); \
    if ((++_sp & 255u) == 0u) { if (xb_ld(&(bar)[XB_TMO])) break; if (_sp > XB_SPIN_CAP) { atomicAdd(&(bar)[XB_TMO], 1u); break; } } } } while (0)

struct XcdBarrier {
    unsigned* bar; unsigned x;
    volatile LAS unsigned* st;
};

__device__ __forceinline__ XcdBarrier xcd_barrier_post(unsigned* bar, volatile LAS unsigned* st, const bool t0  ) {
    XcdBarrier b; b.bar = bar; b.x = xb_xcc_id(); b.st = st;
    if (t0) (void)xb_add(&bar[XB_XCNT(b.x)], 1u);
    return b;
}
__device__ __forceinline__ void xcd_barrier_complete(unsigned* bar, unsigned x, unsigned& nloc, unsigned& nx) {
    const unsigned G = gridDim.x * gridDim.y * gridDim.z;
    unsigned sum, cnt, mine, sp = 0u;
    for (;;) {
        sum = 0u; cnt = 0u; mine = 0u;
#pragma unroll
        for (unsigned j = 0; j < 16; ++j) { const unsigned c = xb_ld(&bar[XB_XCNT(j)]); sum += c; cnt += (c > 0u) ? 1u : 0u; mine = (j == x) ? c : mine; }
        if (sum == G) break;
        __builtin_amdgcn_s_sleep(1);
        if ((++sp & 255u) == 0u) { if (xb_ld(&bar[XB_TMO])) break; if (sp > XB_SPIN_CAP) { atomicAdd(&bar[XB_TMO], 1u); break; } }
    }
    nloc = mine > 0u ? mine : 1u; nx = cnt > 0u ? cnt : 1u;
}

__device__ __forceinline__ void xcd_barrier(const XcdBarrier& b, const int wv) {
    asm volatile("s_waitcnt vmcnt(0)" ::: "memory");
    __syncthreads();
    if (wv == 0 && (int)__builtin_amdgcn_mbcnt_hi(~0u, __builtin_amdgcn_mbcnt_lo(~0u, 0u)) == 0) {
        unsigned* bar = b.bar; unsigned bx = b.x; asm volatile("" : "+s"(bx));
        __builtin_amdgcn_s_waitcnt(0);
        unsigned nloc = b.st[0], nx = b.st[1];
        if (nloc == 0u) { xcd_barrier_complete(bar, bx, nloc, nx); b.st[0] = nloc; b.st[1] = nx; }
        const unsigned old = xb_add(&bar[XB_XSUB(bx)], 1u);
        const unsigned gen = old / nloc;
        if (old + 1u == (gen + 1u) * nloc) {
            __builtin_amdgcn_fence(__ATOMIC_RELEASE, "agent");
            asm volatile("s_waitcnt vmcnt(0)" ::: "memory");
            const unsigned og = xb_add(&bar[XB_TOP], 1u);
            const unsigned tg = og / nx;
            if (og + 1u == (tg + 1u) * nx) xb_add(&bar[XB_TOPGEN], 1u);
            else XB_SPIN(xb_ld(&bar[XB_TOPGEN]) == tg, bar);
            __builtin_amdgcn_fence(__ATOMIC_ACQUIRE, "agent");
            xb_add(&bar[XB_XGEN(bx)], 1u);
            asm volatile("s_waitcnt vmcnt(0)" ::: "memory");
        } else {
            XB_SPIN(xb_ld(&bar[XB_XGEN(bx)]) == gen, bar);
            __builtin_amdgcn_fence(__ATOMIC_ACQUIRE, "agent");
            asm volatile("s_waitcnt vmcnt(0)" ::: "memory");
        }
    }
    __syncthreads();
}

__global__ void __launch_bounds__(512, 2) fwd_kernel(Args a) {
    __shared__ __attribute__((aligned(16))) unsigned char lds_raw[LDS_BYTES];
    cg::grid_group grid = cg::this_grid();
    LAS unsigned char* lds = (LAS unsigned char*)lds_raw;
    const int wv = __builtin_amdgcn_readfirstlane((int)threadIdx.x >> 6);
    const bool t0 = wv == 0 && (int)__builtin_amdgcn_mbcnt_hi(~0u, __builtin_amdgcn_mbcnt_lo(~0u, 0u)) == 0;
    unsigned char* ws = a.ws;

    if (t0) { LAS long long* tab = (LAS long long*)(lds + TAB_OFF); ((LAS unsigned*)(lds + TAB_OFF + 224))[0] = 0u; ((LAS unsigned*)(lds + TAB_OFF + 224))[1] = 0u;
        tab[0] = (long long)((const unsigned char*)a.in[0] - (const unsigned char*)a.ws);
        tab[1] = (long long)((const unsigned char*)a.in[1] - (const unsigned char*)a.ws);
        tab[2] = (long long)((const unsigned char*)a.in[2] - (const unsigned char*)a.ws);
        tab[3] = (long long)((const unsigned char*)a.in[3] - (const unsigned char*)a.ws);
        tab[4] = (long long)((const unsigned char*)a.in[4] - (const unsigned char*)a.ws);
        tab[5] = (long long)((const unsigned char*)a.in[5] - (const unsigned char*)a.ws);
        tab[6] = (long long)((const unsigned char*)a.in[6] - (const unsigned char*)a.ws);
        tab[7] = (long long)((const unsigned char*)a.in[7] - (const unsigned char*)a.ws);
        tab[8] = (long long)((const unsigned char*)a.in[8] - (const unsigned char*)a.ws);
        tab[9] = (long long)((const unsigned char*)a.in[9] - (const unsigned char*)a.ws);
        tab[10] = (long long)((const unsigned char*)a.in[10] - (const unsigned char*)a.ws);
        tab[11] = (long long)((const unsigned char*)a.in[11] - (const unsigned char*)a.ws);
        tab[12] = (long long)((const unsigned char*)a.in[12] - (const unsigned char*)a.ws);
        tab[13] = (long long)((const unsigned char*)a.in[13] - (const unsigned char*)a.ws);
        tab[14] = (long long)((const unsigned char*)a.in[14] - (const unsigned char*)a.ws);
        tab[15] = (long long)((const unsigned char*)a.in[15] - (const unsigned char*)a.ws);
        tab[16] = (long long)((const unsigned char*)a.in[16] - (const unsigned char*)a.ws);
        tab[17] = (long long)((const unsigned char*)a.in[17] - (const unsigned char*)a.ws);
        tab[18] = (long long)((const unsigned char*)a.in[18] - (const unsigned char*)a.ws);
        tab[19] = (long long)((const unsigned char*)a.in[19] - (const unsigned char*)a.ws);
        tab[20] = (long long)((const unsigned char*)a.in[20] - (const unsigned char*)a.ws);
        tab[21] = (long long)((const unsigned char*)a.in[21] - (const unsigned char*)a.ws);
        tab[22] = (long long)((const unsigned char*)a.in[22] - (const unsigned char*)a.ws);
        tab[23] = (long long)((const unsigned char*)a.in[23] - (const unsigned char*)a.ws);
    }
    __syncthreads();
    const XcdBarrier bar = xcd_barrier_post((unsigned*)ws, (volatile LAS unsigned*)(lds + TAB_OFF + 224), t0);
    float* const xout = a.out;
#define WSL(w) size_t w##_z = 0; asm volatile("" : "+s"(w##_z)); unsigned char* w = ws + w##_z
#define HB(w) ((bf16_t*)((w) + WS_H))
#define ZB(w) ((bf16_t*)((w) + WS_Z))
#define MODP(w) ((const float*)((w) + WS_MOD))
    p0_phase(ws, lds, wv);
    grid.sync();
    { WSL(w); RowArgs ra{nullptr, INP(0), INP(1), nullptr, nullptr, nullptr, INP(6), MODP(w) + 1024, MODP(w), HB(w), nullptr, 0, DM}; row_phase<false, true, false, true>(ra, wv); }
    xcd_barrier(bar, wv);
#pragma unroll 1
    for (int l = 0; l < NLAYER; ++l) {
        { WSL(w); int Gl = gridDim.x, bl = blockIdx.x; asm volatile("" : "+s"(Gl), "+s"(bl));
          pg8::Gemm g{HB(w), (const bf16_t*)(w + WS_W + (size_t)l * WL + OW_IN), T, NIN, 1024, 1024}; pg8::StaticOrder S; S.init(T, NIN, Gl, bl);
          pg8::EpiStore<false> E{ZB(w), LZ, LZ, nullptr}; pg8::gemm_phase<pg8::EpiStore<false>, pg8::StaticOrder, true, true>(lds, g, S, E, wv); }
        xcd_barrier(bar, wv);
        { WSL(w); mid_phase(w, l, lds, wv); }
        xcd_barrier(bar, wv);
        { WSL(w); int Gl = gridDim.x, bl = blockIdx.x; asm volatile("" : "+s"(Gl), "+s"(bl));
          pg8::Gemm g{ZB(w) + ZQ, (const bf16_t*)(w + WS_W + (size_t)l * WL + OW_QB), T, 768, 384, LZ}; pg8::StaticOrder S; S.init(T, 768, Gl, bl);
          pg8::EpiQ E{HB(w), (const float*)(w + WS_ROPE), (const float*)(w + WS_SSQ)}; pg8::gemm_phase<pg8::EpiQ, pg8::StaticOrder, true, true>(lds, g, S, E, wv); }
        { WSL(w); int Gl = gridDim.x, bl = blockIdx.x; asm volatile("" : "+s"(Gl), "+s"(bl));
          pg8::Gemm g{ZB(w) + ZKV, (const bf16_t*)(w + WS_W + (size_t)l * WL + OW_KVB), T, 1024, 256, LZ}; pg8::StaticOrder S; S.init(T, 1024, Gl, bl);
          pg8::EpiKV E{ZB(w) + ZV, (bf16_t*)(w + WS_VT), (const float*)(w + WS_SSQ) + T}; pg8::gemm_phase<pg8::EpiKV, pg8::StaticOrder, true, true>(lds, g, S, E, wv); }
        xcd_barrier(bar, wv);
        { WSL(w); attn_phase(w, lds, wv); }
        xcd_barrier(bar, wv);
        { WSL(w); int Gl = gridDim.x, bl = blockIdx.x; asm volatile("" : "+s"(Gl), "+s"(bl));
          pg8::Gemm g{ZB(w) + ZATT, (const bf16_t*)(w + WS_W + (size_t)l * WL + OW_OUT), T, 1024, 1024, LZ}; pg8::StaticOrder S; S.init(T, 1024, Gl, bl);
          pg8::EpiStore<true> E{HB(w), DM, DM, (const float*)(w + WS_SSQ)}; pg8::gemm_phase<pg8::EpiStore<true>, pg8::StaticOrder, true, true>(lds, g, S, E, wv); }
        xcd_barrier(bar, wv);
        { WSL(w); const float* modl = MODP(w) + (size_t)l * NCR * NMODC;
          RowArgs ra{HB(w), INP(0), INP(1), nullptr, INP(7) + l * DM, modl + 2048, INP(8) + l * DM, modl + 4096, modl + 3072, EB(xout), (unsigned char*)xout, DM, 2048};
          if (l == 0) row_phase<true, true, false, true>(ra, wv); else row_phase<true, true, true, true>(ra, wv); }
        xcd_barrier(bar, wv);
        { WSL(w); int Gl = gridDim.x, bl = blockIdx.x; asm volatile("" : "+s"(Gl), "+s"(bl));
          pg8::Gemm g{EB(xout), (const bf16_t*)(w + WS_W + (size_t)l * WL + OW_GU), T, NGU, 1024, 2048}; pg8::StaticOrder S; S.init(T, NGU, Gl, bl);
          pg8::EpiGU E{HB(w)}; pg8::gemm_phase<pg8::EpiGU, pg8::StaticOrder, true, true>(lds, g, S, E, wv); }
        xcd_barrier(bar, wv);
        { WSL(w); int Gl = gridDim.x, bl = blockIdx.x; asm volatile("" : "+s"(Gl), "+s"(bl));
          pg8::Gemm g{HB(w), (const bf16_t*)(w + WS_W + (size_t)l * WL + OW_D), T, 1024, DFF, DFF}; pg8::StaticOrder S; S.init(T, 1024, Gl, bl);
          pg8::EpiStore<false> E{EB(xout), 2048, DM, nullptr}; pg8::gemm_phase<pg8::EpiStore<false>, pg8::StaticOrder, true, true>(lds, g, S, E, wv); }
        xcd_barrier(bar, wv);
        if (l + 1 < NLAYER) {
            WSL(w); const float* modl = MODP(w) + (size_t)l * NCR * NMODC; const float* modn = modl + NCR * NMODC;
            RowArgs ra{EB(xout), nullptr, nullptr, nullptr, INP(9) + l * DM, modl + 5120, INP(6) + (l + 1) * DM, modn + 1024, modn, HB(w), (unsigned char*)xout, 2048, DM};
            row_phase<true, true, true, true>(ra, wv);
            xcd_barrier(bar, wv);
        } else {
            WSL(w); const float* modl = MODP(w) + (size_t)l * NCR * NMODC;
            RowArgs ra{EB(xout), nullptr, nullptr, xout, INP(9) + l * DM, modl + 5120, nullptr, nullptr, nullptr, nullptr, (unsigned char*)xout, 2048, 0};
            row_phase<true, false, true, false>(ra, wv);
        }
    }
}

extern "C" void kernel_launch(void* const* d_in, const int* in_sizes, int n_in, void* d_out, int out_size, void* d_ws, size_t ws_size, hipStream_t stream) {
    static int grid = 0;
    if (grid == 0) {
        if (n_in != 24 || out_size != T * DM || ws_size < WS_END) { fprintf(stderr, "kernel_launch: unexpected problem (n_in %d out %d ws %zu)\n", n_in, out_size, ws_size); grid = -1; return; }
        int dev = 0, cus = 0, per_cu = 0;
        hipGetDevice(&dev); hipDeviceGetAttribute(&cus, hipDeviceAttributeMultiprocessorCount, dev);
        hipOccupancyMaxActiveBlocksPerMultiprocessor(&per_cu, (const void*)fwd_kernel, 512, 0);
        if (per_cu < 1) per_cu = 1;
        grid = cus * per_cu;
        fprintf(stderr, "kernel_launch: grid %d (cus %d x %d)\n", grid, cus, per_cu);
    }
    if (grid < 0) return;
    if (hipMemsetAsync(d_ws, 0, 16384, stream) != hipSuccess) { fprintf(stderr, "kernel_launch: memset failed\n"); return; }
    Args a{};
    for (int i = 0; i < 24; ++i) a.in[i] = (const float*)d_in[i];
    a.out = (float*)d_out; a.ws = (unsigned char*)d_ws;
    void* args[] = {&a};
    hipError_t e = hipLaunchCooperativeKernel((const void*)fwd_kernel, dim3(grid), dim3(512), args, 0, stream);
    if (e != hipSuccess) fprintf(stderr, "cooperative launch failed: %s (grid %d)\n", hipGetErrorString(e), grid);
}
```

```cpp
#include <hip/hip_runtime.h>
#include <hip/hip_cooperative_groups.h>
#include <cstdio>
#include <cstdint>
namespace cg = cooperative_groups;
namespace pg8 {
#define PG8_LAS __attribute__((address_space(3)))
typedef unsigned short bf16_t;
typedef short bf16x8 __attribute__((ext_vector_type(8)));
typedef float f32x4 __attribute__((ext_vector_type(4)));
typedef unsigned u32x4 __attribute__((ext_vector_type(4)));
constexpr int BM = 256, BK = 64, HALF = 128, HTB = HALF * BK * 2  , STAGE_BYTES = 8 * HTB, NXCD = 8, WGM = 8;

__host__ __device__ __forceinline__ int lds_byte(int r, int c) { const int st = (r >> 4) * 2 + (c >> 5), rr = r & 15, cc = c & 31, ob = rr * 64 + cc * 2; return st * 1024 + (ob ^ (((ob >> 9) & 1) << 5)); }
__host__ __device__ __forceinline__ void stage_rc(int b, int& R, int& C) { const int st = b / 1024, sb = b % 1024, swz = sb ^ (((sb >> 9) & 1) << 5); R = (st >> 1) * 16 + swz / 64; C = (st & 1) * 32 + (swz % 64) / 2; }
__host__ __device__ __forceinline__ int perm32(int rho) { const int n = rho >> 4, i = rho & 15; return 8 * (i >> 2) + 4 * n + (i & 3); }

struct Unit { int pm, pn; };
struct Gemm { const bf16_t* A; const bf16_t* Bt; int M, N, K, lda; };

struct StaticOrder {
    int nM, nN, nwg, G, c;
    __host__ __device__ void init(int M, int N, int G_, int c_) { nM = M / BM; nN = N / BM; nwg = nM * nN; G = G_; c = c_; }
    __host__ __device__ bool next(int i, Unit& u) const {
        const long L = (long)i * G + c; if (L >= nwg) return false;
        int wgid = (int)L; { const int q = nwg / NXCD, r = nwg % NXCD, xcd = wgid % NXCD, off = wgid / NXCD; wgid = (xcd < r ? xcd * (q + 1) : r * (q + 1) + (xcd - r) * q) + off; }
        const int nig = WGM * nN, gid = wgid / nig, fm = gid * WGM, gsz = (nM - fm) < WGM ? (nM - fm) : WGM;
        u.pm = fm + ((wgid % nig) % gsz); u.pn = (wgid % nig) / gsz; return true;
    }
    __device__ __forceinline__ void a_ready(const Unit&) const {}
    __device__ __forceinline__ void done(const Unit&) const {}
};

__device__ __forceinline__ unsigned cvt_pk_bf16(float lo, float hi) { unsigned r; asm volatile("v_cvt_pk_bf16_f32 %0, %1, %2" : "=v"(r) : "v"(lo), "v"(hi)); return r; }
typedef float f32x2 __attribute__((ext_vector_type(2)));
template <class Epi, class Sched, bool ALIGN_EPI = false, bool SP2 = false>
__device__ __forceinline__ void gemm_phase(PG8_LAS unsigned char* lds, const Gemm g, const Sched& S, const Epi& E, const int wv  ) {
    int tid0_ = wv * 64 + (int)__builtin_amdgcn_mbcnt_hi(~0u, __builtin_amdgcn_mbcnt_lo(~0u, 0u)); asm volatile("" : "+v"(tid0_));
    const int tid = tid0_, wid = __builtin_amdgcn_readfirstlane(tid >> 6), lane = tid & 63, wr = wid >> 2, wc = wid & 3, fr = lane & 15, fq = lane >> 4;
    const int K = g.K, nt = K / BK;
    unsigned voffA[2], voffB[2];
#pragma unroll
    for (int i = 0; i < 2; ++i) { int R, C; stage_rc(tid * 16 + i * 8192, R, C); const int Rb = Epi::PERM ? ((R & ~31) + perm32(R & 31)) : R;
        voffA[i] = (unsigned)(R * g.lda + C) * 2u; voffB[i] = (unsigned)(Rb * K + C) * 2u; }
    const size_t kstep = (size_t)(BK * 2);
    const size_t hstepB = (size_t)HALF * K * 2, hstepA = (size_t)HALF * g.lda * 2;
    const size_t tstepB = 2 * hstepB, tstepA = 2 * hstepA;
    const unsigned ldsw = (unsigned)wid * 1024u;
    const int aoff = lds_byte(wr * 64 + fr, fq * 8), boff = lds_byte(wc * 32 + fr, fq * 8);
#define PG8_SA(b, h) (((b) * 2 + (h)) * HTB)
#define PG8_SB(b, h) ((4 + (b) * 2 + (h)) * HTB)
#define PG8_STAGE(bufoff, gbase, voff) do { _Pragma("unroll") for (int _i = 0; _i < 2; ++_i) \
        __builtin_amdgcn_global_load_lds((const unsigned*)((const char*)(gbase) + (voff)[_i]), (PG8_LAS unsigned*)(lds + (bufoff) + ldsw + _i * 8192), 16, 0, 0); } while (0)
#define PG8_LDA(dst, b, h) do { _Pragma("unroll") for (int m = 0; m < 4; ++m) _Pragma("unroll") for (int k = 0; k < 2; ++k) dst[m][k] = *(const PG8_LAS bf16x8*)(lds + PG8_SA(b, h) + aoff + m * 2048 + k * 1024); } while (0)
#define PG8_LDB(dst, b, h) do { _Pragma("unroll") for (int n = 0; n < 2; ++n) _Pragma("unroll") for (int k = 0; k < 2; ++k) dst[n][k] = *(const PG8_LAS bf16x8*)(lds + PG8_SB(b, h) + boff + n * 2048 + k * 1024); } while (0)
#define PG8_MMA(ai, bj, At, Bt) do { __builtin_amdgcn_s_setprio(1); _Pragma("unroll") for (int m = 0; m < 4; ++m) _Pragma("unroll") for (int n = 0; n < 2; ++n) _Pragma("unroll") for (int k = 0; k < 2; ++k) \
        acc[ai][bj][m][n] = __builtin_amdgcn_mfma_f32_16x16x32_bf16(Bt[n][k], At[m][k], acc[ai][bj][m][n], 0, 0, 0); __builtin_amdgcn_s_setprio(0); } while (0)
#define PG8_WAIT_V(n) asm volatile("s_waitcnt vmcnt(" #n ")" ::: "memory")
#define PG8_WAIT_L(n) asm volatile("s_waitcnt lgkmcnt(" #n ")" ::: "memory")
#define PG8_BAR __builtin_amdgcn_s_barrier()
#define PG8_SCHED __builtin_amdgcn_sched_barrier(0)
    Unit cur, nxt; int ui = 0;
    if (!S.next(0, cur)) return;
    f32x4 acc[2][2][4][2];
#pragma unroll
    for (int a = 0; a < 2; ++a)
#pragma unroll
        for (int b = 0; b < 2; ++b)
#pragma unroll
            for (int m = 0; m < 4; ++m)
#pragma unroll
                for (int n = 0; n < 2; ++n) acc[a][b][m][n] = (f32x4){0.f, 0.f, 0.f, 0.f};
    bf16x8 At[4][2], B0[2][2], B1[2][2];
    const char* cA = (const char*)g.A + (size_t)cur.pm * tstepA; const char* cB = (const char*)g.Bt + (size_t)cur.pn * tstepB;
    S.a_ready(cur);
    if constexpr (SP2) {
        PG8_STAGE(PG8_SB(0, 0), cB, voffB); PG8_STAGE(PG8_SB(0, 1), cB + hstepB, voffB); PG8_STAGE(PG8_SA(0, 0), cA, voffA); PG8_STAGE(PG8_SA(0, 1), cA + hstepA, voffA);
        if (wr == 1) PG8_BAR;
        PG8_WAIT_V(2); PG8_BAR;
        PG8_STAGE(PG8_SB(1, 0), cB + kstep, voffB); PG8_STAGE(PG8_SA(1, 0), cA + kstep, voffA); PG8_STAGE(PG8_SB(1, 1), cB + hstepB + kstep, voffB);
        PG8_WAIT_V(6); PG8_BAR;
    } else {
        PG8_STAGE(PG8_SB(0, 0), cB, voffB); PG8_STAGE(PG8_SA(0, 0), cA, voffA); PG8_STAGE(PG8_SB(0, 1), cB + hstepB, voffB); PG8_STAGE(PG8_SA(0, 1), cA + hstepA, voffA);
        if (wr == 1) PG8_BAR;
        PG8_WAIT_V(4); PG8_BAR;
        PG8_STAGE(PG8_SB(1, 0), cB + kstep, voffB); PG8_STAGE(PG8_SA(1, 0), cA + kstep, voffA); PG8_STAGE(PG8_SB(1, 1), cB + hstepB + kstep, voffB);
        PG8_WAIT_V(6); PG8_BAR;
    }
    for (;;) {
        const bool has_next = S.next(ui + 1, nxt);
        const char* nA = has_next ? (const char*)g.A + (size_t)nxt.pm * tstepA : cA; const char* nB = has_next ? (const char*)g.Bt + (size_t)nxt.pn * tstepB : cB;
#pragma unroll 1
        for (int t = 0; t < nt; t += 2) {
            const bool last = (t == nt - 2);
            if constexpr (Epi::MIDK) { if (t == 8) E.midk(acc, cur, wr, fr); }
            const char* a1 = cA + (size_t)(t + 1) * kstep;
            const char* a2 = last ? nA : cA + (size_t)(t + 2) * kstep; const char* b2 = last ? nB : cB + (size_t)(t + 2) * kstep;
            const char* a3 = a2 + kstep; const char* b3 = b2 + kstep;
            if (last && has_next) S.a_ready(nxt);
            if constexpr (SP2) {
            PG8_LDB(B0, 0, 0); PG8_LDB(B1, 0, 1); PG8_SCHED; PG8_LDA(At, 0, 0); PG8_STAGE(PG8_SA(1, 1), a1 + hstepA, voffA);
            PG8_WAIT_V(8); PG8_WAIT_L(0); PG8_BAR; PG8_MMA(0, 0, At, B0); PG8_MMA(0, 1, At, B1); PG8_BAR; PG8_SCHED;
            PG8_LDA(At, 0, 1); PG8_STAGE(PG8_SB(0, 0), b2, voffB); PG8_STAGE(PG8_SB(0, 1), b2 + hstepB, voffB); PG8_STAGE(PG8_SA(0, 0), a2, voffA);
            PG8_WAIT_V(8); PG8_WAIT_L(0); PG8_BAR; PG8_MMA(1, 0, At, B0); PG8_MMA(1, 1, At, B1); PG8_BAR; PG8_SCHED;
            PG8_LDB(B0, 1, 0); PG8_LDB(B1, 1, 1); PG8_SCHED; PG8_LDA(At, 1, 0); PG8_STAGE(PG8_SA(0, 1), a2 + hstepA, voffA);
            PG8_WAIT_V(8); PG8_WAIT_L(0); PG8_BAR; PG8_MMA(0, 0, At, B0); PG8_MMA(0, 1, At, B1); PG8_BAR; PG8_SCHED;
            PG8_LDA(At, 1, 1); PG8_STAGE(PG8_SB(1, 0), b3, voffB); PG8_STAGE(PG8_SB(1, 1), b3 + hstepB, voffB); PG8_STAGE(PG8_SA(1, 0), a3, voffA);
            PG8_WAIT_V(8); PG8_WAIT_L(0); PG8_BAR; PG8_MMA(1, 0, At, B0); PG8_MMA(1, 1, At, B1); PG8_BAR; PG8_SCHED;
            } else {
            PG8_LDB(B0, 0, 0); PG8_SCHED; PG8_LDA(At, 0, 0); PG8_STAGE(PG8_SA(1, 1), a1 + hstepA, voffA);
            PG8_WAIT_L(8); PG8_BAR; PG8_WAIT_L(0); PG8_MMA(0, 0, At, B0); PG8_BAR; PG8_SCHED;
            PG8_LDB(B1, 0, 1); PG8_STAGE(PG8_SB(0, 0), b2, voffB);
            PG8_BAR; PG8_WAIT_L(0); PG8_MMA(0, 1, At, B1); PG8_BAR;
            PG8_LDA(At, 0, 1); PG8_STAGE(PG8_SA(0, 0), a2, voffA);
            PG8_BAR; PG8_WAIT_L(0); PG8_MMA(1, 0, At, B0); PG8_BAR; PG8_SCHED;
            PG8_STAGE(PG8_SB(0, 1), b2 + hstepB, voffB);
            PG8_WAIT_V(6); PG8_BAR; PG8_MMA(1, 1, At, B1); PG8_BAR;
            PG8_LDB(B0, 1, 0); PG8_SCHED; PG8_LDA(At, 1, 0); PG8_STAGE(PG8_SA(0, 1), a2 + hstepA, voffA);
            PG8_WAIT_L(8); PG8_BAR; PG8_WAIT_L(0); PG8_MMA(0, 0, At, B0); PG8_BAR; PG8_SCHED;
            PG8_LDB(B1, 1, 1); PG8_STAGE(PG8_SB(1, 0), b3, voffB);
            PG8_BAR; PG8_WAIT_L(0); PG8_MMA(0, 1, At, B1); PG8_BAR;
            PG8_LDA(At, 1, 1); PG8_STAGE(PG8_SA(1, 0), a3, voffA);
            PG8_BAR; PG8_WAIT_L(0); PG8_MMA(1, 0, At, B0); PG8_BAR; PG8_SCHED;
            PG8_STAGE(PG8_SB(1, 1), b3 + hstepB, voffB);
            PG8_WAIT_V(6); PG8_BAR; PG8_MMA(1, 1, At, B1); PG8_BAR;
            }
        }
        if constexpr (ALIGN_EPI) { if (wr == 0) PG8_BAR; }
        if constexpr (!Epi::AFTER_DRAIN) { E(acc, cur, wr, wc, fr, fq); S.done(cur); }
        if (!has_next) break;
#pragma unroll
        for (int a = 0; a < 2; ++a)
#pragma unroll
            for (int b = 0; b < 2; ++b)
#pragma unroll
                for (int m = 0; m < 4; ++m)
#pragma unroll
                    for (int n = 0; n < 2; ++n) acc[a][b][m][n] = (f32x4){0.f, 0.f, 0.f, 0.f};
        cur = nxt; cA = nA; cB = nB; ++ui;
        if constexpr (ALIGN_EPI) { if (wr == 1) PG8_BAR; }
    }
    PG8_WAIT_V(0);
    if constexpr (!ALIGN_EPI) { if (wr == 0) PG8_BAR; }
    PG8_BAR;
    if constexpr (Epi::AFTER_DRAIN) { E.fused(acc, cur, wr, wc, fr, fq, lds, wid, lane); S.done(cur); }
#undef PG8_SA
#undef PG8_SB
#undef PG8_STAGE
#undef PG8_LDA
#undef PG8_LDB
#undef PG8_MMA
#undef PG8_WAIT_V
#undef PG8_WAIT_L
#undef PG8_BAR
#undef PG8_SCHED
}
}

#define LAS __attribute__((address_space(3)))
using pg8::bf16_t; using pg8::bf16x8; using pg8::f32x4; using pg8::u32x4;
typedef float f32x16 __attribute__((ext_vector_type(16)));
typedef float f32x2v __attribute__((ext_vector_type(2)));
typedef __bf16 bf16x2v __attribute__((ext_vector_type(2)));
typedef unsigned u32x2 __attribute__((ext_vector_type(2)));

constexpr int T = 32768, TP = 16384, DM = 1024, NLAYER = 2, NCR = 10, NMODC = 6144;
constexpr int INC = 1696, LZ = 1728, ZQ = 0, ZKV = 384, ZKR = 640, ZU = 704, ZV = 1216, ZATT = 192, NIN = 1792;
constexpr int DFF = 2816, NGU = 5632;
constexpr float EPS = 1e-6f;
constexpr float QSCALE = 0.10206207261596577f * 1.4426950408889634f;
constexpr size_t MiB = 1u << 20;
constexpr size_t WS_MOD = 512 * 1024, WS_ROPE = 1 * MiB, WS_SSQ = 2 * MiB, WS_W = 3 * MiB;
constexpr size_t OW_IN = 0, OW_QB = 3670016, OW_KVB = 4259840, OW_OUT = 4784128, OW_GU = 6881280, OW_D = 18415616, OW_S = 24182784, WL = 24444928;
constexpr size_t WS_H = 50 * MiB, WS_Z = 114 * MiB, WS_VT = 222 * MiB, WS_END = 254 * MiB;
static_assert(WS_Z + (size_t)32768 * LZ * 2 <= WS_VT, "z fits");
static_assert(WS_W + 2 * WL <= WS_H, "weights fit");
constexpr int LDS_BYTES = 147456;

struct Args { const float* in[24]; float* out; unsigned char* ws; };
constexpr int TAB_OFF = LDS_BYTES - 256;
typedef const float* cfptr;
#define GAS __attribute__((address_space(1)))
#define EB(xo) ((bf16_t*)((unsigned char*)(xo) + 2048))
#define INP(k) ((const float*)(ws + ((LAS long long*)(lds + TAB_OFF))[k]))

__device__ __forceinline__ float bf_lo(unsigned w) { return __uint_as_float(w << 16); }
__device__ __forceinline__ float bf_hi(unsigned w) { return __uint_as_float(w & 0xffff0000u); }
__device__ __forceinline__ unsigned pk2(float lo, float hi) { f32x2v v = {lo, hi}; bf16x2v b = __builtin_convertvector(v, bf16x2v); return __builtin_bit_cast(unsigned, b); }
__device__ __forceinline__ float wave_sum(float v) {
#pragma unroll
    for (int o = 1; o < 64; o <<= 1) v += __shfl_xor(v, o);
    return v;
}
__device__ __forceinline__ float gelu_tanh(float x) {
    const float u = 0.7978845608028654f * (x + 0.044715f * x * x * x);
    const float e = __builtin_amdgcn_exp2f(-2.8853900817779268f * u);
    return x * __builtin_amdgcn_rcpf(1.0f + e);
}
__device__ __forceinline__ float silu_f(float x) { return x * __builtin_amdgcn_rcpf(1.0f + __builtin_amdgcn_exp2f(-1.4426950408889634f * x)); }
__device__ __forceinline__ int tok_pos(int row) { return row < TP ? (row & 8191) : (row & 2047); }
__device__ __forceinline__ int tok_cr(int row) { return row < TP ? (row >> 13) : 2 + ((row - TP) >> 11); }

namespace pg8 {
template <bool MK> struct EpiStore {
    static constexpr bool PERM = true, AFTER_DRAIN = false, MIDK = MK;
    bf16_t* O; int ldc; int ncols; const float* ssq;
    __device__ __forceinline__ void operator()(const f32x4 (&acc)[2][2][4][2], const Unit& u, int wr, int wc, int fr, int fq) const {
        const int row0 = u.pm * BM + wr * 64 + fr, col0 = u.pn * BM + wc * 32 + 8 * fq;
#pragma unroll
        for (int ai = 0; ai < 2; ++ai)
#pragma unroll
            for (int m = 0; m < 4; ++m) { bf16_t* rowp = O + (size_t)(row0 + ai * HALF + m * 16) * ldc + col0;
#pragma unroll
                for (int bj = 0; bj < 2; ++bj) if (col0 + bj * HALF < ncols) { const f32x4 v0 = acc[ai][bj][m][0], v1 = acc[ai][bj][m][1];
                    u32x4 w; w.x = pk2(v0[0], v0[1]); w.y = pk2(v0[2], v0[3]); w.z = pk2(v1[0], v1[1]); w.w = pk2(v1[2], v1[3]);
                    *(u32x4*)(rowp + bj * HALF) = w; } }
    }
    __device__ __forceinline__ void midk(f32x4 (&acc)[2][2][4][2], const Unit& u, int wr, int fr) const {
#pragma unroll
        for (int ai = 0; ai < 2; ++ai)
#pragma unroll
            for (int m = 0; m < 4; ++m) { int row = u.pm * BM + ai * HALF + wr * 64 + m * 16 + fr; asm volatile("" : "+v"(row) :: "memory"); const f32x4* p = (const f32x4*)(ssq + (size_t)row * 8);
                const f32x4 s0 = p[0], s1 = p[1]; const float s = ((s0[0] + s0[1]) + (s0[2] + s0[3])) + ((s1[0] + s1[1]) + (s1[2] + s1[3]));
                const float rs = rsqrtf(s * (1.0f / 512.0f) + EPS);
#pragma unroll
                for (int bj = 0; bj < 2; ++bj)
#pragma unroll
                    for (int n = 0; n < 2; ++n) acc[ai][bj][m][n] *= rs; }
    }
};
struct EpiQ {
    static constexpr bool PERM = false, AFTER_DRAIN = false, MIDK = false;
    bf16_t* Q; const float* rope; const float* rstd;
    __device__ __forceinline__ void midk(f32x4 (&)[2][2][4][2], const Unit&, int, int) const {}
    __device__ __forceinline__ void operator()(const f32x4 (&acc)[2][2][4][2], const Unit& u, int wr, int wc, int fr, int fq) const {
        const int G0 = 8 * u.pn + wc, part0 = G0 % 3, part1 = (G0 + 4) % 3;
#pragma unroll
        for (int ai = 0; ai < 2; ++ai)
#pragma unroll
            for (int m = 0; m < 4; ++m) { int row = u.pm * BM + ai * HALF + wr * 64 + m * 16 + fr; asm volatile("" : "+v"(row)); bf16_t* rp = Q + (size_t)row * 768 + 32 * G0 + 4 * fq;
                const float rs = rstd[row] * QSCALE;
                f32x4 cs = {1.f, 1.f, 1.f, 1.f}, sn = {0.f, 0.f, 0.f, 0.f};
                if (part0 == 2 || part1 == 2) { const f32x4* t = (const f32x4*)(rope + ((size_t)tok_pos(row) * 16 + 4 * fq) * 2); const f32x4 c0 = t[0], c1 = t[1];
                    cs = (f32x4){c0[0], c0[2], c1[0], c1[2]}; sn = (f32x4){c0[1], c0[3], c1[1], c1[3]}; }
#pragma unroll
                for (int bj = 0; bj < 2; ++bj) { const bool rp2 = (bj == 0 ? part0 : part1) == 2;
                    f32x4 x1 = acc[ai][bj][m][0] * rs, x2 = acc[ai][bj][m][1] * rs;
                    if (rp2) { const f32x4 o1 = x1 * cs - x2 * sn, o2 = x1 * sn + x2 * cs; x1 = o1; x2 = o2; }
                    u32x2 w1, w2; w1.x = pk2(x1[0], x1[1]); w1.y = pk2(x1[2], x1[3]); w2.x = pk2(x2[0], x2[1]); w2.y = pk2(x2[2], x2[3]);
                    *(u32x2*)(rp + 128 * bj) = w1; *(u32x2*)(rp + 128 * bj + 16) = w2; }
                asm volatile("" ::: "memory"); }
    }
};
struct EpiKV {
    static constexpr bool PERM = true, AFTER_DRAIN = false, MIDK = false;
    bf16_t* kn; bf16_t* vt; const float* rstd;
    __device__ __forceinline__ void midk(f32x4 (&)[2][2][4][2], const Unit&, int, int) const {}
    __device__ __forceinline__ void operator()(const f32x4 (&acc)[2][2][4][2], const Unit& u, int wr, int wc, int fr, int fq) const {
        const int sfr = (fr & 3) | ((fr & 4) << 1) | ((fr & 8) >> 1); const int within = 32 * wc + 8 * fq;
#pragma unroll
        for (int ai = 0; ai < 2; ++ai)
#pragma unroll
            for (int m = 0; m < 4; ++m) { int row = u.pm * BM + ai * HALF + wr * 64 + m * 16 + fr; asm volatile("" : "+v"(row)); const float rs = rstd[row];
#pragma unroll
                for (int bj = 0; bj < 2; ++bj) { const int head = 2 * u.pn + bj;
                    const f32x4 v0 = acc[ai][bj][m][0] * rs, v1 = acc[ai][bj][m][1] * rs;
                    u32x4 w; w.x = pk2(v0[0], v0[1]); w.y = pk2(v0[2], v0[3]); w.z = pk2(v1[0], v1[1]); w.w = pk2(v1[2], v1[3]);
                    if (wc < 2) { *(u32x4*)(kn + (size_t)row * LZ + head * 64 + within) = w; }
                    else { bf16_t* vp = vt + (size_t)(head * 64 + within - 64) * T + ((row & ~15) | sfr);
                        vp[0] = (bf16_t)(w.x & 0xffffu); vp[(size_t)T] = (bf16_t)(w.x >> 16); vp[(size_t)2 * T] = (bf16_t)(w.y & 0xffffu); vp[(size_t)3 * T] = (bf16_t)(w.y >> 16);
                        vp[(size_t)4 * T] = (bf16_t)(w.z & 0xffffu); vp[(size_t)5 * T] = (bf16_t)(w.z >> 16); vp[(size_t)6 * T] = (bf16_t)(w.w & 0xffffu); vp[(size_t)7 * T] = (bf16_t)(w.w >> 16); } }
                asm volatile("" ::: "memory"); }
    }
};
struct EpiGU {
    static constexpr bool PERM = true, AFTER_DRAIN = false, MIDK = false;
    bf16_t* O;
    __device__ __forceinline__ void midk(f32x4 (&)[2][2][4][2], const Unit&, int, int) const {}
    __device__ __forceinline__ void operator()(const f32x4 (&acc)[2][2][4][2], const Unit& u, int wr, int wc, int fr, int fq) const {
        const int col = 128 * u.pn + 32 * wc + 8 * fq;
#pragma unroll
        for (int ai = 0; ai < 2; ++ai)
#pragma unroll
            for (int m = 0; m < 4; ++m) { const int row = u.pm * BM + ai * HALF + wr * 64 + m * 16 + fr;
                const f32x4 g0 = acc[ai][0][m][0], g1 = acc[ai][0][m][1], u0 = acc[ai][1][m][0], u1 = acc[ai][1][m][1];
                u32x4 w; w.x = pk2(silu_f(g0[0]) * u0[0], silu_f(g0[1]) * u0[1]); w.y = pk2(silu_f(g0[2]) * u0[2], silu_f(g0[3]) * u0[3]);
                w.z = pk2(silu_f(g1[0]) * u1[0], silu_f(g1[1]) * u1[1]); w.w = pk2(silu_f(g1[2]) * u1[2], silu_f(g1[3]) * u1[3]);
                *(u32x4*)(O + (size_t)row * DFF + col) = w; }
    }
};
}

__device__ __forceinline__ int rowmap(int mode, int n) { return mode == 0 ? n : mode == 3 ? (n < 672 ? n : n + 32) : (((n >> 7) << 8) + (n & 127) + (mode == 2 ? 128 : 0)); }
__device__ __forceinline__ void transpose_item(const float* W, int K, int N, bf16_t* WT, int mode, const float* gain, LAS float* scr, int item, int lane) {
    const int nblk = N / 32, kb = item / nblk, nb = item % nblk, k0 = 64 * kb, n0 = 32 * nb;
    { const int kq = lane >> 3, nq = lane & 7;
      f32x4 v[8];
#pragma unroll
      for (int i = 0; i < 8; ++i) v[i] = __builtin_nontemporal_load((const f32x4*)(W + (size_t)(k0 + 8 * i + kq) * N + n0 + 4 * nq));
#pragma unroll
      for (int i = 0; i < 8; ++i) { const int kk = 8 * i + kq; const float gk = gain ? gain[k0 + kk] : 1.0f;
#pragma unroll
          for (int e = 0; e < 4; ++e) scr[kk * 33 + 4 * nq + e] = v[i][e] * gk; } }
    asm volatile("s_waitcnt lgkmcnt(0)" ::: "memory");
    const int c = lane & 7;
#pragma unroll
    for (int j = 0; j < 4; ++j) { const int n = (lane >> 3) + 8 * j; const LAS float* s = scr + (8 * c) * 33 + n;
        u32x4 o; o.x = pk2(s[0 * 33], s[1 * 33]); o.y = pk2(s[2 * 33], s[3 * 33]); o.z = pk2(s[4 * 33], s[5 * 33]); o.w = pk2(s[6 * 33], s[7 * 33]);
        *(u32x4*)(WT + (size_t)rowmap(mode, n0 + n) * K + k0 + 8 * c) = o; }
    asm volatile("s_waitcnt lgkmcnt(0)" ::: "memory");
}

constexpr int WT_I_IN = 16 * 53, WT_I_QB = 6 * 24, WT_I_KVB = 4 * 32, WT_I_OUT = 16 * 32, WT_I_G = 16 * 88, WT_I_D = 44 * 32;
constexpr int WT_NITEMS = WT_I_IN + WT_I_QB + WT_I_KVB + WT_I_OUT + 2 * WT_I_G + WT_I_D;
__device__ __forceinline__ void wt_convert(unsigned char* ws, LAS unsigned char* lds, int l, int it0, int it1, int rank, int nwk, int tid, int lane, int wid) {
    unsigned char* wb = ws + WS_W + (size_t)l * WL;
    if (it0 == 0) {
        const int gtid = rank * 512 + tid, NT = nwk * 512;
        for (int j = gtid; j < 65536; j += NT) { const float* s = INP(16) + (size_t)l * 131072 + 2 * j; ((unsigned*)(wb + OW_S))[j] = pk2(s[0], s[1]); }
        for (int j = gtid; j < 12288; j += NT) { const int r = j >> 7, dr = r < 32 ? 672 + r : 1728 + (r - 32);
            ((u32x4*)(wb + OW_IN))[(size_t)dr * 128 + (j & 127)] = (u32x4){0u, 0u, 0u, 0u}; }
    }
    LAS float* scr = (LAS float*)(lds + 65536) + wid * (64 * 33);
    for (int it = it0 + rank * 8 + wid; it < it1; it += nwk * 8) {
        int r = it;
        if (r < WT_I_IN) { transpose_item(INP(10) + (size_t)l * 1024 * INC, 1024, INC, (bf16_t*)(wb + OW_IN), 3, nullptr, scr, r, lane); continue; } r -= WT_I_IN;
        if (r < WT_I_QB) { transpose_item(INP(12) + (size_t)l * 384 * 768, 384, 768, (bf16_t*)(wb + OW_QB), 0, INP(11) + l * 384, scr, r, lane); continue; } r -= WT_I_QB;
        if (r < WT_I_KVB) { transpose_item(INP(14) + (size_t)l * 256 * 1024, 256, 1024, (bf16_t*)(wb + OW_KVB), 0, INP(13) + l * 256, scr, r, lane); continue; } r -= WT_I_KVB;
        if (r < WT_I_OUT) { const int kb = r / 32; transpose_item(INP(20) + (size_t)l * 1024 * 1024, 1024, 1024, (bf16_t*)(wb + OW_OUT), 0, kb < 8 ? INP(18) + l * 512 : INP(19) + l * 512 - 512, scr, r, lane); continue; } r -= WT_I_OUT;
        if (r < WT_I_G) { transpose_item(INP(21) + (size_t)l * 1024 * DFF, 1024, DFF, (bf16_t*)(wb + OW_GU), 1, nullptr, scr, r, lane); continue; } r -= WT_I_G;
        if (r < WT_I_G) { transpose_item(INP(22) + (size_t)l * 1024 * DFF, 1024, DFF, (bf16_t*)(wb + OW_GU), 2, nullptr, scr, r, lane); continue; } r -= WT_I_G;
        transpose_item(INP(23) + (size_t)l * DFF * 1024, DFF, 1024, (bf16_t*)(wb + OW_D), 0, nullptr, scr, r, lane);
    }
}

__device__ __forceinline__ void p0_phase(unsigned char* ws, LAS unsigned char* lds, const int wv) {
    int tid = wv * 64 + (int)__builtin_amdgcn_mbcnt_hi(~0u, __builtin_amdgcn_mbcnt_lo(~0u, 0u)); asm volatile("" : "+v"(tid)); const int lane = tid & 63, wid = wv;
    const int G = gridDim.x;
    {
        LAS float* cs = (LAS float*)lds; LAS float* red = cs + NCR * 1024;
        float* mod = (float*)(ws + WS_MOD);
        for (int bg = blockIdx.x; bg < 192; bg += G) {
            for (int t = tid; t < NCR * 1024; t += 512) { const int cr = t >> 10, k = t & 1023; const float c = cr < 2 ? INP(2)[cr * 1024 + k] : INP(3)[(cr - 2) * 1024 + k]; cs[t] = silu_f(c); }
            __syncthreads();
            const int l = bg / 96, cb = (bg % 96) * 64;
            const int cg4 = lane & 15, kq = lane >> 4;
            const float* wm = INP(4) + (size_t)l * 1024 * NMODC + cb + 4 * cg4;
            f32x4 acc[NCR];
#pragma unroll
            for (int cr = 0; cr < NCR; ++cr) acc[cr] = (f32x4){0.f, 0.f, 0.f, 0.f};
#pragma unroll 8
            for (int kk = 0; kk < 32; ++kk) { const int k = wid * 128 + 4 * kk + kq; const f32x4 w = __builtin_nontemporal_load((const f32x4*)(wm + (size_t)k * NMODC));
#pragma unroll
                for (int cr = 0; cr < NCR; ++cr) acc[cr] += w * cs[cr * 1024 + k]; }
#pragma unroll
            for (int cr = 0; cr < NCR; ++cr) {
#pragma unroll
                for (int e = 0; e < 4; ++e) { float s = acc[cr][e]; s += __shfl_xor(s, 16); s += __shfl_xor(s, 32); acc[cr][e] = s; }
                if (kq == 0) *(LAS f32x4*)(red + (wid * NCR + cr) * 64 + 4 * cg4) = acc[cr]; }
            __syncthreads();
            for (int t = tid; t < NCR * 64; t += 512) { const int cr = t >> 6, ln = t & 63; float s = 0.f;
#pragma unroll
                for (int w = 0; w < 8; ++w) s += red[(w * NCR + cr) * 64 + ln];
                mod[(size_t)(l * NCR + cr) * NMODC + cb + ln] = s + INP(5)[l * NMODC + cb + ln]; }
            __syncthreads();
        }
    }
    const int gtid = blockIdx.x * 512 + tid, NT = G * 512;
    {
        float* rope = (float*)(ws + WS_ROPE);
        for (int idx = gtid; idx < 8192 * 16; idx += NT) { const int pos = idx >> 4, i = idx & 15;
            const float inv = exp2f(-(float)i * 0.8304820237218406f);
            const float ang = (float)pos * inv;
            double rev = (double)ang * 0.15915494309189535; rev -= __builtin_rint(rev);
            const float rf = (float)rev;
            rope[2 * idx] = __builtin_amdgcn_cosf(rf); rope[2 * idx + 1] = __builtin_amdgcn_sinf(rf); }
    }
    wt_convert(ws, lds, 0, 0, WT_NITEMS, blockIdx.x, G, tid, lane, wid);
    wt_convert(ws, lds, 1, 0, WT_NITEMS, blockIdx.x, G, tid, lane, wid);
}

struct RowArgs { const bf16_t* src; const float* xin_p; const float* xin_s; float* xout; const float* gpost; const float* ga; const float* gpre; const float* sc; const float* sh; bf16_t* hout; unsigned char* xb; int src_ld, h_ld; };
template <bool HAS_RES, bool HAS_H, bool XIN_BF, bool XOUT_BF>
__device__ __forceinline__ void row_phase(const RowArgs& ra, const int wv) {
    int tid = wv * 64 + (int)__builtin_amdgcn_mbcnt_hi(~0u, __builtin_amdgcn_mbcnt_lo(~0u, 0u)); asm volatile("" : "+v"(tid)); const int lane = tid & 63, wid = wv;
    const int gw = blockIdx.x * 8 + wid, NGW = gridDim.x * 8;
    for (int grp = gw; grp < T / 16; grp += NGW) {
        const int r0 = grp * 16, cr = tok_cr(r0);
        float A[16], B[16], S[16];
#pragma unroll
        for (int j = 0; j < 2; ++j)
#pragma unroll
            for (int q = 0; q < 2; ++q) { const int c = 512 * j + 8 * lane + 4 * q;
                if (HAS_RES) { const f32x4 g = *(const f32x4*)(ra.gpost + c), m = *(const f32x4*)(ra.ga + (size_t)cr * NMODC + c);
#pragma unroll
                    for (int e = 0; e < 4; ++e) A[8 * j + 4 * q + e] = g[e] * m[e]; }
                if (HAS_H) { const f32x4 g = *(const f32x4*)(ra.gpre + c), s1 = *(const f32x4*)(ra.sc + (size_t)cr * NMODC + c), s2 = *(const f32x4*)(ra.sh + (size_t)cr * NMODC + c);
#pragma unroll
                    for (int e = 0; e < 4; ++e) { B[8 * j + 4 * q + e] = g[e] * (1.0f + s1[e]); S[8 * j + 4 * q + e] = s2[e]; } } }
#pragma unroll 2
        for (int i = 0; i < 16; ++i) {
            const int row = r0 + i;
            float x[16];
            if constexpr (XIN_BF) {
#pragma unroll
                for (int j = 0; j < 2; ++j) { const u32x4 w = __builtin_nontemporal_load((const u32x4*)((const bf16_t*)(ra.xb + (size_t)row * 4096) + 512 * j + 8 * lane));
                    x[8 * j + 0] = bf_lo(w.x); x[8 * j + 1] = bf_hi(w.x); x[8 * j + 2] = bf_lo(w.y); x[8 * j + 3] = bf_hi(w.y);
                    x[8 * j + 4] = bf_lo(w.z); x[8 * j + 5] = bf_hi(w.z); x[8 * j + 6] = bf_lo(w.w); x[8 * j + 7] = bf_hi(w.w); }
            } else {
                const float* xr = row < TP ? ra.xin_p + (size_t)row * DM : ra.xin_s + (size_t)(row - TP) * DM;
#pragma unroll
                for (int j = 0; j < 2; ++j)
#pragma unroll
                    for (int q = 0; q < 2; ++q) { const f32x4 v = __builtin_nontemporal_load((const f32x4*)(xr + 512 * j + 8 * lane + 4 * q));
#pragma unroll
                        for (int e = 0; e < 4; ++e) x[8 * j + 4 * q + e] = v[e]; }
            }
            if (HAS_RES) {
                float sv[16]; float ss = 0.f;
#pragma unroll
                for (int j = 0; j < 2; ++j) { const u32x4 w = __builtin_nontemporal_load((const u32x4*)(ra.src + (size_t)row * ra.src_ld + 512 * j + 8 * lane));
                    sv[8 * j + 0] = bf_lo(w.x); sv[8 * j + 1] = bf_hi(w.x); sv[8 * j + 2] = bf_lo(w.y); sv[8 * j + 3] = bf_hi(w.y);
                    sv[8 * j + 4] = bf_lo(w.z); sv[8 * j + 5] = bf_hi(w.z); sv[8 * j + 6] = bf_lo(w.w); sv[8 * j + 7] = bf_hi(w.w); }
#pragma unroll
                for (int e = 0; e < 16; ++e) ss += sv[e] * sv[e];
                const float rs = rsqrtf(wave_sum(ss) * (1.0f / DM) + EPS);
#pragma unroll
                for (int e = 0; e < 16; ++e) x[e] += A[e] * (sv[e] * rs);
                if constexpr (XOUT_BF) {
#pragma unroll
                    for (int j = 0; j < 2; ++j) { u32x4 w; w.x = pk2(x[8 * j], x[8 * j + 1]); w.y = pk2(x[8 * j + 2], x[8 * j + 3]); w.z = pk2(x[8 * j + 4], x[8 * j + 5]); w.w = pk2(x[8 * j + 6], x[8 * j + 7]);
                        __builtin_nontemporal_store(w, (u32x4*)((bf16_t*)(ra.xb + (size_t)row * 4096) + 512 * j + 8 * lane)); }
                } else {
#pragma unroll
                    for (int j = 0; j < 2; ++j)
#pragma unroll
                        for (int q = 0; q < 2; ++q) { const f32x4 v = {x[8 * j + 4 * q], x[8 * j + 4 * q + 1], x[8 * j + 4 * q + 2], x[8 * j + 4 * q + 3]};
                            __builtin_nontemporal_store(v, (f32x4*)(ra.xout + (size_t)row * DM + 512 * j + 8 * lane + 4 * q)); }
                }
            }
            if (HAS_H) {
                float ss = 0.f;
#pragma unroll
                for (int e = 0; e < 16; ++e) ss += x[e] * x[e];
                const float rs = rsqrtf(wave_sum(ss) * (1.0f / DM) + EPS);
#pragma unroll
                for (int j = 0; j < 2; ++j) { u32x4 w; float h[8];
#pragma unroll
                    for (int e = 0; e < 8; ++e) h[e] = x[8 * j + e] * rs * B[8 * j + e] + S[8 * j + e];
                    w.x = pk2(h[0], h[1]); w.y = pk2(h[2], h[3]); w.z = pk2(h[4], h[5]); w.w = pk2(h[6], h[7]);
                    __builtin_nontemporal_store(w, (u32x4*)(ra.hout + (size_t)row * ra.h_ld + 512 * j + 8 * lane)); }
            }
        }
    }
}

__device__ __forceinline__ void mid_phase(unsigned char* ws, int l, LAS unsigned char* lds, const int wv) {
    int tid = wv * 64 + (int)__builtin_amdgcn_mbcnt_hi(~0u, __builtin_amdgcn_mbcnt_lo(~0u, 0u)); asm volatile("" : "+v"(tid)); const int lane = tid & 63, wid = wv;
    bf16_t* z = (bf16_t*)(ws + WS_Z); bf16_t* kr = (bf16_t*)(ws + WS_H) + (size_t)T * 768;
    float* rstdq = (float*)(ws + WS_SSQ); float* rstdkv = rstdq + T;
    const float* rope = (const float*)(ws + WS_ROPE);
    const bf16_t* Wsb = (const bf16_t*)(ws + WS_W + l * WL + OW_S);
    const float* g_sgu = INP(15) + l * 512; const float* b_sp = INP(17) + l * 1024;
    LAS bf16_t* vn = (LAS bf16_t*)lds;
    LAS float* part = (LAS float*)(lds + 131072);
    LAS float* rstd_s = part + 1024;
    const int r32 = lane & 31, hi = lane >> 5;
    for (int ch = blockIdx.x; ch < T / 128; ch += gridDim.x) {
        const int R0 = ch * 128;
        float gs[8];
#pragma unroll
        for (int e = 0; e < 8; ++e) gs[e] = g_sgu[8 * lane + e];
        { const int rrow = R0 + wid * 16 + (lane >> 2), L = lane & 3;
          const u32x4 wr_ = *(const u32x4*)(z + (size_t)rrow * LZ + ZKR + 8 * L);
          const f32x4* tp = (const f32x4*)(rope + ((size_t)tok_pos(rrow) * 16 + 8 * (L & 1)) * 2);
          const f32x4 t0 = tp[0], t1 = tp[1], t2 = tp[2], t3 = tp[3];
          const float cs[8] = {t0[0], t0[2], t1[0], t1[2], t2[0], t2[2], t3[0], t3[2]}, sn[8] = {t0[1], t0[3], t1[1], t1[3], t2[1], t2[3], t3[1], t3[3]};
          float mine[8] = {bf_lo(wr_.x), bf_hi(wr_.x), bf_lo(wr_.y), bf_hi(wr_.y), bf_lo(wr_.z), bf_hi(wr_.z), bf_lo(wr_.w), bf_hi(wr_.w)}; float o[8];
#pragma unroll
          for (int e = 0; e < 8; ++e) { const float oth = __shfl_xor(mine[e], 2); o[e] = L < 2 ? (mine[e] * cs[e] - oth * sn[e]) : (oth * sn[e] + mine[e] * cs[e]); }
          u32x4 w; w.x = pk2(o[0], o[1]); w.y = pk2(o[2], o[3]); w.z = pk2(o[4], o[5]); w.w = pk2(o[6], o[7]);
          *(u32x4*)(kr + (size_t)rrow * 32 + 8 * L) = w; }
#pragma unroll 1
        for (int i0 = 0; i0 < 16; i0 += 4) {
            u32x4 wqa[4], wkva[4], wva[4];
#pragma unroll
            for (int k = 0; k < 4; ++k) { const bf16_t* zr = z + (size_t)(R0 + wid * 16 + i0 + k) * LZ;
                wqa[k] = (u32x4){0u, 0u, 0u, 0u}; wkva[k] = (u32x4){0u, 0u, 0u, 0u};
                if (lane < 48) wqa[k] = *(const u32x4*)(zr + ZQ + 8 * lane);
                if (lane < 32) wkva[k] = *(const u32x4*)(zr + ZKV + 8 * lane);
                wva[k] = __builtin_nontemporal_load((const u32x4*)(zr + ZV + 8 * lane)); }
#pragma unroll
            for (int k = 0; k < 4; ++k) {
                const int lr = wid * 16 + i0 + k, row = R0 + lr; const u32x4 wq = wqa[k], wkv = wkva[k], wv = wva[k];
                float sq = 0.f, skv = 0.f;
                { const float f0 = bf_lo(wq.x), f1 = bf_hi(wq.x), f2 = bf_lo(wq.y), f3 = bf_hi(wq.y), f4 = bf_lo(wq.z), f5 = bf_hi(wq.z), f6 = bf_lo(wq.w), f7 = bf_hi(wq.w);
                  sq = (f0 * f0 + f1 * f1) + (f2 * f2 + f3 * f3) + (f4 * f4 + f5 * f5) + (f6 * f6 + f7 * f7); }
                { const float f0 = bf_lo(wkv.x), f1 = bf_hi(wkv.x), f2 = bf_lo(wkv.y), f3 = bf_hi(wkv.y), f4 = bf_lo(wkv.z), f5 = bf_hi(wkv.z), f6 = bf_lo(wkv.w), f7 = bf_hi(wkv.w);
                  skv = (f0 * f0 + f1 * f1) + (f2 * f2 + f3 * f3) + (f4 * f4 + f5 * f5) + (f6 * f6 + f7 * f7); }
                float gv[8];
                gv[0] = gelu_tanh(bf_lo(wv.x)); gv[1] = gelu_tanh(bf_hi(wv.x)); gv[2] = gelu_tanh(bf_lo(wv.y)); gv[3] = gelu_tanh(bf_hi(wv.y));
                gv[4] = gelu_tanh(bf_lo(wv.z)); gv[5] = gelu_tanh(bf_hi(wv.z)); gv[6] = gelu_tanh(bf_lo(wv.w)); gv[7] = gelu_tanh(bf_hi(wv.w));
                float sv = 0.f;
#pragma unroll
                for (int e = 0; e < 8; ++e) sv += gv[e] * gv[e];
                sq = wave_sum(sq); skv = wave_sum(skv); sv = wave_sum(sv);
                if (lane == 0) { rstdq[row] = rsqrtf(sq * (1.0f / 384.0f) + EPS); rstdkv[row] = rsqrtf(skv * (1.0f / 256.0f) + EPS); }
                const float rv = rsqrtf(sv * (1.0f / 512.0f) + EPS);
                { u32x4 o; o.x = pk2(gv[0] * rv * gs[0], gv[1] * rv * gs[1]); o.y = pk2(gv[2] * rv * gs[2], gv[3] * rv * gs[3]);
                  o.z = pk2(gv[4] * rv * gs[4], gv[5] * rv * gs[5]); o.w = pk2(gv[6] * rv * gs[6], gv[7] * rv * gs[7]);
                  *(LAS u32x4*)(vn + lr * 512 + 8 * lane) = o; }
            }
        }
        __syncthreads();
        const int g = wid;
        f32x16 acc[2][4];
#pragma unroll
        for (int ct = 0; ct < 2; ++ct)
#pragma unroll
            for (int tt = 0; tt < 4; ++tt)
#pragma unroll
                for (int r = 0; r < 16; ++r) acc[ct][tt][r] = 0.f;
#pragma unroll 1
        for (int ks = 0; ks < 8; ++ks) {
            bf16x8 af[2], bfr[4];
#pragma unroll
            for (int ct = 0; ct < 2; ++ct)
#pragma unroll
                for (int e = 0; e < 8; ++e) af[ct][e] = (short)vn[(16 * ks + 8 * hi + e) * 512 + 64 * g + 32 * ct + r32];
#pragma unroll
            for (int tt = 0; tt < 4; ++tt) bfr[tt] = *(const bf16x8*)(Wsb + ((size_t)(g * 128 + 32 * tt + r32) * 128 + 16 * ks + 8 * hi));
#pragma unroll
            for (int ct = 0; ct < 2; ++ct)
#pragma unroll
                for (int tt = 0; tt < 4; ++tt) acc[ct][tt] = __builtin_amdgcn_mfma_f32_32x32x16_bf16(af[ct], bfr[tt], acc[ct][tt], 0, 0, 0);
        }
#pragma unroll
        for (int tt = 0; tt < 4; ++tt) { const int t = 32 * tt + r32; const float bias = b_sp[g * 128 + t]; const bf16_t* zu = z + (size_t)(R0 + t) * LZ + ZU + 64 * g; float s = 0.f;
#pragma unroll
            for (int ct = 0; ct < 2; ++ct)
#pragma unroll
                for (int rq = 0; rq < 4; ++rq) { const u32x2 w = *(const u32x2*)(zu + 32 * ct + 8 * rq + 4 * hi);
                    const float u0 = gelu_tanh(bf_lo(w.x)), u1 = gelu_tanh(bf_hi(w.x)), u2 = gelu_tanh(bf_lo(w.y)), u3 = gelu_tanh(bf_hi(w.y));
                    float v0 = u0 * (acc[ct][tt][4 * rq] + bias), v1 = u1 * (acc[ct][tt][4 * rq + 1] + bias), v2 = u2 * (acc[ct][tt][4 * rq + 2] + bias), v3 = u3 * (acc[ct][tt][4 * rq + 3] + bias);
                    acc[ct][tt][4 * rq] = v0; acc[ct][tt][4 * rq + 1] = v1; acc[ct][tt][4 * rq + 2] = v2; acc[ct][tt][4 * rq + 3] = v3;
                    s += (v0 * v0 + v1 * v1) + (v2 * v2 + v3 * v3); }
            s += __shfl_xor(s, 32);
            if (hi == 0) part[g * 128 + t] = s; }
        __syncthreads();
        if (tid < 128) { float s = 0.f;
#pragma unroll
            for (int w = 0; w < 8; ++w) s += part[w * 128 + tid];
            rstd_s[tid] = rsqrtf(s * (1.0f / 512.0f) + EPS); }
        __syncthreads();
#pragma unroll
        for (int tt = 0; tt < 4; ++tt) { const int t = 32 * tt + r32; const float rs = rstd_s[t]; bf16_t* zu = z + (size_t)(R0 + t) * LZ + ZU + 64 * g;
#pragma unroll
            for (int ct = 0; ct < 2; ++ct)
#pragma unroll
                for (int rq = 0; rq < 4; ++rq) { u32x2 w; w.x = pk2(acc[ct][tt][4 * rq] * rs, acc[ct][tt][4 * rq + 1] * rs); w.y = pk2(acc[ct][tt][4 * rq + 2] * rs, acc[ct][tt][4 * rq + 3] * rs);
                    *(u32x2*)(zu + 32 * ct + 8 * rq + 4 * hi) = w; } }
        __syncthreads();
    }
}

constexpr int KROW = 208, VROW = 144, KTILE_B = 64 * KROW, VTILE_B = 64 * VROW;
__device__ __forceinline__ void attn_phase(unsigned char* ws, LAS unsigned char* lds, const int wv) {
    int tid = wv * 64 + (int)__builtin_amdgcn_mbcnt_hi(~0u, __builtin_amdgcn_mbcnt_lo(~0u, 0u)); asm volatile("" : "+v"(tid)); const int lane = tid & 63, wid = wv;
    const bf16_t* Q = (const bf16_t*)(ws + WS_H); const bf16_t* kr = Q + (size_t)T * 768;
    bf16_t* z = (bf16_t*)(ws + WS_Z); const bf16_t* kn = z + ZV; const bf16_t* Vt = (const bf16_t*)(ws + WS_VT);
    float* ssq = (float*)(ws + WS_SSQ);
    const int r32 = lane & 31, hi = lane >> 5, G = gridDim.x;
    if (wid >= 4) __builtin_amdgcn_s_setprio(1);
    LAS unsigned char* Kl = lds; LAS unsigned char* Vl = lds + 2 * KTILE_B;
    const int kc0 = tid, kc1 = tid + 512;
    const int kr0 = kc0 / 12, kp0 = kc0 % 12, kr1 = kc1 / 12, kp1 = kc1 % 12;
    const int vd = tid >> 3, vch = tid & 7;
    for (int it = 0;; ++it) {
        const int flat = it * G + blockIdx.x; if (flat >= 1024) break;
        int seq, head, qb, s0, len;
        { const int v = flat < 512 ? flat : flat - 512; const int x = v & 7, y = v >> 3;
          if (flat < 512) { qb = y & 31; const int pair = x + 8 * (y >> 5); seq = pair >> 3; head = pair & 7; s0 = seq * 8192; len = 8192; }
          else { qb = y & 7; const int pair = x + 8 * (y >> 3); seq = pair >> 3; head = pair & 7; s0 = TP + seq * 2048; len = 2048; } }
        const int NTL = len / 64;
        const int qrow = s0 + qb * 256 + wid * 32 + r32;
        bf16x8 qf[6];
#pragma unroll
        for (int d0 = 0; d0 < 6; ++d0) qf[d0] = *(const bf16x8*)(Q + (size_t)qrow * 768 + head * 96 + d0 * 16 + hi * 8);
        const unsigned ko0 = kp0 < 8 ? (unsigned)(WS_Z + ((size_t)(s0 + kr0) * LZ + ZV + head * 64 + kp0 * 8) * 2) : (unsigned)(WS_H + ((size_t)T * 768 + (size_t)(s0 + kr0) * 32 + (kp0 - 8) * 8) * 2);
        const unsigned kst0 = kp0 < 8 ? 64u * LZ * 2u : 64u * 32u * 2u;
        const unsigned ko1 = kp1 < 8 ? (unsigned)(WS_Z + ((size_t)(s0 + kr1) * LZ + ZV + head * 64 + kp1 * 8) * 2) : (unsigned)(WS_H + ((size_t)T * 768 + (size_t)(s0 + kr1) * 32 + (kp1 - 8) * 8) * 2);
        const unsigned kst1 = kp1 < 8 ? 64u * LZ * 2u : 64u * 32u * 2u;
        const unsigned vo = (unsigned)(WS_VT + ((size_t)(head * 64 + vd) * T + s0 + vch * 8) * 2);
#define KLD0(t) (*(const u32x4*)(ws + (ko0 + (unsigned)(t) * kst0)))
#define KLD1(t) (*(const u32x4*)(ws + (ko1 + (unsigned)(t) * kst1)))
#define VLD(t) (*(const u32x4*)(ws + (vo + (unsigned)(t) * 128u)))
        const int kd0 = kr0 * KROW + kp0 * 16, kd1 = kr1 * KROW + kp1 * 16, vdst = vd * VROW + vch * 16;
        u32x4 rk0, rk1 = {0u, 0u, 0u, 0u}, rv;
        rk0 = KLD0(0); if (tid < 256) rk1 = KLD1(0); rv = VLD(0);
        *(LAS u32x4*)(Kl + kd0) = rk0; if (tid < 256) *(LAS u32x4*)(Kl + kd1) = rk1; *(LAS u32x4*)(Vl + vdst) = rv;
        rk0 = KLD0(1); if (tid < 256) rk1 = KLD1(1);
        *(LAS u32x4*)(Kl + KTILE_B + kd0) = rk0; if (tid < 256) *(LAS u32x4*)(Kl + KTILE_B + kd1) = rk1;
        rk0 = KLD0(2); if (tid < 256) rk1 = KLD1(2); rv = VLD(1);
        __syncthreads();
        f32x16 o0, o1, negm, sc0, sc1; bf16x8 kf[12];
#pragma unroll
        for (int r = 0; r < 16; ++r) { o0[r] = 0.f; o1[r] = 0.f; negm[r] = 0.f; }
        float lsum = 0.f;
        { const LAS unsigned char* Kb = Kl + r32 * KROW + hi * 16;
#pragma unroll
          for (int d0 = 0; d0 < 6; ++d0) { kf[2 * d0] = *(const LAS bf16x8*)(Kb + d0 * 32); kf[2 * d0 + 1] = *(const LAS bf16x8*)(Kb + 32 * KROW + d0 * 32); }
#pragma unroll
          for (int d0 = 0; d0 < 6; ++d0) {
              sc0 = __builtin_amdgcn_mfma_f32_32x32x16_bf16(kf[2 * d0], qf[d0], d0 == 0 ? negm : sc0, 0, 0, 0);
              sc1 = __builtin_amdgcn_mfma_f32_32x32x16_bf16(kf[2 * d0 + 1], qf[d0], d0 == 0 ? negm : sc1, 0, 0, 0); }
          float rm = fmaxf(fmaxf(sc0[0], sc0[1]), sc1[0]);
#pragma unroll
          for (int r = 2; r < 16; r += 2) rm = fmaxf(fmaxf(rm, sc0[r]), sc0[r + 1]);
#pragma unroll
          for (int r = 1; r < 15; r += 2) rm = fmaxf(fmaxf(rm, sc1[r]), sc1[r + 1]);
          rm = fmaxf(rm, sc1[15]);
          rm = fmaxf(rm, __shfl_xor(rm, 32));
#pragma unroll
          for (int r = 0; r < 16; ++r) { sc0[r] -= rm; sc1[r] -= rm; negm[r] = -rm; }
          const LAS unsigned char* Kb1 = Kb + KTILE_B;
#pragma unroll
          for (int d0 = 0; d0 < 6; ++d0) { kf[2 * d0] = *(const LAS bf16x8*)(Kb1 + d0 * 32); kf[2 * d0 + 1] = *(const LAS bf16x8*)(Kb1 + 32 * KROW + d0 * 32); } }
        __syncthreads();
        int vb3 = 0;
#pragma unroll 2
        for (int kt = 0; kt < NTL; ++kt) {
            const int buf = kt & 1; const int vb3n = vb3 == 2 ? 0 : vb3 + 1;
            const int t3 = kt + 3 < NTL ? kt + 3 : NTL - 1, t2 = kt + 2 < NTL ? kt + 2 : NTL - 1;
            *(LAS u32x4*)(Kl + buf * KTILE_B + kd0) = rk0; if (tid < 256) *(LAS u32x4*)(Kl + buf * KTILE_B + kd1) = rk1;
            *(LAS u32x4*)(Vl + vb3n * VTILE_B + vdst) = rv;
            rk0 = KLD0(t3); if (tid < 256) rk1 = KLD1(t3);
            rv = VLD(t2);
            f32x16 sn0, sn1;
#pragma unroll
            for (int d0 = 0; d0 < 6; ++d0) {
                sn0 = __builtin_amdgcn_mfma_f32_32x32x16_bf16(kf[2 * d0], qf[d0], d0 == 0 ? negm : sn0, 0, 0, 0);
                sn1 = __builtin_amdgcn_mfma_f32_32x32x16_bf16(kf[2 * d0 + 1], qf[d0], d0 == 0 ? negm : sn1, 0, 0, 0); }
#pragma unroll
            for (int r = 0; r < 16; ++r) { sc0[r] = __builtin_amdgcn_exp2f(sc0[r]); sc1[r] = __builtin_amdgcn_exp2f(sc1[r]); }
#pragma unroll
            for (int r = 0; r < 16; ++r) { lsum += sc0[r]; asm volatile("" : "+v"(lsum)); lsum += sc1[r]; asm volatile("" : "+v"(lsum)); }
            float lchk = lsum;
            { auto rr = __builtin_amdgcn_permlane32_swap(__float_as_uint(lchk), __float_as_uint(lchk), false, false); lchk = fmaxf(__uint_as_float(rr[0]), __uint_as_float(rr[1])); }
            u32x4 pw[4];
            pw[0] = (u32x4){pk2(sc0[0], sc0[1]), pk2(sc0[2], sc0[3]), pk2(sc0[4], sc0[5]), pk2(sc0[6], sc0[7])};
            pw[1] = (u32x4){pk2(sc0[8], sc0[9]), pk2(sc0[10], sc0[11]), pk2(sc0[12], sc0[13]), pk2(sc0[14], sc0[15])};
            pw[2] = (u32x4){pk2(sc1[0], sc1[1]), pk2(sc1[2], sc1[3]), pk2(sc1[4], sc1[5]), pk2(sc1[6], sc1[7])};
            pw[3] = (u32x4){pk2(sc1[8], sc1[9]), pk2(sc1[10], sc1[11]), pk2(sc1[12], sc1[13]), pk2(sc1[14], sc1[15])};
            asm volatile("s_waitcnt lgkmcnt(0)" ::: "memory"); __builtin_amdgcn_s_barrier(); asm volatile("" ::: "memory");
            { const LAS unsigned char* Kb = Kl + buf * KTILE_B + r32 * KROW + hi * 16;
#pragma unroll
              for (int d0 = 0; d0 < 6; ++d0) { kf[2 * d0] = *(const LAS bf16x8*)(Kb + d0 * 32); kf[2 * d0 + 1] = *(const LAS bf16x8*)(Kb + 32 * KROW + d0 * 32); } }
            { const LAS unsigned char* Vb = Vl + vb3 * VTILE_B + r32 * VROW + hi * 16;
#pragma unroll
              for (int h2 = 0; h2 < 2; ++h2) { bf16x8 vf[4];
#pragma unroll
                  for (int s = 0; s < 2; ++s) { vf[2 * s] = *(const LAS bf16x8*)(Vb + (2 * h2 + s) * 32); vf[2 * s + 1] = *(const LAS bf16x8*)(Vb + 32 * VROW + (2 * h2 + s) * 32); }
#pragma unroll
                  for (int s = 0; s < 2; ++s) {
                      const bf16x8 pb = __builtin_bit_cast(bf16x8, pw[2 * h2 + s]);
                      o0 = __builtin_amdgcn_mfma_f32_32x32x16_bf16(vf[2 * s], pb, o0, 0, 0, 0);
                      o1 = __builtin_amdgcn_mfma_f32_32x32x16_bf16(vf[2 * s + 1], pb, o1, 0, 0, 0); } } }
            if (__any(lchk > 1.0e12f)) {
                const float dl = fmaxf(floorf(__builtin_amdgcn_logf(lchk)), 0.f); const float f = __builtin_amdgcn_exp2f(-dl);
                lsum *= f; const float nm = negm[0] - dl;
#pragma unroll
                for (int r = 0; r < 16; ++r) { sn0[r] -= dl; sn1[r] -= dl; o0[r] *= f; o1[r] *= f; negm[r] = nm; }
            }
            sc0 = sn0; sc1 = sn1; vb3 = vb3n;
        }
        __syncthreads();
        lsum += __shfl_xor(lsum, 32);
        const float inv = 1.0f / lsum;
        bf16_t* orow = z + (size_t)qrow * LZ + ZATT + head * 64;
        float sq = 0.f;
#pragma unroll
        for (int rq = 0; rq < 4; ++rq) {
            const float a0 = o0[4 * rq] * inv, a1 = o0[4 * rq + 1] * inv, a2 = o0[4 * rq + 2] * inv, a3 = o0[4 * rq + 3] * inv;
            const float b0 = o1[4 * rq] * inv, b1 = o1[4 * rq + 1] * inv, b2 = o1[4 * rq + 2] * inv, b3 = o1[4 * rq + 3] * inv;
            sq += (a0 * a0 + a1 * a1) + (a2 * a2 + a3 * a3) + (b0 * b0 + b1 * b1) + (b2 * b2 + b3 * b3);
            u32x2 w0, w1; w0.x = pk2(a0, a1); w0.y = pk2(a2, a3); w1.x = pk2(b0, b1); w1.y = pk2(b2, b3);
            *(u32x2*)(orow + 8 * rq + 4 * hi) = w0; *(u32x2*)(orow + 32 + 8 * rq + 4 * hi) = w1;
        }
        sq += __shfl_xor(sq, 32);
        if (hi == 0) ssq[(size_t)qrow * 8 + head] = sq;
    }
    __builtin_amdgcn_s_setprio(0);
}

#define XB_TMO      128
#define XB_XCNT(j)  (256  + 64 * (j))
#define XB_XSUB(j)  (1280 + 64 * (j))
#define XB_XGEN(j)  (2304 + 64 * (j))
#define XB_TOP      3328
#define XB_TOPGEN   3392
#define XCD_BAR_WORDS 3456
#define XB_SPIN_CAP (1u << 18)

__device__ __forceinline__ unsigned xb_ld(unsigned* p)              { return __hip_atomic_load(p, __ATOMIC_RELAXED, __HIP_MEMORY_SCOPE_AGENT); }
__device__ __forceinline__ unsigned xb_add(unsigned* p, unsigned v) { return __hip_atomic_fetch_add(p, v, __ATOMIC_RELAXED, __HIP_MEMORY_SCOPE_AGENT); }
__device__ __forceinline__ unsigned xb_xcc_id() { return (unsigned)__builtin_amdgcn_s_getreg((3 << 11) | 20) & 0xFu; }
#define XB_SPIN(cond, bar) do { unsigned _sp = 0; while (cond) { __builtin_amdgcn_s_sleep(1); \
    if ((++_sp & 255u) == 0u) { if (xb_ld(&(bar)[XB_TMO])) break; if (_sp > XB_SPIN_CAP) { atomicAdd(&(bar)[XB_TMO], 1u); break; } } } } while (0)

struct XcdBarrier {
    unsigned* bar; unsigned x;
    volatile LAS unsigned* st;
};

__device__ __forceinline__ XcdBarrier xcd_barrier_post(unsigned* bar, volatile LAS unsigned* st, const bool t0  ) {
    XcdBarrier b; b.bar = bar; b.x = xb_xcc_id(); b.st = st;
    if (t0) (void)xb_add(&bar[XB_XCNT(b.x)], 1u);
    return b;
}
__device__ __forceinline__ void xcd_barrier_complete(unsigned* bar, unsigned x, unsigned& nloc, unsigned& nx) {
    const unsigned G = gridDim.x * gridDim.y * gridDim.z;
    unsigned sum, cnt, mine, sp = 0u;
    for (;;) {
        sum = 0u; cnt = 0u; mine = 0u;
#pragma unroll
        for (unsigned j = 0; j < 16; ++j) { const unsigned c = xb_ld(&bar[XB_XCNT(j)]); sum += c; cnt += (c > 0u) ? 1u : 0u; mine = (j == x) ? c : mine; }
        if (sum == G) break;
        __builtin_amdgcn_s_sleep(1);
        if ((++sp & 255u) == 0u) { if (xb_ld(&bar[XB_TMO])) break; if (sp > XB_SPIN_CAP) { atomicAdd(&bar[XB_TMO], 1u); break; } }
    }
    nloc = mine > 0u ? mine : 1u; nx = cnt > 0u ? cnt : 1u;
}

__device__ __forceinline__ void xcd_barrier(const XcdBarrier& b, const int wv) {
    asm volatile("s_waitcnt vmcnt(0)" ::: "memory");
    __syncthreads();
    if (wv == 0 && (int)__builtin_amdgcn_mbcnt_hi(~0u, __builtin_amdgcn_mbcnt_lo(~0u, 0u)) == 0) {
        unsigned* bar = b.bar; unsigned bx = b.x; asm volatile("" : "+s"(bx));
        __builtin_amdgcn_s_waitcnt(0);
        unsigned nloc = b.st[0], nx = b.st[1];
        if (nloc == 0u) { xcd_barrier_complete(bar, bx, nloc, nx); b.st[0] = nloc; b.st[1] = nx; }
        const unsigned old = xb_add(&bar[XB_XSUB(bx)], 1u);
        const unsigned gen = old / nloc;
        if (old + 1u == (gen + 1u) * nloc) {
            __builtin_amdgcn_fence(__ATOMIC_RELEASE, "agent");
            asm volatile("s_waitcnt vmcnt(0)" ::: "memory");
            const unsigned og = xb_add(&bar[XB_TOP], 1u);
            const unsigned tg = og / nx;
            if (og + 1u == (tg + 1u) * nx) xb_add(&bar[XB_TOPGEN], 1u);
            else XB_SPIN(xb_ld(&bar[XB_TOPGEN]) == tg, bar);
            __builtin_amdgcn_fence(__ATOMIC_ACQUIRE, "agent");
            xb_add(&bar[XB_XGEN(bx)], 1u);
            asm volatile("s_waitcnt vmcnt(0)" ::: "memory");
        } else {
            XB_SPIN(xb_ld(&bar[XB_XGEN(bx)]) == gen, bar);
            __builtin_amdgcn_fence(__ATOMIC_ACQUIRE, "agent");
            asm volatile("s_waitcnt vmcnt(0)" ::: "memory");
        }
    }
    __syncthreads();
}

__global__ void __launch_bounds__(512, 2) fwd_kernel(Args a) {
    __shared__ __attribute__((aligned(16))) unsigned char lds_raw[LDS_BYTES];
    cg::grid_group grid = cg::this_grid();
    LAS unsigned char* lds = (LAS unsigned char*)lds_raw;
    const int wv = __builtin_amdgcn_readfirstlane((int)threadIdx.x >> 6);
    const bool t0 = wv == 0 && (int)__builtin_amdgcn_mbcnt_hi(~0u, __builtin_amdgcn_mbcnt_lo(~0u, 0u)) == 0;
    unsigned char* ws = a.ws;

    if (t0) { LAS long long* tab = (LAS long long*)(lds + TAB_OFF); ((LAS unsigned*)(lds + TAB_OFF + 224))[0] = 0u; ((LAS unsigned*)(lds + TAB_OFF + 224))[1] = 0u;
        tab[0] = (long long)((const unsigned char*)a.in[0] - (const unsigned char*)a.ws);
        tab[1] = (long long)((const unsigned char*)a.in[1] - (const unsigned char*)a.ws);
        tab[2] = (long long)((const unsigned char*)a.in[2] - (const unsigned char*)a.ws);
        tab[3] = (long long)((const unsigned char*)a.in[3] - (const unsigned char*)a.ws);
        tab[4] = (long long)((const unsigned char*)a.in[4] - (const unsigned char*)a.ws);
        tab[5] = (long long)((const unsigned char*)a.in[5] - (const unsigned char*)a.ws);
        tab[6] = (long long)((const unsigned char*)a.in[6] - (const unsigned char*)a.ws);
        tab[7] = (long long)((const unsigned char*)a.in[7] - (const unsigned char*)a.ws);
        tab[8] = (long long)((const unsigned char*)a.in[8] - (const unsigned char*)a.ws);
        tab[9] = (long long)((const unsigned char*)a.in[9] - (const unsigned char*)a.ws);
        tab[10] = (long long)((const unsigned char*)a.in[10] - (const unsigned char*)a.ws);
        tab[11] = (long long)((const unsigned char*)a.in[11] - (const unsigned char*)a.ws);
        tab[12] = (long long)((const unsigned char*)a.in[12] - (const unsigned char*)a.ws);
        tab[13] = (long long)((const unsigned char*)a.in[13] - (const unsigned char*)a.ws);
        tab[14] = (long long)((const unsigned char*)a.in[14] - (const unsigned char*)a.ws);
        tab[15] = (long long)((const unsigned char*)a.in[15] - (const unsigned char*)a.ws);
        tab[16] = (long long)((const unsigned char*)a.in[16] - (const unsigned char*)a.ws);
        tab[17] = (long long)((const unsigned char*)a.in[17] - (const unsigned char*)a.ws);
        tab[18] = (long long)((const unsigned char*)a.in[18] - (const unsigned char*)a.ws);
        tab[19] = (long long)((const unsigned char*)a.in[19] - (const unsigned char*)a.ws);
        tab[20] = (long long)((const unsigned char*)a.in[20] - (const unsigned char*)a.ws);
        tab[21] = (long long)((const unsigned char*)a.in[21] - (const unsigned char*)a.ws);
        tab[22] = (long long)((const unsigned char*)a.in[22] - (const unsigned char*)a.ws);
        tab[23] = (long long)((const unsigned char*)a.in[23] - (const unsigned char*)a.ws);
    }
    __syncthreads();
    const XcdBarrier bar = xcd_barrier_post((unsigned*)ws, (volatile LAS unsigned*)(lds + TAB_OFF + 224), t0);
    float* const xout = a.out;
#define WSL(w) size_t w##_z = 0; asm volatile("" : "+s"(w##_z)); unsigned char* w = ws + w##_z
#define HB(w) ((bf16_t*)((w) + WS_H))
#define ZB(w) ((bf16_t*)((w) + WS_Z))
#define MODP(w) ((const float*)((w) + WS_MOD))
    p0_phase(ws, lds, wv);
    grid.sync();
    { WSL(w); RowArgs ra{nullptr, INP(0), INP(1), nullptr, nullptr, nullptr, INP(6), MODP(w) + 1024, MODP(w), HB(w), nullptr, 0, DM}; row_phase<false, true, false, true>(ra, wv); }
    xcd_barrier(bar, wv);
#pragma unroll 1
    for (int l = 0; l < NLAYER; ++l) {
        { WSL(w); int Gl = gridDim.x, bl = blockIdx.x; asm volatile("" : "+s"(Gl), "+s"(bl));
          pg8::Gemm g{HB(w), (const bf16_t*)(w + WS_W + (size_t)l * WL + OW_IN), T, NIN, 1024, 1024}; pg8::StaticOrder S; S.init(T, NIN, Gl, bl);
          pg8::EpiStore<false> E{ZB(w), LZ, LZ, nullptr}; pg8::gemm_phase<pg8::EpiStore<false>, pg8::StaticOrder, true, true>(lds, g, S, E, wv); }
        xcd_barrier(bar, wv);
        { WSL(w); mid_phase(w, l, lds, wv); }
        xcd_barrier(bar, wv);
        { WSL(w); int Gl = gridDim.x, bl = blockIdx.x; asm volatile("" : "+s"(Gl), "+s"(bl));
          pg8::Gemm g{ZB(w) + ZQ, (const bf16_t*)(w + WS_W + (size_t)l * WL + OW_QB), T, 768, 384, LZ}; pg8::StaticOrder S; S.init(T, 768, Gl, bl);
          pg8::EpiQ E{HB(w), (const float*)(w + WS_ROPE), (const float*)(w + WS_SSQ)}; pg8::gemm_phase<pg8::EpiQ, pg8::StaticOrder, true, true>(lds, g, S, E, wv); }
        { WSL(w); int Gl = gridDim.x, bl = blockIdx.x; asm volatile("" : "+s"(Gl), "+s"(bl));
          pg8::Gemm g{ZB(w) + ZKV, (const bf16_t*)(w + WS_W + (size_t)l * WL + OW_KVB), T, 1024, 256, LZ}; pg8::StaticOrder S; S.init(T, 1024, Gl, bl);
          pg8::EpiKV E{ZB(w) + ZV, (bf16_t*)(w + WS_VT), (const float*)(w + WS_SSQ) + T}; pg8::gemm_phase<pg8::EpiKV, pg8::StaticOrder, true, true>(lds, g, S, E, wv); }
        xcd_barrier(bar, wv);
        { WSL(w); attn_phase(w, lds, wv); }
        xcd_barrier(bar, wv);
        { WSL(w); int Gl = gridDim.x, bl = blockIdx.x; asm volatile("" : "+s"(Gl), "+s"(bl));
          pg8::Gemm g{ZB(w) + ZATT, (const bf16_t*)(w + WS_W + (size_t)l * WL + OW_OUT), T, 1024, 1024, LZ}; pg8::StaticOrder S; S.init(T, 1024, Gl, bl);
          pg8::EpiStore<true> E{HB(w), DM, DM, (const float*)(w + WS_SSQ)}; pg8::gemm_phase<pg8::EpiStore<true>, pg8::StaticOrder, true, true>(lds, g, S, E, wv); }
        xcd_barrier(bar, wv);
        { WSL(w); const float* modl = MODP(w) + (size_t)l * NCR * NMODC;
          RowArgs ra{HB(w), INP(0), INP(1), nullptr, INP(7) + l * DM, modl + 2048, INP(8) + l * DM, modl + 4096, modl + 3072, EB(xout), (unsigned char*)xout, DM, 2048};
          if (l == 0) row_phase<true, true, false, true>(ra, wv); else row_phase<true, true, true, true>(ra, wv); }
        xcd_barrier(bar, wv);
        { WSL(w); int Gl = gridDim.x, bl = blockIdx.x; asm volatile("" : "+s"(Gl), "+s"(bl));
          pg8::Gemm g{EB(xout), (const bf16_t*)(w + WS_W + (size_t)l * WL + OW_GU), T, NGU, 1024, 2048}; pg8::StaticOrder S; S.init(T, NGU, Gl, bl);
          pg8::EpiGU E{HB(w)}; pg8::gemm_phase<pg8::EpiGU, pg8::StaticOrder, true, true>(lds, g, S, E, wv); }
        xcd_barrier(bar, wv);
        { WSL(w); int Gl = gridDim.x, bl = blockIdx.x; asm volatile("" : "+s"(Gl), "+s"(bl));
          pg8::Gemm g{HB(w), (const bf16_t*)(w + WS_W + (size_t)l * WL + OW_D), T, 1024, DFF, DFF}; pg8::StaticOrder S; S.init(T, 1024, Gl, bl);
          pg8::EpiStore<false> E{EB(xout), 2048, DM, nullptr}; pg8::gemm_phase<pg8::EpiStore<false>, pg8::StaticOrder, true, true>(lds, g, S, E, wv); }
        xcd_barrier(bar, wv);
        if (l + 1 < NLAYER) {
            WSL(w); const float* modl = MODP(w) + (size_t)l * NCR * NMODC; const float* modn = modl + NCR * NMODC;
            RowArgs ra{EB(xout), nullptr, nullptr, nullptr, INP(9) + l * DM, modl + 5120, INP(6) + (l + 1) * DM, modn + 1024, modn, HB(w), (unsigned char*)xout, 2048, DM};
            row_phase<true, true, true, true>(ra, wv);
            xcd_barrier(bar, wv);
        } else {
            WSL(w); const float* modl = MODP(w) + (size_t)l * NCR * NMODC;
            RowArgs ra{EB(xout), nullptr, nullptr, xout, INP(9) + l * DM, modl + 5120, nullptr, nullptr, nullptr, nullptr, (unsigned char*)xout, 2048, 0};
            row_phase<true, false, true, false>(ra, wv);
        }
    }
}

extern "C" void kernel_launch(void* const* d_in, const int* in_sizes, int n_in, void* d_out, int out_size, void* d_ws, size_t ws_size, hipStream_t stream) {
    static int grid = 0;
    if (grid == 0) {
        if (n_in != 24 || out_size != T * DM || ws_size < WS_END) { fprintf(stderr, "kernel_launch: unexpected problem (n_in %d out %d ws %zu)\n", n_in, out_size, ws_size); grid = -1; return; }
        int dev = 0, cus = 0, per_cu = 0;
        hipGetDevice(&dev); hipDeviceGetAttribute(&cus, hipDeviceAttributeMultiprocessorCount, dev);
        hipOccupancyMaxActiveBlocksPerMultiprocessor(&per_cu, (const void*)fwd_kernel, 512, 0);
        if (per_cu < 1) per_cu = 1;
        grid = cus * per_cu;
        fprintf(stderr, "kernel_launch: grid %d (cus %d x %d)\n", grid, cus, per_cu);
    }
    if (grid < 0) return;
    if (hipMemsetAsync(d_ws, 0, 16384, stream) != hipSuccess) { fprintf(stderr, "kernel_launch: memset failed\n"); return; }
    Args a{};
    for (int i = 0; i < 24; ++i) a.in[i] = (const float*)d_in[i];
    a.out = (float*)d_out; a.ws = (unsigned char*)d_ws;
    void* args[] = {&a};
    hipError_t e = hipLaunchCooperativeKernel((const void*)fwd_kernel, dim3(grid), dim3(512), args, 0, stream);
    if (e != hipSuccess) fprintf(stderr, "cooperative launch failed: %s (grid %d)\n", hipGetErrorString(e), grid);
}
```

```cpp
#include <hip/hip_runtime.h>
#include <hip/hip_cooperative_groups.h>
#include <cstdio>
#include <cstdint>
namespace cg = cooperative_groups;
namespace pg8 {
#define PG8_LAS __attribute__((address_space(3)))
typedef unsigned short bf16_t;
typedef short bf16x8 __attribute__((ext_vector_type(8)));
typedef float f32x4 __attribute__((ext_vector_type(4)));
typedef unsigned u32x4 __attribute__((ext_vector_type(4)));
constexpr int BM = 256, BK = 64, HALF = 128, HTB = HALF * BK * 2  , STAGE_BYTES = 8 * HTB, NXCD = 8, WGM = 8;

__host__ __device__ __forceinline__ int lds_byte(int r, int c) { const int st = (r >> 4) * 2 + (c >> 5), rr = r & 15, cc = c & 31, ob = rr * 64 + cc * 2; return st * 1024 + (ob ^ (((ob >> 9) & 1) << 5)); }
__host__ __device__ __forceinline__ void stage_rc(int b, int& R, int& C) { const int st = b / 1024, sb = b % 1024, swz = sb ^ (((sb >> 9) & 1) << 5); R = (st >> 1) * 16 + swz / 64; C = (st & 1) * 32 + (swz % 64) / 2; }
__host__ __device__ __forceinline__ int perm32(int rho) { const int n = rho >> 4, i = rho & 15; return 8 * (i >> 2) + 4 * n + (i & 3); }

struct Unit { int pm, pn; };
struct Gemm { const bf16_t* A; const bf16_t* Bt; int M, N, K, lda; };

struct StaticOrder {
    int nM, nN, nwg, G, c;
    __host__ __device__ void init(int M, int N, int G_, int c_) { nM = M / BM; nN = N / BM; nwg = nM * nN; G = G_; c = c_; }
    __host__ __device__ bool next(int i, Unit& u) const {
        const long L = (long)i * G + c; if (L >= nwg) return false;
        int wgid = (int)L; { const int q = nwg / NXCD, r = nwg % NXCD, xcd = wgid % NXCD, off = wgid / NXCD; wgid = (xcd < r ? xcd * (q + 1) : r * (q + 1) + (xcd - r) * q) + off; }
        const int nig = WGM * nN, gid = wgid / nig, fm = gid * WGM, gsz = (nM - fm) < WGM ? (nM - fm) : WGM;
        u.pm = fm + ((wgid % nig) % gsz); u.pn = (wgid % nig) / gsz; return true;
    }
    __device__ __forceinline__ void a_ready(const Unit&) const {}
    __device__ __forceinline__ void done(const Unit&) const {}
};

__device__ __forceinline__ unsigned cvt_pk_bf16(float lo, float hi) { unsigned r; asm volatile("v_cvt_pk_bf16_f32 %0, %1, %2" : "=v"(r) : "v"(lo), "v"(hi)); return r; }
typedef float f32x2 __attribute__((ext_vector_type(2)));
template <class Epi, class Sched, bool ALIGN_EPI = false, bool SP2 = false>
__device__ __forceinline__ void gemm_phase(PG8_LAS unsigned char* lds, const Gemm g, const Sched& S, const Epi& E, const int wv  ) {
    int tid0_ = wv * 64 + (int)__builtin_amdgcn_mbcnt_hi(~0u, __builtin_amdgcn_mbcnt_lo(~0u, 0u)); asm volatile("" : "+v"(tid0_));
    const int tid = tid0_, wid = __builtin_amdgcn_readfirstlane(tid >> 6), lane = tid & 63, wr = wid >> 2, wc = wid & 3, fr = lane & 15, fq = lane >> 4;
    const int K = g.K, nt = K / BK;
    unsigned voffA[2], voffB[2];
#pragma unroll
    for (int i = 0; i < 2; ++i) { int R, C; stage_rc(tid * 16 + i * 8192, R, C); const int Rb = Epi::PERM ? ((R & ~31) + perm32(R & 31)) : R;
        voffA[i] = (unsigned)(R * g.lda + C) * 2u; voffB[i] = (unsigned)(Rb * K + C) * 2u; }
    const size_t kstep = (size_t)(BK * 2);
    const size_t hstepB = (size_t)HALF * K * 2, hstepA = (size_t)HALF * g.lda * 2;
    const size_t tstepB = 2 * hstepB, tstepA = 2 * hstepA;
    const unsigned ldsw = (unsigned)wid * 1024u;
    const int aoff = lds_byte(wr * 64 + fr, fq * 8), boff = lds_byte(wc * 32 + fr, fq * 8);
#define PG8_SA(b, h) (((b) * 2 + (h)) * HTB)
#define PG8_SB(b, h) ((4 + (b) * 2 + (h)) * HTB)
#define PG8_STAGE(bufoff, gbase, voff) do { _Pragma("unroll") for (int _i = 0; _i < 2; ++_i) \
        __builtin_amdgcn_global_load_lds((const unsigned*)((const char*)(gbase) + (voff)[_i]), (PG8_LAS unsigned*)(lds + (bufoff) + ldsw + _i * 8192), 16, 0, 0); } while (0)
#define PG8_LDA(dst, b, h) do { _Pragma("unroll") for (int m = 0; m < 4; ++m) _Pragma("unroll") for (int k = 0; k < 2; ++k) dst[m][k] = *(const PG8_LAS bf16x8*)(lds + PG8_SA(b, h) + aoff + m * 2048 + k * 1024); } while (0)
#define PG8_LDB(dst, b, h) do { _Pragma("unroll") for (int n = 0; n < 2; ++n) _Pragma("unroll") for (int k = 0; k < 2; ++k) dst[n][k] = *(const PG8_LAS bf16x8*)(lds + PG8_SB(b, h) + boff + n * 2048 + k * 1024); } while (0)
#define PG8_MMA(ai, bj, At, Bt) do { __builtin_amdgcn_s_setprio(1); _Pragma("unroll") for (int m = 0; m < 4; ++m) _Pragma("unroll") for (int n = 0; n < 2; ++n) _Pragma("unroll") for (int k = 0; k < 2; ++k) \
        acc[ai][bj][m][n] = __builtin_amdgcn_mfma_f32_16x16x32_bf16(Bt[n][k], At[m][k], acc[ai][bj][m][n], 0, 0, 0); __builtin_amdgcn_s_setprio(0); } while (0)
#define PG8_WAIT_V(n) asm volatile("s_waitcnt vmcnt(" #n ")" ::: "memory")
#define PG8_WAIT_L(n) asm volatile("s_waitcnt lgkmcnt(" #n ")" ::: "memory")
#define PG8_BAR __builtin_amdgcn_s_barrier()
#define PG8_SCHED __builtin_amdgcn_sched_barrier(0)
    Unit cur, nxt; int ui = 0;
    if (!S.next(0, cur)) return;
    f32x4 acc[2][2][4][2];
#pragma unroll
    for (int a = 0; a < 2; ++a)
#pragma unroll
        for (int b = 0; b < 2; ++b)
#pragma unroll
            for (int m = 0; m < 4; ++m)
#pragma unroll
                for (int n = 0; n < 2; ++n) acc[a][b][m][n] = (f32x4){0.f, 0.f, 0.f, 0.f};
    bf16x8 At[4][2], B0[2][2], B1[2][2];
    const char* cA = (const char*)g.A + (size_t)cur.pm * tstepA; const char* cB = (const char*)g.Bt + (size_t)cur.pn * tstepB;
    S.a_ready(cur);
    if constexpr (SP2) {
        PG8_STAGE(PG8_SB(0, 0), cB, voffB); PG8_STAGE(PG8_SB(0, 1), cB + hstepB, voffB); PG8_STAGE(PG8_SA(0, 0), cA, voffA); PG8_STAGE(PG8_SA(0, 1), cA + hstepA, voffA);
        if (wr == 1) PG8_BAR;
        PG8_WAIT_V(2); PG8_BAR;
        PG8_STAGE(PG8_SB(1, 0), cB + kstep, voffB); PG8_STAGE(PG8_SA(1, 0), cA + kstep, voffA); PG8_STAGE(PG8_SB(1, 1), cB + hstepB + kstep, voffB);
        PG8_WAIT_V(6); PG8_BAR;
    } else {
        PG8_STAGE(PG8_SB(0, 0), cB, voffB); PG8_STAGE(PG8_SA(0, 0), cA, voffA); PG8_STAGE(PG8_SB(0, 1), cB + hstepB, voffB); PG8_STAGE(PG8_SA(0, 1), cA + hstepA, voffA);
        if (wr == 1) PG8_BAR;
        PG8_WAIT_V(4); PG8_BAR;
        PG8_STAGE(PG8_SB(1, 0), cB + kstep, voffB); PG8_STAGE(PG8_SA(1, 0), cA + kstep, voffA); PG8_STAGE(PG8_SB(1, 1), cB + hstepB + kstep, voffB);
        PG8_WAIT_V(6); PG8_BAR;
    }
    for (;;) {
        const bool has_next = S.next(ui + 1, nxt);
        const char* nA = has_next ? (const char*)g.A + (size_t)nxt.pm * tstepA : cA; const char* nB = has_next ? (const char*)g.Bt + (size_t)nxt.pn * tstepB : cB;
#pragma unroll 1
        for (int t = 0; t < nt; t += 2) {
            const bool last = (t == nt - 2);
            if constexpr (Epi::MIDK) { if (t == 8) E.midk(acc, cur, wr, fr); }
            const char* a1 = cA + (size_t)(t + 1) * kstep;
            const char* a2 = last ? nA : cA + (size_t)(t + 2) * kstep; const char* b2 = last ? nB : cB + (size_t)(t + 2) * kstep;
            const char* a3 = a2 + kstep; const char* b3 = b2 + kstep;
            if (last && has_next) S.a_ready(nxt);
            if constexpr (SP2) {
            PG8_LDB(B0, 0, 0); PG8_LDB(B1, 0, 1); PG8_SCHED; PG8_LDA(At, 0, 0); PG8_STAGE(PG8_SA(1, 1), a1 + hstepA, voffA);
            PG8_WAIT_V(8); PG8_WAIT_L(0); PG8_BAR; PG8_MMA(0, 0, At, B0); PG8_MMA(0, 1, At, B1); PG8_BAR; PG8_SCHED;
            PG8_LDA(At, 0, 1); PG8_STAGE(PG8_SB(0, 0), b2, voffB); PG8_STAGE(PG8_SB(0, 1), b2 + hstepB, voffB); PG8_STAGE(PG8_SA(0, 0), a2, voffA);
            PG8_WAIT_V(8); PG8_WAIT_L(0); PG8_BAR; PG8_MMA(1, 0, At, B0); PG8_MMA(1, 1, At, B1); PG8_BAR; PG8_SCHED;
            PG8_LDB(B0, 1, 0); PG8_LDB(B1, 1, 1); PG8_SCHED; PG8_LDA(At, 1, 0); PG8_STAGE(PG8_SA(0, 1), a2 + hstepA, voffA);
            PG8_WAIT_V(8); PG8_WAIT_L(0); PG8_BAR; PG8_MMA(0, 0, At, B0); PG8_MMA(0, 1, At, B1); PG8_BAR; PG8_SCHED;
            PG8_LDA(At, 1, 1); PG8_STAGE(PG8_SB(1, 0), b3, voffB); PG8_STAGE(PG8_SB(1, 1), b3 + hstepB, voffB); PG8_STAGE(PG8_SA(1, 0), a3, voffA);
            PG8_WAIT_V(8); PG8_WAIT_L(0); PG8_BAR; PG8_MMA(1, 0, At, B0); PG8_MMA(1, 1, At, B1); PG8_BAR; PG8_SCHED;
            } else {
            PG8_LDB(B0, 0, 0); PG8_SCHED; PG8_LDA(At, 0, 0); PG8_STAGE(PG8_SA(1, 1), a1 + hstepA, voffA);
            PG8_WAIT_L(8); PG8_BAR; PG8_WAIT_L(0); PG8_MMA(0, 0, At, B0); PG8_BAR; PG8_SCHED;
            PG8_LDB(B1, 0, 1); PG8_STAGE(PG8_SB(0, 0), b2, voffB);
            PG8_BAR; PG8_WAIT_L(0); PG8_MMA(0, 1, At, B1); PG8_BAR;
            PG8_LDA(At, 0, 1); PG8_STAGE(PG8_SA(0, 0), a2, voffA);
            PG8_BAR; PG8_WAIT_L(0); PG8_MMA(1, 0, At, B0); PG8_BAR; PG8_SCHED;
            PG8_STAGE(PG8_SB(0, 1), b2 + hstepB, voffB);
            PG8_WAIT_V(6); PG8_BAR; PG8_MMA(1, 1, At, B1); PG8_BAR;
            PG8_LDB(B0, 1, 0); PG8_SCHED; PG8_LDA(At, 1, 0); PG8_STAGE(PG8_SA(0, 1), a2 + hstepA, voffA);
            PG8_WAIT_L(8); PG8_BAR; PG8_WAIT_L(0); PG8_MMA(0, 0, At, B0); PG8_BAR; PG8_SCHED;
            PG8_LDB(B1, 1, 1); PG8_STAGE(PG8_SB(1, 0), b3, voffB);
            PG8_BAR; PG8_WAIT_L(0); PG8_MMA(0, 1, At, B1); PG8_BAR;
            PG8_LDA(At, 1, 1); PG8_STAGE(PG8_SA(1, 0), a3, voffA);
            PG8_BAR; PG8_WAIT_L(0); PG8_MMA(1, 0, At, B0); PG8_BAR; PG8_SCHED;
            PG8_STAGE(PG8_SB(1, 1), b3 + hstepB, voffB);
            PG8_WAIT_V(6); PG8_BAR; PG8_MMA(1, 1, At, B1); PG8_BAR;
            }
        }
        if constexpr (ALIGN_EPI) { if (wr == 0) PG8_BAR; }
        if constexpr (!Epi::AFTER_DRAIN) { E(acc, cur, wr, wc, fr, fq); S.done(cur); }
        if (!has_next) break;
#pragma unroll
        for (int a = 0; a < 2; ++a)
#pragma unroll
            for (int b = 0; b < 2; ++b)
#pragma unroll
                for (int m = 0; m < 4; ++m)
#pragma unroll
                    for (int n = 0; n < 2; ++n) acc[a][b][m][n] = (f32x4){0.f, 0.f, 0.f, 0.f};
        cur = nxt; cA = nA; cB = nB; ++ui;
        if constexpr (ALIGN_EPI) { if (wr == 1) PG8_BAR; }
    }
    PG8_WAIT_V(0);
    if constexpr (!ALIGN_EPI) { if (wr == 0) PG8_BAR; }
    PG8_BAR;
    if constexpr (Epi::AFTER_DRAIN) { E.fused(acc, cur, wr, wc, fr, fq, lds, wid, lane); S.done(cur); }
#undef PG8_SA
#undef PG8_SB
#undef PG8_STAGE
#undef PG8_LDA
#undef PG8_LDB
#undef PG8_MMA
#undef PG8_WAIT_V
#undef PG8_WAIT_L
#undef PG8_BAR
#undef PG8_SCHED
}
}

#define LAS __attribute__((address_space(3)))
using pg8::bf16_t; using pg8::bf16x8; using pg8::f32x4; using pg8::u32x4;
typedef float f32x16 __attribute__((ext_vector_type(16)));
typedef float f32x2v __attribute__((ext_vector_type(2)));
typedef __bf16 bf16x2v __attribute__((ext_vector_type(2)));
typedef unsigned u32x2 __attribute__((ext_vector_type(2)));

constexpr int T = 32768, TP = 16384, DM = 1024, NLAYER = 2, NCR = 10, NMODC = 6144;
constexpr int INC = 1696, LZ = 1728, ZQ = 0, ZKV = 384, ZKR = 640, ZU = 704, ZV = 1216, ZATT = 192, NIN = 1792;
constexpr int DFF = 2816, NGU = 5632;
constexpr float EPS = 1e-6f;
constexpr float QSCALE = 0.10206207261596577f * 1.4426950408889634f;
constexpr size_t MiB = 1u << 20;
constexpr size_t WS_MOD = 512 * 1024, WS_ROPE = 1 * MiB, WS_SSQ = 2 * MiB, WS_W = 3 * MiB;
constexpr size_t OW_IN = 0, OW_QB = 3670016, OW_KVB = 4259840, OW_OUT = 4784128, OW_GU = 6881280, OW_D = 18415616, OW_S = 24182784, WL = 24444928;
constexpr size_t WS_H = 50 * MiB, WS_Z = 114 * MiB, WS_VT = 222 * MiB, WS_END = 254 * MiB;
static_assert(WS_Z + (size_t)32768 * LZ * 2 <= WS_VT, "z fits");
static_assert(WS_W + 2 * WL <= WS_H, "weights fit");
constexpr int LDS_BYTES = 147456;

struct Args { const float* in[24]; float* out; unsigned char* ws; };
constexpr int TAB_OFF = LDS_BYTES - 256;
typedef const float* cfptr;
#define GAS __attribute__((address_space(1)))
#define EB(xo) ((bf16_t*)((unsigned char*)(xo) + 2048))
#define INP(k) ((const float*)(ws + ((LAS long long*)(lds + TAB_OFF))[k]))

__device__ __forceinline__ float bf_lo(unsigned w) { return __uint_as_float(w << 16); }
__device__ __forceinline__ float bf_hi(unsigned w) { return __uint_as_float(w & 0xffff0000u); }
__device__ __forceinline__ unsigned pk2(float lo, float hi) { f32x2v v = {lo, hi}; bf16x2v b = __builtin_convertvector(v, bf16x2v); return __builtin_bit_cast(unsigned, b); }
__device__ __forceinline__ float wave_sum(float v) {
#pragma unroll
    for (int o = 1; o < 64; o <<= 1) v += __shfl_xor(v, o);
    return v;
}
__device__ __forceinline__ float gelu_tanh(float x) {
    const float u = 0.7978845608028654f * (x + 0.044715f * x * x * x);
    const float e = __builtin_amdgcn_exp2f(-2.8853900817779268f * u);
    return x * __builtin_amdgcn_rcpf(1.0f + e);
}
__device__ __forceinline__ float silu_f(float x) { return x * __builtin_amdgcn_rcpf(1.0f + __builtin_amdgcn_exp2f(-1.4426950408889634f * x)); }
__device__ __forceinline__ int tok_pos(int row) { return row < TP ? (row & 8191) : (row & 2047); }
__device__ __forceinline__ int tok_cr(int row) { return row < TP ? (row >> 13) : 2 + ((row - TP) >> 11); }

namespace pg8 {
template <bool MK> struct EpiStore {
    static constexpr bool PERM = true, AFTER_DRAIN = false, MIDK = MK;
    bf16_t* O; int ldc; int ncols; const float* ssq; int nt;
    __device__ __forceinline__ void operator()(const f32x4 (&acc)[2][2][4][2], const Unit& u, int wr, int wc, int fr, int fq) const {
        const int row0 = u.pm * BM + wr * 64 + fr, col0 = u.pn * BM + wc * 32 + 8 * fq;
#pragma unroll
        for (int ai = 0; ai < 2; ++ai)
#pragma unroll
            for (int m = 0; m < 4; ++m) { bf16_t* rowp = O + (size_t)(row0 + ai * HALF + m * 16) * ldc + col0;
#pragma unroll
                for (int bj = 0; bj < 2; ++bj) if (col0 + bj * HALF < ncols) { const f32x4 v0 = acc[ai][bj][m][0], v1 = acc[ai][bj][m][1];
                    u32x4 w; w.x = pk2(v0[0], v0[1]); w.y = pk2(v0[2], v0[3]); w.z = pk2(v1[0], v1[1]); w.w = pk2(v1[2], v1[3]);
                    if (nt) __builtin_nontemporal_store(w, (u32x4*)(rowp + bj * HALF)); else *(u32x4*)(rowp + bj * HALF) = w; } }
    }
    __device__ __forceinline__ void midk(f32x4 (&acc)[2][2][4][2], const Unit& u, int wr, int fr) const {
#pragma unroll
        for (int ai = 0; ai < 2; ++ai)
#pragma unroll
            for (int m = 0; m < 4; ++m) { int row = u.pm * BM + ai * HALF + wr * 64 + m * 16 + fr; asm volatile("" : "+v"(row) :: "memory"); const f32x4* p = (const f32x4*)(ssq + (size_t)row * 8);
                const f32x4 s0 = p[0], s1 = p[1]; const float s = ((s0[0] + s0[1]) + (s0[2] + s0[3])) + ((s1[0] + s1[1]) + (s1[2] + s1[3]));
                const float rs = rsqrtf(s * (1.0f / 512.0f) + EPS);
#pragma unroll
                for (int bj = 0; bj < 2; ++bj)
#pragma unroll
                    for (int n = 0; n < 2; ++n) acc[ai][bj][m][n] *= rs; }
    }
};
struct EpiQ {
    static constexpr bool PERM = false, AFTER_DRAIN = false, MIDK = false;
    bf16_t* Q; const float* rope; const float* rstd;
    __device__ __forceinline__ void midk(f32x4 (&)[2][2][4][2], const Unit&, int, int) const {}
    __device__ __forceinline__ void operator()(const f32x4 (&acc)[2][2][4][2], const Unit& u, int wr, int wc, int fr, int fq) const {
        const int G0 = 8 * u.pn + wc, part0 = G0 % 3, part1 = (G0 + 4) % 3;
#pragma unroll
        for (int ai = 0; ai < 2; ++ai)
#pragma unroll
            for (int m = 0; m < 4; ++m) { int row = u.pm * BM + ai * HALF + wr * 64 + m * 16 + fr; asm volatile("" : "+v"(row)); bf16_t* rp = Q + (size_t)row * 768 + 32 * G0 + 4 * fq;
                const float rs = rstd[row] * QSCALE;
                f32x4 cs = {1.f, 1.f, 1.f, 1.f}, sn = {0.f, 0.f, 0.f, 0.f};
                if (part0 == 2 || part1 == 2) { const f32x4* t = (const f32x4*)(rope + ((size_t)tok_pos(row) * 16 + 4 * fq) * 2); const f32x4 c0 = t[0], c1 = t[1];
                    cs = (f32x4){c0[0], c0[2], c1[0], c1[2]}; sn = (f32x4){c0[1], c0[3], c1[1], c1[3]}; }
#pragma unroll
                for (int bj = 0; bj < 2; ++bj) { const bool rp2 = (bj == 0 ? part0 : part1) == 2;
                    f32x4 x1 = acc[ai][bj][m][0] * rs, x2 = acc[ai][bj][m][1] * rs;
                    if (rp2) { const f32x4 o1 = x1 * cs - x2 * sn, o2 = x1 * sn + x2 * cs; x1 = o1; x2 = o2; }
                    u32x2 w1, w2; w1.x = pk2(x1[0], x1[1]); w1.y = pk2(x1[2], x1[3]); w2.x = pk2(x2[0], x2[1]); w2.y = pk2(x2[2], x2[3]);
                    *(u32x2*)(rp + 128 * bj) = w1; *(u32x2*)(rp + 128 * bj + 16) = w2; }
                asm volatile("" ::: "memory"); }
    }
};
struct EpiKV {
    static constexpr bool PERM = true, AFTER_DRAIN = false, MIDK = false;
    bf16_t* kn; bf16_t* vt; const float* rstd;
    __device__ __forceinline__ void midk(f32x4 (&)[2][2][4][2], const Unit&, int, int) const {}
    __device__ __forceinline__ void operator()(const f32x4 (&acc)[2][2][4][2], const Unit& u, int wr, int wc, int fr, int fq) const {
        const int sfr = (fr & 3) | ((fr & 4) << 1) | ((fr & 8) >> 1); const int within = 32 * wc + 8 * fq;
#pragma unroll
        for (int ai = 0; ai < 2; ++ai)
#pragma unroll
            for (int m = 0; m < 4; ++m) { int row = u.pm * BM + ai * HALF + wr * 64 + m * 16 + fr; asm volatile("" : "+v"(row)); const float rs = rstd[row];
#pragma unroll
                for (int bj = 0; bj < 2; ++bj) { const int head = 2 * u.pn + bj;
                    const f32x4 v0 = acc[ai][bj][m][0] * rs, v1 = acc[ai][bj][m][1] * rs;
                    u32x4 w; w.x = pk2(v0[0], v0[1]); w.y = pk2(v0[2], v0[3]); w.z = pk2(v1[0], v1[1]); w.w = pk2(v1[2], v1[3]);
                    if (wc < 2) { *(u32x4*)(kn + (size_t)row * LZ + head * 64 + within) = w; }
                    else { bf16_t* vp = vt + (size_t)(head * 64 + within - 64) * T + ((row & ~15) | sfr);
                        vp[0] = (bf16_t)(w.x & 0xffffu); vp[(size_t)T] = (bf16_t)(w.x >> 16); vp[(size_t)2 * T] = (bf16_t)(w.y & 0xffffu); vp[(size_t)3 * T] = (bf16_t)(w.y >> 16);
                        vp[(size_t)4 * T] = (bf16_t)(w.z & 0xffffu); vp[(size_t)5 * T] = (bf16_t)(w.z >> 16); vp[(size_t)6 * T] = (bf16_t)(w.w & 0xffffu); vp[(size_t)7 * T] = (bf16_t)(w.w >> 16); } }
                asm volatile("" ::: "memory"); }
    }
};
struct EpiGU {
    static constexpr bool PERM = true, AFTER_DRAIN = false, MIDK = false;
    bf16_t* O;
    __device__ __forceinline__ void midk(f32x4 (&)[2][2][4][2], const Unit&, int, int) const {}
    __device__ __forceinline__ void operator()(const f32x4 (&acc)[2][2][4][2], const Unit& u, int wr, int wc, int fr, int fq) const {
        const int col = 128 * u.pn + 32 * wc + 8 * fq;
#pragma unroll
        for (int ai = 0; ai < 2; ++ai)
#pragma unroll
            for (int m = 0; m < 4; ++m) { const int row = u.pm * BM + ai * HALF + wr * 64 + m * 16 + fr;
                const f32x4 g0 = acc[ai][0][m][0], g1 = acc[ai][0][m][1], u0 = acc[ai][1][m][0], u1 = acc[ai][1][m][1];
                u32x4 w; w.x = pk2(silu_f(g0[0]) * u0[0], silu_f(g0[1]) * u0[1]); w.y = pk2(silu_f(g0[2]) * u0[2], silu_f(g0[3]) * u0[3]);
                w.z = pk2(silu_f(g1[0]) * u1[0], silu_f(g1[1]) * u1[1]); w.w = pk2(silu_f(g1[2]) * u1[2], silu_f(g1[3]) * u1[3]);
                *(u32x4*)(O + (size_t)row * DFF + col) = w; }
    }
};
}

__device__ __forceinline__ int rowmap(int mode, int n) { return mode == 0 ? n : mode == 3 ? (n < 672 ? n : n + 32) : (((n >> 7) << 8) + (n & 127) + (mode == 2 ? 128 : 0)); }
__device__ __forceinline__ void transpose_item(const float* W, int K, int N, bf16_t* WT, int mode, const float* gain, LAS float* scr, int item, int lane) {
    const int nblk = N / 32, kb = item / nblk, nb = item % nblk, k0 = 64 * kb, n0 = 32 * nb;
    { const int kq = lane >> 3, nq = lane & 7;
      f32x4 v[8];
#pragma unroll
      for (int i = 0; i < 8; ++i) v[i] = __builtin_nontemporal_load((const f32x4*)(W + (size_t)(k0 + 8 * i + kq) * N + n0 + 4 * nq));
#pragma unroll
      for (int i = 0; i < 8; ++i) { const int kk = 8 * i + kq; const float gk = gain ? gain[k0 + kk] : 1.0f;
#pragma unroll
          for (int e = 0; e < 4; ++e) scr[kk * 33 + 4 * nq + e] = v[i][e] * gk; } }
    asm volatile("s_waitcnt lgkmcnt(0)" ::: "memory");
    const int c = lane & 7;
#pragma unroll
    for (int j = 0; j < 4; ++j) { const int n = (lane >> 3) + 8 * j; const LAS float* s = scr + (8 * c) * 33 + n;
        u32x4 o; o.x = pk2(s[0 * 33], s[1 * 33]); o.y = pk2(s[2 * 33], s[3 * 33]); o.z = pk2(s[4 * 33], s[5 * 33]); o.w = pk2(s[6 * 33], s[7 * 33]);
        *(u32x4*)(WT + (size_t)rowmap(mode, n0 + n) * K + k0 + 8 * c) = o; }
    asm volatile("s_waitcnt lgkmcnt(0)" ::: "memory");
}

constexpr int WT_I_IN = 16 * 53, WT_I_QB = 6 * 24, WT_I_KVB = 4 * 32, WT_I_OUT = 16 * 32, WT_I_G = 16 * 88, WT_I_D = 44 * 32;
constexpr int WT_NITEMS = WT_I_IN + WT_I_QB + WT_I_KVB + WT_I_OUT + 2 * WT_I_G + WT_I_D;
__device__ __forceinline__ void wt_convert(unsigned char* ws, LAS unsigned char* lds, int l, int it0, int it1, int rank, int nwk, int tid, int lane, int wid) {
    unsigned char* wb = ws + WS_W + (size_t)l * WL;
    if (it0 == 0) {
        const int gtid = rank * 512 + tid, NT = nwk * 512;
        for (int j = gtid; j < 65536; j += NT) { const float* s = INP(16) + (size_t)l * 131072 + 2 * j; ((unsigned*)(wb + OW_S))[j] = pk2(s[0], s[1]); }
        for (int j = gtid; j < 12288; j += NT) { const int r = j >> 7, dr = r < 32 ? 672 + r : 1728 + (r - 32);
            ((u32x4*)(wb + OW_IN))[(size_t)dr * 128 + (j & 127)] = (u32x4){0u, 0u, 0u, 0u}; }
    }
    LAS float* scr = (LAS float*)(lds + 65536) + wid * (64 * 33);
    for (int it = it0 + rank * 8 + wid; it < it1; it += nwk * 8) {
        int r = it;
        if (r < WT_I_IN) { transpose_item(INP(10) + (size_t)l * 1024 * INC, 1024, INC, (bf16_t*)(wb + OW_IN), 3, nullptr, scr, r, lane); continue; } r -= WT_I_IN;
        if (r < WT_I_QB) { transpose_item(INP(12) + (size_t)l * 384 * 768, 384, 768, (bf16_t*)(wb + OW_QB), 0, INP(11) + l * 384, scr, r, lane); continue; } r -= WT_I_QB;
        if (r < WT_I_KVB) { transpose_item(INP(14) + (size_t)l * 256 * 1024, 256, 1024, (bf16_t*)(wb + OW_KVB), 0, INP(13) + l * 256, scr, r, lane); continue; } r -= WT_I_KVB;
        if (r < WT_I_OUT) { const int kb = r / 32; transpose_item(INP(20) + (size_t)l * 1024 * 1024, 1024, 1024, (bf16_t*)(wb + OW_OUT), 0, kb < 8 ? INP(18) + l * 512 : INP(19) + l * 512 - 512, scr, r, lane); continue; } r -= WT_I_OUT;
        if (r < WT_I_G) { transpose_item(INP(21) + (size_t)l * 1024 * DFF, 1024, DFF, (bf16_t*)(wb + OW_GU), 1, nullptr, scr, r, lane); continue; } r -= WT_I_G;
        if (r < WT_I_G) { transpose_item(INP(22) + (size_t)l * 1024 * DFF, 1024, DFF, (bf16_t*)(wb + OW_GU), 2, nullptr, scr, r, lane); continue; } r -= WT_I_G;
        transpose_item(INP(23) + (size_t)l * DFF * 1024, DFF, 1024, (bf16_t*)(wb + OW_D), 0, nullptr, scr, r, lane);
    }
}

__device__ __forceinline__ void p0_phase(unsigned char* ws, LAS unsigned char* lds, const int wv) {
    int tid = wv * 64 + (int)__builtin_amdgcn_mbcnt_hi(~0u, __builtin_amdgcn_mbcnt_lo(~0u, 0u)); asm volatile("" : "+v"(tid)); const int lane = tid & 63, wid = wv;
    const int G = gridDim.x;
    {
        LAS float* cs = (LAS float*)lds; LAS float* red = cs + NCR * 1024;
        float* mod = (float*)(ws + WS_MOD);
        for (int bg = blockIdx.x; bg < 192; bg += G) {
            for (int t = tid; t < NCR * 1024; t += 512) { const int cr = t >> 10, k = t & 1023; const float c = cr < 2 ? INP(2)[cr * 1024 + k] : INP(3)[(cr - 2) * 1024 + k]; cs[t] = silu_f(c); }
            __syncthreads();
            const int l = bg / 96, cb = (bg % 96) * 64;
            const int cg4 = lane & 15, kq = lane >> 4;
            const float* wm = INP(4) + (size_t)l * 1024 * NMODC + cb + 4 * cg4;
            f32x4 acc[NCR];
#pragma unroll
            for (int cr = 0; cr < NCR; ++cr) acc[cr] = (f32x4){0.f, 0.f, 0.f, 0.f};
#pragma unroll 8
            for (int kk = 0; kk < 32; ++kk) { const int k = wid * 128 + 4 * kk + kq; const f32x4 w = __builtin_nontemporal_load((const f32x4*)(wm + (size_t)k * NMODC));
#pragma unroll
                for (int cr = 0; cr < NCR; ++cr) acc[cr] += w * cs[cr * 1024 + k]; }
#pragma unroll
            for (int cr = 0; cr < NCR; ++cr) {
#pragma unroll
                for (int e = 0; e < 4; ++e) { float s = acc[cr][e]; s += __shfl_xor(s, 16); s += __shfl_xor(s, 32); acc[cr][e] = s; }
                if (kq == 0) *(LAS f32x4*)(red + (wid * NCR + cr) * 64 + 4 * cg4) = acc[cr]; }
            __syncthreads();
            for (int t = tid; t < NCR * 64; t += 512) { const int cr = t >> 6, ln = t & 63; float s = 0.f;
#pragma unroll
                for (int w = 0; w < 8; ++w) s += red[(w * NCR + cr) * 64 + ln];
                mod[(size_t)(l * NCR + cr) * NMODC + cb + ln] = s + INP(5)[l * NMODC + cb + ln]; }
            __syncthreads();
        }
    }
    const int gtid = blockIdx.x * 512 + tid, NT = G * 512;
    {
        float* rope = (float*)(ws + WS_ROPE);
        for (int idx = gtid; idx < 8192 * 16; idx += NT) { const int pos = idx >> 4, i = idx & 15;
            const float inv = exp2f(-(float)i * 0.8304820237218406f);
            const float ang = (float)pos * inv;
            double rev = (double)ang * 0.15915494309189535; rev -= __builtin_rint(rev);
            const float rf = (float)rev;
            rope[2 * idx] = __builtin_amdgcn_cosf(rf); rope[2 * idx + 1] = __builtin_amdgcn_sinf(rf); }
    }
    wt_convert(ws, lds, 0, 0, WT_NITEMS, blockIdx.x, G, tid, lane, wid);
    wt_convert(ws, lds, 1, 0, WT_NITEMS, blockIdx.x, G, tid, lane, wid);
}

struct RowArgs { const bf16_t* src; const float* xin_p; const float* xin_s; float* xout; const float* gpost; const float* ga; const float* gpre; const float* sc; const float* sh; bf16_t* hout; unsigned char* xb; int src_ld, h_ld; };
template <bool HAS_RES, bool HAS_H, bool XIN_BF, bool XOUT_BF>
__device__ __forceinline__ void row_phase(const RowArgs& ra, const int wv) {
    int tid = wv * 64 + (int)__builtin_amdgcn_mbcnt_hi(~0u, __builtin_amdgcn_mbcnt_lo(~0u, 0u)); asm volatile("" : "+v"(tid)); const int lane = tid & 63, wid = wv;
    const int gw = blockIdx.x * 8 + wid, NGW = gridDim.x * 8;
    for (int grp = gw; grp < T / 16; grp += NGW) {
        const int r0 = grp * 16, cr = tok_cr(r0);
        float A[16], B[16], S[16];
#pragma unroll
        for (int j = 0; j < 2; ++j)
#pragma unroll
            for (int q = 0; q < 2; ++q) { const int c = 512 * j + 8 * lane + 4 * q;
                if (HAS_RES) { const f32x4 g = *(const f32x4*)(ra.gpost + c), m = *(const f32x4*)(ra.ga + (size_t)cr * NMODC + c);
#pragma unroll
                    for (int e = 0; e < 4; ++e) A[8 * j + 4 * q + e] = g[e] * m[e]; }
                if (HAS_H) { const f32x4 g = *(const f32x4*)(ra.gpre + c), s1 = *(const f32x4*)(ra.sc + (size_t)cr * NMODC + c), s2 = *(const f32x4*)(ra.sh + (size_t)cr * NMODC + c);
#pragma unroll
                    for (int e = 0; e < 4; ++e) { B[8 * j + 4 * q + e] = g[e] * (1.0f + s1[e]); S[8 * j + 4 * q + e] = s2[e]; } } }
#pragma unroll 2
        for (int i = 0; i < 16; ++i) {
            const int row = r0 + i;
            float x[16];
            if constexpr (XIN_BF) {
#pragma unroll
                for (int j = 0; j < 2; ++j) { const u32x4 w = __builtin_nontemporal_load((const u32x4*)((const bf16_t*)(ra.xb + (size_t)row * 4096) + 512 * j + 8 * lane));
                    x[8 * j + 0] = bf_lo(w.x); x[8 * j + 1] = bf_hi(w.x); x[8 * j + 2] = bf_lo(w.y); x[8 * j + 3] = bf_hi(w.y);
                    x[8 * j + 4] = bf_lo(w.z); x[8 * j + 5] = bf_hi(w.z); x[8 * j + 6] = bf_lo(w.w); x[8 * j + 7] = bf_hi(w.w); }
            } else {
                const float* xr = row < TP ? ra.xin_p + (size_t)row * DM : ra.xin_s + (size_t)(row - TP) * DM;
#pragma unroll
                for (int j = 0; j < 2; ++j)
#pragma unroll
                    for (int q = 0; q < 2; ++q) { const f32x4 v = __builtin_nontemporal_load((const f32x4*)(xr + 512 * j + 8 * lane + 4 * q));
#pragma unroll
                        for (int e = 0; e < 4; ++e) x[8 * j + 4 * q + e] = v[e]; }
            }
            if (HAS_RES) {
                float sv[16]; float ss = 0.f;
#pragma unroll
                for (int j = 0; j < 2; ++j) { const u32x4 w = __builtin_nontemporal_load((const u32x4*)(ra.src + (size_t)row * ra.src_ld + 512 * j + 8 * lane));
                    sv[8 * j + 0] = bf_lo(w.x); sv[8 * j + 1] = bf_hi(w.x); sv[8 * j + 2] = bf_lo(w.y); sv[8 * j + 3] = bf_hi(w.y);
                    sv[8 * j + 4] = bf_lo(w.z); sv[8 * j + 5] = bf_hi(w.z); sv[8 * j + 6] = bf_lo(w.w); sv[8 * j + 7] = bf_hi(w.w); }
#pragma unroll
                for (int e = 0; e < 16; ++e) ss += sv[e] * sv[e];
                const float rs = rsqrtf(wave_sum(ss) * (1.0f / DM) + EPS);
#pragma unroll
                for (int e = 0; e < 16; ++e) x[e] += A[e] * (sv[e] * rs);
                if constexpr (XOUT_BF) {
#pragma unroll
                    for (int j = 0; j < 2; ++j) { u32x4 w; w.x = pk2(x[8 * j], x[8 * j + 1]); w.y = pk2(x[8 * j + 2], x[8 * j + 3]); w.z = pk2(x[8 * j + 4], x[8 * j + 5]); w.w = pk2(x[8 * j + 6], x[8 * j + 7]);
                        __builtin_nontemporal_store(w, (u32x4*)((bf16_t*)(ra.xb + (size_t)row * 4096) + 512 * j + 8 * lane)); }
                } else {
#pragma unroll
                    for (int j = 0; j < 2; ++j)
#pragma unroll
                        for (int q = 0; q < 2; ++q) { const f32x4 v = {x[8 * j + 4 * q], x[8 * j + 4 * q + 1], x[8 * j + 4 * q + 2], x[8 * j + 4 * q + 3]};
                            __builtin_nontemporal_store(v, (f32x4*)(ra.xout + (size_t)row * DM + 512 * j + 8 * lane + 4 * q)); }
                }
            }
            if (HAS_H) {
                float ss = 0.f;
#pragma unroll
                for (int e = 0; e < 16; ++e) ss += x[e] * x[e];
                const float rs = rsqrtf(wave_sum(ss) * (1.0f / DM) + EPS);
#pragma unroll
                for (int j = 0; j < 2; ++j) { u32x4 w; float h[8];
#pragma unroll
                    for (int e = 0; e < 8; ++e) h[e] = x[8 * j + e] * rs * B[8 * j + e] + S[8 * j + e];
                    w.x = pk2(h[0], h[1]); w.y = pk2(h[2], h[3]); w.z = pk2(h[4], h[5]); w.w = pk2(h[6], h[7]);
                    *(u32x4*)(ra.hout + (size_t)row * ra.h_ld + 512 * j + 8 * lane) = w; }
            }
        }
    }
}

__device__ __forceinline__ void mid_phase(unsigned char* ws, int l, LAS unsigned char* lds, const int wv) {
    int tid = wv * 64 + (int)__builtin_amdgcn_mbcnt_hi(~0u, __builtin_amdgcn_mbcnt_lo(~0u, 0u)); asm volatile("" : "+v"(tid)); const int lane = tid & 63, wid = wv;
    bf16_t* z = (bf16_t*)(ws + WS_Z); bf16_t* kr = (bf16_t*)(ws + WS_H) + (size_t)T * 768;
    float* rstdq = (float*)(ws + WS_SSQ); float* rstdkv = rstdq + T;
    const float* rope = (const float*)(ws + WS_ROPE);
    const bf16_t* Wsb = (const bf16_t*)(ws + WS_W + l * WL + OW_S);
    const float* g_sgu = INP(15) + l * 512; const float* b_sp = INP(17) + l * 1024;
    LAS bf16_t* vn = (LAS bf16_t*)lds;
    LAS float* part = (LAS float*)(lds + 131072);
    LAS float* rstd_s = part + 1024;
    const int r32 = lane & 31, hi = lane >> 5;
    for (int ch = blockIdx.x; ch < T / 128; ch += gridDim.x) {
        const int R0 = ch * 128;
        float gs[8];
#pragma unroll
        for (int e = 0; e < 8; ++e) gs[e] = g_sgu[8 * lane + e];
        { const int rrow = R0 + wid * 16 + (lane >> 2), L = lane & 3;
          const u32x4 wr_ = *(const u32x4*)(z + (size_t)rrow * LZ + ZKR + 8 * L);
          const f32x4* tp = (const f32x4*)(rope + ((size_t)tok_pos(rrow) * 16 + 8 * (L & 1)) * 2);
          const f32x4 t0 = tp[0], t1 = tp[1], t2 = tp[2], t3 = tp[3];
          const float cs[8] = {t0[0], t0[2], t1[0], t1[2], t2[0], t2[2], t3[0], t3[2]}, sn[8] = {t0[1], t0[3], t1[1], t1[3], t2[1], t2[3], t3[1], t3[3]};
          float mine[8] = {bf_lo(wr_.x), bf_hi(wr_.x), bf_lo(wr_.y), bf_hi(wr_.y), bf_lo(wr_.z), bf_hi(wr_.z), bf_lo(wr_.w), bf_hi(wr_.w)}; float o[8];
#pragma unroll
          for (int e = 0; e < 8; ++e) { const float oth = __shfl_xor(mine[e], 2); o[e] = L < 2 ? (mine[e] * cs[e] - oth * sn[e]) : (oth * sn[e] + mine[e] * cs[e]); }
          u32x4 w; w.x = pk2(o[0], o[1]); w.y = pk2(o[2], o[3]); w.z = pk2(o[4], o[5]); w.w = pk2(o[6], o[7]);
          *(u32x4*)(kr + (size_t)rrow * 32 + 8 * L) = w; }
#pragma unroll 1
        for (int i0 = 0; i0 < 16; i0 += 4) {
            u32x4 wqa[4], wkva[4], wva[4];
#pragma unroll
            for (int k = 0; k < 4; ++k) { const bf16_t* zr = z + (size_t)(R0 + wid * 16 + i0 + k) * LZ;
                wqa[k] = (u32x4){0u, 0u, 0u, 0u}; wkva[k] = (u32x4){0u, 0u, 0u, 0u};
                if (lane < 48) wqa[k] = *(const u32x4*)(zr + ZQ + 8 * lane);
                if (lane < 32) wkva[k] = *(const u32x4*)(zr + ZKV + 8 * lane);
                wva[k] = *(const u32x4*)(zr + ZV + 8 * lane); }
#pragma unroll
            for (int k = 0; k < 4; ++k) {
                const int lr = wid * 16 + i0 + k, row = R0 + lr; const u32x4 wq = wqa[k], wkv = wkva[k], wv = wva[k];
                float sq = 0.f, skv = 0.f;
                { const float f0 = bf_lo(wq.x), f1 = bf_hi(wq.x), f2 = bf_lo(wq.y), f3 = bf_hi(wq.y), f4 = bf_lo(wq.z), f5 = bf_hi(wq.z), f6 = bf_lo(wq.w), f7 = bf_hi(wq.w);
                  sq = (f0 * f0 + f1 * f1) + (f2 * f2 + f3 * f3) + (f4 * f4 + f5 * f5) + (f6 * f6 + f7 * f7); }
                { const float f0 = bf_lo(wkv.x), f1 = bf_hi(wkv.x), f2 = bf_lo(wkv.y), f3 = bf_hi(wkv.y), f4 = bf_lo(wkv.z), f5 = bf_hi(wkv.z), f6 = bf_lo(wkv.w), f7 = bf_hi(wkv.w);
                  skv = (f0 * f0 + f1 * f1) + (f2 * f2 + f3 * f3) + (f4 * f4 + f5 * f5) + (f6 * f6 + f7 * f7); }
                float gv[8];
                gv[0] = gelu_tanh(bf_lo(wv.x)); gv[1] = gelu_tanh(bf_hi(wv.x)); gv[2] = gelu_tanh(bf_lo(wv.y)); gv[3] = gelu_tanh(bf_hi(wv.y));
                gv[4] = gelu_tanh(bf_lo(wv.z)); gv[5] = gelu_tanh(bf_hi(wv.z)); gv[6] = gelu_tanh(bf_lo(wv.w)); gv[7] = gelu_tanh(bf_hi(wv.w));
                float sv = 0.f;
#pragma unroll
                for (int e = 0; e < 8; ++e) sv += gv[e] * gv[e];
                sq = wave_sum(sq); skv = wave_sum(skv); sv = wave_sum(sv);
                if (lane == 0) { rstdq[row] = rsqrtf(sq * (1.0f / 384.0f) + EPS); rstdkv[row] = rsqrtf(skv * (1.0f / 256.0f) + EPS); }
                const float rv = rsqrtf(sv * (1.0f / 512.0f) + EPS);
                { u32x4 o; o.x = pk2(gv[0] * rv * gs[0], gv[1] * rv * gs[1]); o.y = pk2(gv[2] * rv * gs[2], gv[3] * rv * gs[3]);
                  o.z = pk2(gv[4] * rv * gs[4], gv[5] * rv * gs[5]); o.w = pk2(gv[6] * rv * gs[6], gv[7] * rv * gs[7]);
                  *(LAS u32x4*)(vn + lr * 512 + 8 * lane) = o; }
            }
        }
        __syncthreads();
        const int g = wid;
        f32x16 acc[2][4];
#pragma unroll
        for (int ct = 0; ct < 2; ++ct)
#pragma unroll
            for (int tt = 0; tt < 4; ++tt)
#pragma unroll
                for (int r = 0; r < 16; ++r) acc[ct][tt][r] = 0.f;
#pragma unroll 1
        for (int ks = 0; ks < 8; ++ks) {
            bf16x8 af[2], bfr[4];
#pragma unroll
            for (int ct = 0; ct < 2; ++ct)
#pragma unroll
                for (int e = 0; e < 8; ++e) af[ct][e] = (short)vn[(16 * ks + 8 * hi + e) * 512 + 64 * g + 32 * ct + r32];
#pragma unroll
            for (int tt = 0; tt < 4; ++tt) bfr[tt] = *(const bf16x8*)(Wsb + ((size_t)(g * 128 + 32 * tt + r32) * 128 + 16 * ks + 8 * hi));
#pragma unroll
            for (int ct = 0; ct < 2; ++ct)
#pragma unroll
                for (int tt = 0; tt < 4; ++tt) acc[ct][tt] = __builtin_amdgcn_mfma_f32_32x32x16_bf16(af[ct], bfr[tt], acc[ct][tt], 0, 0, 0);
        }
#pragma unroll
        for (int tt = 0; tt < 4; ++tt) { const int t = 32 * tt + r32; const float bias = b_sp[g * 128 + t]; const bf16_t* zu = z + (size_t)(R0 + t) * LZ + ZU + 64 * g; float s = 0.f;
#pragma unroll
            for (int ct = 0; ct < 2; ++ct)
#pragma unroll
                for (int rq = 0; rq < 4; ++rq) { const u32x2 w = *(const u32x2*)(zu + 32 * ct + 8 * rq + 4 * hi);
                    const float u0 = gelu_tanh(bf_lo(w.x)), u1 = gelu_tanh(bf_hi(w.x)), u2 = gelu_tanh(bf_lo(w.y)), u3 = gelu_tanh(bf_hi(w.y));
                    float v0 = u0 * (acc[ct][tt][4 * rq] + bias), v1 = u1 * (acc[ct][tt][4 * rq + 1] + bias), v2 = u2 * (acc[ct][tt][4 * rq + 2] + bias), v3 = u3 * (acc[ct][tt][4 * rq + 3] + bias);
                    acc[ct][tt][4 * rq] = v0; acc[ct][tt][4 * rq + 1] = v1; acc[ct][tt][4 * rq + 2] = v2; acc[ct][tt][4 * rq + 3] = v3;
                    s += (v0 * v0 + v1 * v1) + (v2 * v2 + v3 * v3); }
            s += __shfl_xor(s, 32);
            if (hi == 0) part[g * 128 + t] = s; }
        __syncthreads();
        if (tid < 128) { float s = 0.f;
#pragma unroll
            for (int w = 0; w < 8; ++w) s += part[w * 128 + tid];
            rstd_s[tid] = rsqrtf(s * (1.0f / 512.0f) + EPS); }
        __syncthreads();
#pragma unroll
        for (int tt = 0; tt < 4; ++tt) { const int t = 32 * tt + r32; const float rs = rstd_s[t]; bf16_t* zu = z + (size_t)(R0 + t) * LZ + ZU + 64 * g;
#pragma unroll
            for (int ct = 0; ct < 2; ++ct)
#pragma unroll
                for (int rq = 0; rq < 4; ++rq) { u32x2 w; w.x = pk2(acc[ct][tt][4 * rq] * rs, acc[ct][tt][4 * rq + 1] * rs); w.y = pk2(acc[ct][tt][4 * rq + 2] * rs, acc[ct][tt][4 * rq + 3] * rs);
                    *(u32x2*)(zu + 32 * ct + 8 * rq + 4 * hi) = w; } }
        __syncthreads();
    }
}

constexpr int KROW = 208, VROW = 144, KTILE_B = 64 * KROW, VTILE_B = 64 * VROW;
__device__ __forceinline__ void attn_phase(unsigned char* ws, LAS unsigned char* lds, const int wv) {
    int tid = wv * 64 + (int)__builtin_amdgcn_mbcnt_hi(~0u, __builtin_amdgcn_mbcnt_lo(~0u, 0u)); asm volatile("" : "+v"(tid)); const int lane = tid & 63, wid = wv;
    const bf16_t* Q = (const bf16_t*)(ws + WS_H); const bf16_t* kr = Q + (size_t)T * 768;
    bf16_t* z = (bf16_t*)(ws + WS_Z); const bf16_t* kn = z + ZV; const bf16_t* Vt = (const bf16_t*)(ws + WS_VT);
    float* ssq = (float*)(ws + WS_SSQ);
    const int r32 = lane & 31, hi = lane >> 5, G = gridDim.x;
    if (wid >= 4) __builtin_amdgcn_s_setprio(1);
    LAS unsigned char* Kl = lds; LAS unsigned char* Vl = lds + 2 * KTILE_B;
    const int kc0 = tid, kc1 = tid + 512;
    const int kr0 = kc0 / 12, kp0 = kc0 % 12, kr1 = kc1 / 12, kp1 = kc1 % 12;
    const int vd = tid >> 3, vch = tid & 7;
    for (int it = 0;; ++it) {
        const int flat = it * G + blockIdx.x; if (flat >= 1024) break;
        int seq, head, qb, s0, len;
        { const int v = flat < 512 ? flat : flat - 512; const int x = v & 7, y = v >> 3;
          if (flat < 512) { qb = y & 31; const int pair = x + 8 * (y >> 5); seq = pair >> 3; head = pair & 7; s0 = seq * 8192; len = 8192; }
          else { qb = y & 7; const int pair = x + 8 * (y >> 3); seq = pair >> 3; head = pair & 7; s0 = TP + seq * 2048; len = 2048; } }
        const int NTL = len / 64;
        const int qrow = s0 + qb * 256 + wid * 32 + r32;
        bf16x8 qf[6];
#pragma unroll
        for (int d0 = 0; d0 < 6; ++d0) qf[d0] = *(const bf16x8*)(Q + (size_t)qrow * 768 + head * 96 + d0 * 16 + hi * 8);
        const unsigned ko0 = kp0 < 8 ? (unsigned)(WS_Z + ((size_t)(s0 + kr0) * LZ + ZV + head * 64 + kp0 * 8) * 2) : (unsigned)(WS_H + ((size_t)T * 768 + (size_t)(s0 + kr0) * 32 + (kp0 - 8) * 8) * 2);
        const unsigned kst0 = kp0 < 8 ? 64u * LZ * 2u : 64u * 32u * 2u;
        const unsigned ko1 = kp1 < 8 ? (unsigned)(WS_Z + ((size_t)(s0 + kr1) * LZ + ZV + head * 64 + kp1 * 8) * 2) : (unsigned)(WS_H + ((size_t)T * 768 + (size_t)(s0 + kr1) * 32 + (kp1 - 8) * 8) * 2);
        const unsigned kst1 = kp1 < 8 ? 64u * LZ * 2u : 64u * 32u * 2u;
        const unsigned vo = (unsigned)(WS_VT + ((size_t)(head * 64 + vd) * T + s0 + vch * 8) * 2);
#define KLD0(t) (*(const u32x4*)(ws + (ko0 + (unsigned)(t) * kst0)))
#define KLD1(t) (*(const u32x4*)(ws + (ko1 + (unsigned)(t) * kst1)))
#define VLD(t) (*(const u32x4*)(ws + (vo + (unsigned)(t) * 128u)))
        const int kd0 = kr0 * KROW + kp0 * 16, kd1 = kr1 * KROW + kp1 * 16, vdst = vd * VROW + vch * 16;
        u32x4 rk0, rk1 = {0u, 0u, 0u, 0u}, rv;
        rk0 = KLD0(0); if (tid < 256) rk1 = KLD1(0); rv = VLD(0);
        *(LAS u32x4*)(Kl + kd0) = rk0; if (tid < 256) *(LAS u32x4*)(Kl + kd1) = rk1; *(LAS u32x4*)(Vl + vdst) = rv;
        rk0 = KLD0(1); if (tid < 256) rk1 = KLD1(1);
        *(LAS u32x4*)(Kl + KTILE_B + kd0) = rk0; if (tid < 256) *(LAS u32x4*)(Kl + KTILE_B + kd1) = rk1;
        rk0 = KLD0(2); if (tid < 256) rk1 = KLD1(2); rv = VLD(1);
        __syncthreads();
        f32x16 o0, o1, negm, sc0, sc1; bf16x8 kf[12];
#pragma unroll
        for (int r = 0; r < 16; ++r) { o0[r] = 0.f; o1[r] = 0.f; negm[r] = 0.f; }
        float lsum = 0.f;
        { const LAS unsigned char* Kb = Kl + r32 * KROW + hi * 16;
#pragma unroll
          for (int d0 = 0; d0 < 6; ++d0) { kf[2 * d0] = *(const LAS bf16x8*)(Kb + d0 * 32); kf[2 * d0 + 1] = *(const LAS bf16x8*)(Kb + 32 * KROW + d0 * 32); }
#pragma unroll
          for (int d0 = 0; d0 < 6; ++d0) {
              sc0 = __builtin_amdgcn_mfma_f32_32x32x16_bf16(kf[2 * d0], qf[d0], d0 == 0 ? negm : sc0, 0, 0, 0);
              sc1 = __builtin_amdgcn_mfma_f32_32x32x16_bf16(kf[2 * d0 + 1], qf[d0], d0 == 0 ? negm : sc1, 0, 0, 0); }
          float rm = fmaxf(fmaxf(sc0[0], sc0[1]), sc1[0]);
#pragma unroll
          for (int r = 2; r < 16; r += 2) rm = fmaxf(fmaxf(rm, sc0[r]), sc0[r + 1]);
#pragma unroll
          for (int r = 1; r < 15; r += 2) rm = fmaxf(fmaxf(rm, sc1[r]), sc1[r + 1]);
          rm = fmaxf(rm, sc1[15]);
          rm = fmaxf(rm, __shfl_xor(rm, 32));
#pragma unroll
          for (int r = 0; r < 16; ++r) { sc0[r] -= rm; sc1[r] -= rm; negm[r] = -rm; }
          const LAS unsigned char* Kb1 = Kb + KTILE_B;
#pragma unroll
          for (int d0 = 0; d0 < 6; ++d0) { kf[2 * d0] = *(const LAS bf16x8*)(Kb1 + d0 * 32); kf[2 * d0 + 1] = *(const LAS bf16x8*)(Kb1 + 32 * KROW + d0 * 32); } }
        __syncthreads();
        int vb3 = 0;
#pragma unroll 2
        for (int kt = 0; kt < NTL; ++kt) {
            const int buf = kt & 1; const int vb3n = vb3 == 2 ? 0 : vb3 + 1;
            const int t3 = kt + 3 < NTL ? kt + 3 : NTL - 1, t2 = kt + 2 < NTL ? kt + 2 : NTL - 1;
            *(LAS u32x4*)(Kl + buf * KTILE_B + kd0) = rk0; if (tid < 256) *(LAS u32x4*)(Kl + buf * KTILE_B + kd1) = rk1;
            *(LAS u32x4*)(Vl + vb3n * VTILE_B + vdst) = rv;
            rk0 = KLD0(t3); if (tid < 256) rk1 = KLD1(t3);
            rv = VLD(t2);
            f32x16 sn0, sn1;
#pragma unroll
            for (int d0 = 0; d0 < 6; ++d0) {
                sn0 = __builtin_amdgcn_mfma_f32_32x32x16_bf16(kf[2 * d0], qf[d0], d0 == 0 ? negm : sn0, 0, 0, 0);
                sn1 = __builtin_amdgcn_mfma_f32_32x32x16_bf16(kf[2 * d0 + 1], qf[d0], d0 == 0 ? negm : sn1, 0, 0, 0); }
#pragma unroll
            for (int r = 0; r < 16; ++r) { sc0[r] = __builtin_amdgcn_exp2f(sc0[r]); sc1[r] = __builtin_amdgcn_exp2f(sc1[r]); }
#pragma unroll
            for (int r = 0; r < 16; ++r) { lsum += sc0[r]; asm volatile("" : "+v"(lsum)); lsum += sc1[r]; asm volatile("" : "+v"(lsum)); }
            float lchk = lsum;
            { auto rr = __builtin_amdgcn_permlane32_swap(__float_as_uint(lchk), __float_as_uint(lchk), false, false); lchk = fmaxf(__uint_as_float(rr[0]), __uint_as_float(rr[1])); }
            u32x4 pw[4];
            pw[0] = (u32x4){pk2(sc0[0], sc0[1]), pk2(sc0[2], sc0[3]), pk2(sc0[4], sc0[5]), pk2(sc0[6], sc0[7])};
            pw[1] = (u32x4){pk2(sc0[8], sc0[9]), pk2(sc0[10], sc0[11]), pk2(sc0[12], sc0[13]), pk2(sc0[14], sc0[15])};
            pw[2] = (u32x4){pk2(sc1[0], sc1[1]), pk2(sc1[2], sc1[3]), pk2(sc1[4], sc1[5]), pk2(sc1[6], sc1[7])};
            pw[3] = (u32x4){pk2(sc1[8], sc1[9]), pk2(sc1[10], sc1[11]), pk2(sc1[12], sc1[13]), pk2(sc1[14], sc1[15])};
            asm volatile("s_waitcnt lgkmcnt(0)" ::: "memory"); __builtin_amdgcn_s_barrier(); asm volatile("" ::: "memory");
            { const LAS unsigned char* Kb = Kl + buf * KTILE_B + r32 * KROW + hi * 16;
#pragma unroll
              for (int d0 = 0; d0 < 6; ++d0) { kf[2 * d0] = *(const LAS bf16x8*)(Kb + d0 * 32); kf[2 * d0 + 1] = *(const LAS bf16x8*)(Kb + 32 * KROW + d0 * 32); } }
            { const LAS unsigned char* Vb = Vl + vb3 * VTILE_B + r32 * VROW + hi * 16;
#pragma unroll
              for (int h2 = 0; h2 < 2; ++h2) { bf16x8 vf[4];
#pragma unroll
                  for (int s = 0; s < 2; ++s) { vf[2 * s] = *(const LAS bf16x8*)(Vb + (2 * h2 + s) * 32); vf[2 * s + 1] = *(const LAS bf16x8*)(Vb + 32 * VROW + (2 * h2 + s) * 32); }
#pragma unroll
                  for (int s = 0; s < 2; ++s) {
                      const bf16x8 pb = __builtin_bit_cast(bf16x8, pw[2 * h2 + s]);
                      o0 = __builtin_amdgcn_mfma_f32_32x32x16_bf16(vf[2 * s], pb, o0, 0, 0, 0);
                      o1 = __builtin_amdgcn_mfma_f32_32x32x16_bf16(vf[2 * s + 1], pb, o1, 0, 0, 0); } } }
            if (__any(lchk > 1.0e12f)) {
                const float dl = fmaxf(floorf(__builtin_amdgcn_logf(lchk)), 0.f); const float f = __builtin_amdgcn_exp2f(-dl);
                lsum *= f; const float nm = negm[0] - dl;
#pragma unroll
                for (int r = 0; r < 16; ++r) { sn0[r] -= dl; sn1[r] -= dl; o0[r] *= f; o1[r] *= f; negm[r] = nm; }
            }
            sc0 = sn0; sc1 = sn1; vb3 = vb3n;
        }
        __syncthreads();
        lsum += __shfl_xor(lsum, 32);
        const float inv = 1.0f / lsum;
        bf16_t* orow = z + (size_t)qrow * LZ + ZATT + head * 64;
        float sq = 0.f;
#pragma unroll
        for (int rq = 0; rq < 4; ++rq) {
            const float a0 = o0[4 * rq] * inv, a1 = o0[4 * rq + 1] * inv, a2 = o0[4 * rq + 2] * inv, a3 = o0[4 * rq + 3] * inv;
            const float b0 = o1[4 * rq] * inv, b1 = o1[4 * rq + 1] * inv, b2 = o1[4 * rq + 2] * inv, b3 = o1[4 * rq + 3] * inv;
            sq += (a0 * a0 + a1 * a1) + (a2 * a2 + a3 * a3) + (b0 * b0 + b1 * b1) + (b2 * b2 + b3 * b3);
            u32x2 w0, w1; w0.x = pk2(a0, a1); w0.y = pk2(a2, a3); w1.x = pk2(b0, b1); w1.y = pk2(b2, b3);
            *(u32x2*)(orow + 8 * rq + 4 * hi) = w0; *(u32x2*)(orow + 32 + 8 * rq + 4 * hi) = w1;
        }
        sq += __shfl_xor(sq, 32);
        if (hi == 0) ssq[(size_t)qrow * 8 + head] = sq;
    }
    __builtin_amdgcn_s_setprio(0);
}

#define XB_TMO      128
#define XB_XCNT(j)  (256  + 64 * (j))
#define XB_XSUB(j)  (1280 + 64 * (j))
#define XB_XGEN(j)  (2304 + 64 * (j))
#define XB_TOP      3328
#define XB_TOPGEN   3392
#define XCD_BAR_WORDS 3456
#define XB_SPIN_CAP (1u << 18)

__device__ __forceinline__ unsigned xb_ld(unsigned* p)              { return __hip_atomic_load(p, __ATOMIC_RELAXED, __HIP_MEMORY_SCOPE_AGENT); }
__device__ __forceinline__ unsigned xb_add(unsigned* p, unsigned v) { return __hip_atomic_fetch_add(p, v, __ATOMIC_RELAXED, __HIP_MEMORY_SCOPE_AGENT); }
__device__ __forceinline__ unsigned xb_xcc_id() { return (unsigned)__builtin_amdgcn_s_getreg((3 << 11) | 20) & 0xFu; }
#define XB_SPIN(cond, bar) do { unsigned _sp = 0; while (cond) { __builtin_amdgcn_s_sleep(1); \
    if ((++_sp & 255u) == 0u) { if (xb_ld(&(bar)[XB_TMO])) break; if (_sp > XB_SPIN_CAP) { atomicAdd(&(bar)[XB_TMO], 1u); break; } } } } while (0)

struct XcdBarrier {
    unsigned* bar; unsigned x;
    volatile LAS unsigned* st;
};

__device__ __forceinline__ XcdBarrier xcd_barrier_post(unsigned* bar, volatile LAS unsigned* st, const bool t0  ) {
    XcdBarrier b; b.bar = bar; b.x = xb_xcc_id(); b.st = st;
    if (t0) (void)xb_add(&bar[XB_XCNT(b.x)], 1u);
    return b;
}
__device__ __forceinline__ void xcd_barrier_complete(unsigned* bar, unsigned x, unsigned& nloc, unsigned& nx) {
    const unsigned G = gridDim.x * gridDim.y * gridDim.z;
    unsigned sum, cnt, mine, sp = 0u;
    for (;;) {
        sum = 0u; cnt = 0u; mine = 0u;
#pragma unroll
        for (unsigned j = 0; j < 16; ++j) { const unsigned c = xb_ld(&bar[XB_XCNT(j)]); sum += c; cnt += (c > 0u) ? 1u : 0u; mine = (j == x) ? c : mine; }
        if (sum == G) break;
        __builtin_amdgcn_s_sleep(1);
        if ((++sp & 255u) == 0u) { if (xb_ld(&bar[XB_TMO])) break; if (sp > XB_SPIN_CAP) { atomicAdd(&bar[XB_TMO], 1u); break; } }
    }
    nloc = mine > 0u ? mine : 1u; nx = cnt > 0u ? cnt : 1u;
}

__device__ __forceinline__ void xcd_barrier(const XcdBarrier& b, const int wv) {
    asm volatile("s_waitcnt vmcnt(0)" ::: "memory");
    __syncthreads();
    if (wv == 0 && (int)__builtin_amdgcn_mbcnt_hi(~0u, __builtin_amdgcn_mbcnt_lo(~0u, 0u)) == 0) {
        unsigned* bar = b.bar; unsigned bx = b.x; asm volatile("" : "+s"(bx));
        __builtin_amdgcn_s_waitcnt(0);
        unsigned nloc = b.st[0], nx = b.st[1];
        if (nloc == 0u) { xcd_barrier_complete(bar, bx, nloc, nx); b.st[0] = nloc; b.st[1] = nx; }
        const unsigned old = xb_add(&bar[XB_XSUB(bx)], 1u);
        const unsigned gen = old / nloc;
        if (old + 1u == (gen + 1u) * nloc) {
            __builtin_amdgcn_fence(__ATOMIC_RELEASE, "agent");
            asm volatile("s_waitcnt vmcnt(0)" ::: "memory");
            const unsigned og = xb_add(&bar[XB_TOP], 1u);
            const unsigned tg = og / nx;
            if (og + 1u == (tg + 1u) * nx) xb_add(&bar[XB_TOPGEN], 1u);
            else XB_SPIN(xb_ld(&bar[XB_TOPGEN]) == tg, bar);
            __builtin_amdgcn_fence(__ATOMIC_ACQUIRE, "agent");
            xb_add(&bar[XB_XGEN(bx)], 1u);
            asm volatile("s_waitcnt vmcnt(0)" ::: "memory");
        } else {
            XB_SPIN(xb_ld(&bar[XB_XGEN(bx)]) == gen, bar);
            __builtin_amdgcn_fence(__ATOMIC_ACQUIRE, "agent");
            asm volatile("s_waitcnt vmcnt(0)" ::: "memory");
        }
    }
    __syncthreads();
}

__global__ void __launch_bounds__(512, 2) fwd_kernel(Args a) {
    __shared__ __attribute__((aligned(16))) unsigned char lds_raw[LDS_BYTES];
    cg::grid_group grid = cg::this_grid();
    LAS unsigned char* lds = (LAS unsigned char*)lds_raw;
    const int wv = __builtin_amdgcn_readfirstlane((int)threadIdx.x >> 6);
    const bool t0 = wv == 0 && (int)__builtin_amdgcn_mbcnt_hi(~0u, __builtin_amdgcn_mbcnt_lo(~0u, 0u)) == 0;
    unsigned char* ws = a.ws;

    if (t0) { LAS long long* tab = (LAS long long*)(lds + TAB_OFF); ((LAS unsigned*)(lds + TAB_OFF + 224))[0] = 0u; ((LAS unsigned*)(lds + TAB_OFF + 224))[1] = 0u;
        tab[0] = (long long)((const unsigned char*)a.in[0] - (const unsigned char*)a.ws);
        tab[1] = (long long)((const unsigned char*)a.in[1] - (const unsigned char*)a.ws);
        tab[2] = (long long)((const unsigned char*)a.in[2] - (const unsigned char*)a.ws);
        tab[3] = (long long)((const unsigned char*)a.in[3] - (const unsigned char*)a.ws);
        tab[4] = (long long)((const unsigned char*)a.in[4] - (const unsigned char*)a.ws);
        tab[5] = (long long)((const unsigned char*)a.in[5] - (const unsigned char*)a.ws);
        tab[6] = (long long)((const unsigned char*)a.in[6] - (const unsigned char*)a.ws);
        tab[7] = (long long)((const unsigned char*)a.in[7] - (const unsigned char*)a.ws);
        tab[8] = (long long)((const unsigned char*)a.in[8] - (const unsigned char*)a.ws);
        tab[9] = (long long)((const unsigned char*)a.in[9] - (const unsigned char*)a.ws);
        tab[10] = (long long)((const unsigned char*)a.in[10] - (const unsigned char*)a.ws);
        tab[11] = (long long)((const unsigned char*)a.in[11] - (const unsigned char*)a.ws);
        tab[12] = (long long)((const unsigned char*)a.in[12] - (const unsigned char*)a.ws);
        tab[13] = (long long)((const unsigned char*)a.in[13] - (const unsigned char*)a.ws);
        tab[14] = (long long)((const unsigned char*)a.in[14] - (const unsigned char*)a.ws);
        tab[15] = (long long)((const unsigned char*)a.in[15] - (const unsigned char*)a.ws);
        tab[16] = (long long)((const unsigned char*)a.in[16] - (const unsigned char*)a.ws);
        tab[17] = (long long)((const unsigned char*)a.in[17] - (const unsigned char*)a.ws);
        tab[18] = (long long)((const unsigned char*)a.in[18] - (const unsigned char*)a.ws);
        tab[19] = (long long)((const unsigned char*)a.in[19] - (const unsigned char*)a.ws);
        tab[20] = (long long)((const unsigned char*)a.in[20] - (const unsigned char*)a.ws);
        tab[21] = (long long)((const unsigned char*)a.in[21] - (const unsigned char*)a.ws);
        tab[22] = (long long)((const unsigned char*)a.in[22] - (const unsigned char*)a.ws);
        tab[23] = (long long)((const unsigned char*)a.in[23] - (const unsigned char*)a.ws);
    }
    __syncthreads();
    const XcdBarrier bar = xcd_barrier_post((unsigned*)ws, (volatile LAS unsigned*)(lds + TAB_OFF + 224), t0);
    float* const xout = a.out;
#define WSL(w) size_t w##_z = 0; asm volatile("" : "+s"(w##_z)); unsigned char* w = ws + w##_z
#define HB(w) ((bf16_t*)((w) + WS_H))
#define ZB(w) ((bf16_t*)((w) + WS_Z))
#define MODP(w) ((const float*)((w) + WS_MOD))
    p0_phase(ws, lds, wv);
    grid.sync();
    { WSL(w); RowArgs ra{nullptr, INP(0), INP(1), nullptr, nullptr, nullptr, INP(6), MODP(w) + 1024, MODP(w), HB(w), nullptr, 0, DM}; row_phase<false, true, false, true>(ra, wv); }
    xcd_barrier(bar, wv);
#pragma unroll 1
    for (int l = 0; l < NLAYER; ++l) {
        { WSL(w); int Gl = gridDim.x, bl = blockIdx.x; asm volatile("" : "+s"(Gl), "+s"(bl));
          pg8::Gemm g{HB(w), (const bf16_t*)(w + WS_W + (size_t)l * WL + OW_IN), T, NIN, 1024, 1024}; pg8::StaticOrder S; S.init(T, NIN, Gl, bl);
          pg8::EpiStore<false> E{ZB(w), LZ, LZ, nullptr, 0}; pg8::gemm_phase<pg8::EpiStore<false>, pg8::StaticOrder, true, true>(lds, g, S, E, wv); }
        xcd_barrier(bar, wv);
        { WSL(w); mid_phase(w, l, lds, wv); }
        xcd_barrier(bar, wv);
        { WSL(w); int Gl = gridDim.x, bl = blockIdx.x; asm volatile("" : "+s"(Gl), "+s"(bl));
          pg8::Gemm g{ZB(w) + ZQ, (const bf16_t*)(w + WS_W + (size_t)l * WL + OW_QB), T, 768, 384, LZ}; pg8::StaticOrder S; S.init(T, 768, Gl, bl);
          pg8::EpiQ E{HB(w), (const float*)(w + WS_ROPE), (const float*)(w + WS_SSQ)}; pg8::gemm_phase<pg8::EpiQ, pg8::StaticOrder, true, true>(lds, g, S, E, wv); }
        { WSL(w); int Gl = gridDim.x, bl = blockIdx.x; asm volatile("" : "+s"(Gl), "+s"(bl));
          pg8::Gemm g{ZB(w) + ZKV, (const bf16_t*)(w + WS_W + (size_t)l * WL + OW_KVB), T, 1024, 256, LZ}; pg8::StaticOrder S; S.init(T, 1024, Gl, bl);
          pg8::EpiKV E{ZB(w) + ZV, (bf16_t*)(w + WS_VT), (const float*)(w + WS_SSQ) + T}; pg8::gemm_phase<pg8::EpiKV, pg8::StaticOrder, true, true>(lds, g, S, E, wv); }
        xcd_barrier(bar, wv);
        { WSL(w); attn_phase(w, lds, wv); }
        xcd_barrier(bar, wv);
        { WSL(w); int Gl = gridDim.x, bl = blockIdx.x; asm volatile("" : "+s"(Gl), "+s"(bl));
          pg8::Gemm g{ZB(w) + ZATT, (const bf16_t*)(w + WS_W + (size_t)l * WL + OW_OUT), T, 1024, 1024, LZ}; pg8::StaticOrder S; S.init(T, 1024, Gl, bl);
          pg8::EpiStore<true> E{HB(w), DM, DM, (const float*)(w + WS_SSQ), 1}; pg8::gemm_phase<pg8::EpiStore<true>, pg8::StaticOrder, true, true>(lds, g, S, E, wv); }
        xcd_barrier(bar, wv);
        { WSL(w); const float* modl = MODP(w) + (size_t)l * NCR * NMODC;
          RowArgs ra{HB(w), INP(0), INP(1), nullptr, INP(7) + l * DM, modl + 2048, INP(8) + l * DM, modl + 4096, modl + 3072, EB(xout), (unsigned char*)xout, DM, 2048};
          if (l == 0) row_phase<true, true, false, true>(ra, wv); else row_phase<true, true, true, true>(ra, wv); }
        xcd_barrier(bar, wv);
        { WSL(w); int Gl = gridDim.x, bl = blockIdx.x; asm volatile("" : "+s"(Gl), "+s"(bl));
          pg8::Gemm g{EB(xout), (const bf16_t*)(w + WS_W + (size_t)l * WL + OW_GU), T, NGU, 1024, 2048}; pg8::StaticOrder S; S.init(T, NGU, Gl, bl);
          pg8::EpiGU E{HB(w)}; pg8::gemm_phase<pg8::EpiGU, pg8::StaticOrder, true, true>(lds, g, S, E, wv); }
        xcd_barrier(bar, wv);
        { WSL(w); int Gl = gridDim.x, bl = blockIdx.x; asm volatile("" : "+s"(Gl), "+s"(bl));
          pg8::Gemm g{HB(w), (const bf16_t*)(w + WS_W + (size_t)l * WL + OW_D), T, 1024, DFF, DFF}; pg8::StaticOrder S; S.init(T, 1024, Gl, bl);
          pg8::EpiStore<false> E{EB(xout), 2048, DM, nullptr, 1}; pg8::gemm_phase<pg8::EpiStore<false>, pg8::StaticOrder, true, true>(lds, g, S, E, wv); }
        xcd_barrier(bar, wv);
        if (l + 1 < NLAYER) {
            WSL(w); const float* modl = MODP(w) + (size_t)l * NCR * NMODC; const float* modn = modl + NCR * NMODC;
            RowArgs ra{EB(xout), nullptr, nullptr, nullptr, INP(9) + l * DM, modl + 5120, INP(6) + (l + 1) * DM, modn + 1024, modn, HB(w), (unsigned char*)xout, 2048, DM};
            row_phase<true, true, true, true>(ra, wv);
            xcd_barrier(bar, wv);
        } else {
            WSL(w); const float* modl = MODP(w) + (size_t)l * NCR * NMODC;
            RowArgs ra{EB(xout), nullptr, nullptr, xout, INP(9) + l * DM, modl + 5120, nullptr, nullptr, nullptr, nullptr, (unsigned char*)xout, 2048, 0};
            row_phase<true, false, true, false>(ra, wv);
        }
    }
}

extern "C" void kernel_launch(void* const* d_in, const int* in_sizes, int n_in, void* d_out, int out_size, void* d_ws, size_t ws_size, hipStream_t stream) {
    static int grid = 0;
    if (grid == 0) {
        if (n_in != 24 || out_size != T * DM || ws_size < WS_END) { fprintf(stderr, "kernel_launch: unexpected problem (n_in %d out %d ws %zu)\n", n_in, out_size, ws_size); grid = -1; return; }
        int dev = 0, cus = 0, per_cu = 0;
        hipGetDevice(&dev); hipDeviceGetAttribute(&cus, hipDeviceAttributeMultiprocessorCount, dev);
        hipOccupancyMaxActiveBlocksPerMultiprocessor(&per_cu, (const void*)fwd_kernel, 512, 0);
        if (per_cu < 1) per_cu = 1;
        grid = cus * per_cu;
        fprintf(stderr, "kernel_launch: grid %d (cus %d x %d)\n", grid, cus, per_cu);
    }
    if (grid < 0) return;
    if (hipMemsetAsync(d_ws, 0, 16384, stream) != hipSuccess) { fprintf(stderr, "kernel_launch: memset failed\n"); return; }
    Args a{};
    for (int i = 0; i < 24; ++i) a.in[i] = (const float*)d_in[i];
    a.out = (float*)d_out; a.ws = (unsigned char*)d_ws;
    void* args[] = {&a};
    hipError_t e = hipLaunchCooperativeKernel((const void*)fwd_kernel, dim3(grid), dim3(512), args, 0, stream);
    if (e != hipSuccess) fprintf(stderr, "cooperative launch failed: %s (grid %d)\n", hipGetErrorString(e), grid);
}
```
